# Optimizing an MI355X kernel written in HIP

```python
import math
import jax, jax.numpy as jnp
from jax import lax
import numpy as np

D_MODEL = 1024
BATCH = 8
SEQ = 2048
DEPTH = 1
DEC_BATCH = 2
DEC_SEQ = 8192
PAST_LEN = 128

GRID_W = 64
MIX_WIDTH = D_MODEL
ATT_WIDTH = MIX_WIDTH // 2
HEAD_DIM = 64
N_HEADS = ATT_WIDTH // HEAD_DIM
POOL_WIDTH = MIX_WIDTH - ATT_WIDTH
POOL_WINDOWS = (2, 4, 8, 16)
N_POOL = len(POOL_WINDOWS)
POOL_GROUP_DIM = POOL_WIDTH // N_POOL
IN_WIDTH = 3 * ATT_WIDTH + POOL_WIDTH
WIN_ROWS = 8
WIN_COLS = 16
D_FF = 2816
CONV_W = 3
EPS = 1e-6

kernel_name = "hybrid_natten_pool_encoder"


def rmsnorm(x, g):
    xf = x.astype(jnp.float32)
    y = xf * lax.rsqrt(jnp.mean(xf * xf, axis=-1, keepdims=True) + EPS)
    return (y * g.astype(jnp.float32)).astype(x.dtype)


def neighborhood_attention(q, k, v, rpb):
    B, T, H, hd = q.shape
    rows = T // GRID_W
    kh = min(WIN_ROWS, rows)
    kw = WIN_COLS
    qg = q.reshape(B, rows, GRID_W, H, hd)
    kg = k.reshape(B, rows, GRID_W, H, hd)
    vg = v.reshape(B, rows, GRID_W, H, hd)
    cols = jnp.arange(GRID_W)
    col_start = jnp.clip(cols - kw // 2, 0, GRID_W - kw)
    col_idx = col_start[:, None] + jnp.arange(kw)[None, :]
    dc = col_idx - cols[:, None] + (WIN_COLS - 1)
    scale = HEAD_DIM ** -0.5

    def row_block(r):
        rs = jnp.clip(r - kh // 2, 0, rows - kh)
        q_r = lax.dynamic_index_in_dim(qg, r, axis=1, keepdims=False)
        k_rows = lax.dynamic_slice_in_dim(kg, rs, kh, axis=1)
        v_rows = lax.dynamic_slice_in_dim(vg, rs, kh, axis=1)
        k_nb = k_rows[:, :, col_idx]
        v_nb = v_rows[:, :, col_idx]
        s = jnp.einsum('bqhd,biqjhd->bhqij', q_r, k_nb)
        dr = rs + jnp.arange(kh) - r + (WIN_ROWS - 1)
        bias = rpb[:, dr[None, :, None], dc[:, None, :]]
        s = s.astype(jnp.float32) * scale + bias.astype(jnp.float32)[None]
        p = jax.nn.softmax(s.reshape(B, H, GRID_W, kh * kw), axis=-1)
        p = p.reshape(B, H, GRID_W, kh, kw).astype(v.dtype)
        return jnp.einsum('bhqij,biqjhd->bqhd', p, v_nb)

    out = lax.map(row_block, jnp.arange(rows))
    return jnp.transpose(out, (1, 0, 2, 3, 4)).reshape(B, T, H * hd)


def multiscale_pool(u, w_pool, pool_scale):
    B, T, _ = u.shape
    ug = u.reshape(B, T, N_POOL, POOL_GROUP_DIM).astype(jnp.float32)
    cs = jnp.concatenate([jnp.zeros((B, 1, N_POOL, POOL_GROUP_DIM), jnp.float32),
                          jnp.cumsum(ug, axis=1)], axis=1)
    t = jnp.arange(T)
    means = []
    for g, w in enumerate(POOL_WINDOWS):
        lo = jnp.clip(t - w // 2, 0, T)
        hi = jnp.clip(t - w // 2 + w, 0, T)
        cnt = (hi - lo).astype(jnp.float32)
        means.append((cs[:, hi, g] - cs[:, lo, g]) / cnt[None, :, None])
    mixed = (jnp.stack(means, axis=2) - ug).astype(u.dtype)
    y = jnp.einsum('btgc,gcd->btgd', mixed, w_pool)
    return y.reshape(B, T, POOL_WIDTH) * pool_scale


def dwconv3(x, w, b):
    xp = jnp.pad(x, ((0, 0), (1, 1), (0, 0)))
    return xp[:, :-2] * w[0] + xp[:, 1:-1] * w[1] + xp[:, 2:] * w[2] + b


def encoder_layer(x, c, w_ada, b_ada, norm1_g, norm2_g, w_in, q_norm_g, k_norm_g,
                  rpb, w_pool, pool_scale, w_out, w_up, conv_w, conv_b, w_down):
    B, T, D = x.shape
    mod = jnp.einsum('bd,de->be', jax.nn.silu(c), w_ada) + b_ada
    sh1, sc1, g1, sh2, sc2, g2 = jnp.split(mod[:, None, :], 6, axis=-1)

    h = rmsnorm(x, norm1_g) * (1 + sc1) + sh1
    proj = jnp.einsum('btd,de->bte', h, w_in)
    q, k, v, u = jnp.split(proj, [ATT_WIDTH, 2 * ATT_WIDTH, 3 * ATT_WIDTH], axis=-1)
    q = rmsnorm(q.reshape(B, T, N_HEADS, HEAD_DIM), q_norm_g)
    k = rmsnorm(k.reshape(B, T, N_HEADS, HEAD_DIM), k_norm_g)
    v = v.reshape(B, T, N_HEADS, HEAD_DIM)
    a = neighborhood_attention(q, k, v, rpb)
    p = multiscale_pool(u, w_pool, pool_scale)
    mixed = jnp.einsum('bte,ed->btd', jnp.concatenate([a, p], axis=-1), w_out)
    x = x + g1 * mixed

    h = rmsnorm(x, norm2_g) * (1 + sc2) + sh2
    up = dwconv3(jnp.einsum('btd,df->btf', h, w_up), conv_w, conv_b)
    gate, val = jnp.split(up, 2, axis=-1)
    y = jnp.einsum('btf,fd->btd', jax.nn.silu(gate) * val, w_down)
    return x + g2 * y


def setup_inputs(seed: int = 0) -> dict:
    key = jax.random.key(seed)
    ks = jax.random.split(key, 24)
    nrm = jax.random.normal
    L, D, F = DEPTH, D_MODEL, D_FF
    f32 = jnp.float32
    conv_center = jnp.zeros((CONV_W, 1), f32).at[CONV_W // 2].set(1.0)
    return {
        "x_prompt": nrm(ks[0], (BATCH, SEQ, D), f32),
        "x_sample": nrm(ks[1], (DEC_BATCH, DEC_SEQ, D), f32),
        "c_prompt": nrm(ks[2], (BATCH, D), f32),
        "c_sample": nrm(ks[3], (DEC_BATCH, D), f32),
        "w_ada": nrm(ks[4], (L, D, 6 * D), f32) * (0.5 * D ** -0.5),
        "b_ada": nrm(ks[5], (L, 6 * D), f32) * 0.02,
        "norm1_g": 1.0 + 0.05 * nrm(ks[6], (L, D), f32),
        "norm2_g": 1.0 + 0.05 * nrm(ks[7], (L, D), f32),
        "w_in": nrm(ks[8], (L, D, IN_WIDTH), f32) * D ** -0.5,
        "q_norm_g": 1.0 + 0.05 * nrm(ks[9], (L, HEAD_DIM), f32),
        "k_norm_g": 1.0 + 0.05 * nrm(ks[10], (L, HEAD_DIM), f32),
        "rpb": 0.5 * nrm(ks[11], (L, N_HEADS, 2 * WIN_ROWS - 1, 2 * WIN_COLS - 1), f32),
        "w_pool": nrm(ks[12], (L, N_POOL, POOL_GROUP_DIM, POOL_GROUP_DIM), f32) * POOL_GROUP_DIM ** -0.5,
        "pool_scale": 1.0 + 0.1 * nrm(ks[13], (L, POOL_WIDTH), f32),
        "w_out": nrm(ks[14], (L, MIX_WIDTH, D), f32) * MIX_WIDTH ** -0.5,
        "w_up": nrm(ks[15], (L, D, 2 * F), f32) * D ** -0.5,
        "conv_w": conv_center[None] + 0.2 * nrm(ks[16], (L, CONV_W, 2 * F), f32),
        "conv_b": 0.02 * nrm(ks[17], (L, 2 * F), f32),
        "w_down": nrm(ks[18], (L, F, D), f32) * F ** -0.5,
    }


def reference(x_prompt, x_sample, c_prompt, c_sample, w_ada, b_ada, norm1_g, norm2_g,
              w_in, q_norm_g, k_norm_g, rpb, w_pool, pool_scale, w_out, w_up,
              conv_w, conv_b, w_down):
    y_prompt = x_prompt
    y_sample = x_sample
    for l in range(DEPTH):
        params = (w_ada[l], b_ada[l], norm1_g[l], norm2_g[l], w_in[l], q_norm_g[l],
                  k_norm_g[l], rpb[l], w_pool[l], pool_scale[l], w_out[l], w_up[l],
                  conv_w[l], conv_b[l], w_down[l])
        y_prompt = encoder_layer(y_prompt, c_prompt, *params)
        y_sample = encoder_layer(y_sample, c_sample, *params)
    return (y_prompt, y_sample)
```

```cpp
#include <hip/hip_runtime.h>
#include <cstdio>
#include <cstdint>

constexpr int D = 1024, MT = 32768, NPR = 16384, INW = 2048, ATTW = 512, HD = 64, NH = 8, FF = 2816, FF2 = 5632, NBATCH = 10, MODW = 6144;
constexpr float EPS = 1e-6f;

namespace pg8 {
#define PG8_LAS __attribute__((address_space(3)))
typedef unsigned short bf16_t;
typedef short bf16x8 __attribute__((ext_vector_type(8)));
typedef float f32x4 __attribute__((ext_vector_type(4)));
typedef unsigned u32x4 __attribute__((ext_vector_type(4)));
constexpr int BM = 256, BK = 64, HALF = 128, HTB = HALF * BK * 2  , STAGE_BYTES = 8 * HTB, NXCD = 8, WGM = 8;

__host__ __device__ __forceinline__ int lds_byte(int r, int c) { const int st = (r >> 4) * 2 + (c >> 5), rr = r & 15, cc = c & 31, ob = rr * 64 + cc * 2; return st * 1024 + (ob ^ (((ob >> 9) & 1) << 5)); }
__host__ __device__ __forceinline__ void stage_rc(int b, int& R, int& C) { const int st = b / 1024, sb = b % 1024, swz = sb ^ (((sb >> 9) & 1) << 5); R = (st >> 1) * 16 + swz / 64; C = (st & 1) * 32 + (swz % 64) / 2; }
__host__ __device__ __forceinline__ int perm32(int rho) { const int n = rho >> 4, i = rho & 15; return 8 * (i >> 2) + 4 * n + (i & 3); }

struct Unit { int pm, pn; };
struct Gemm { const bf16_t* A; const bf16_t* Bt; int M, N, K; };

struct StaticOrder {
    int nM, nN, nwg, G, c;
    __host__ __device__ void init(int M, int N, int G_, int c_) { nM = M / BM; nN = N / BM; nwg = nM * nN; G = G_; c = c_; }
    __host__ __device__ bool next(int i, Unit& u) const {
        const long L = (long)i * G + c; if (L >= nwg) return false;
        int wgid = (int)L; { const int q = nwg / NXCD, r = nwg % NXCD, xcd = wgid % NXCD, off = wgid / NXCD; wgid = (xcd < r ? xcd * (q + 1) : r * (q + 1) + (xcd - r) * q) + off; }
        const int nig = WGM * nN, gid = wgid / nig, fm = gid * WGM, gsz = (nM - fm) < WGM ? (nM - fm) : WGM;
        u.pm = fm + ((wgid % nig) % gsz); u.pn = (wgid % nig) / gsz; return true;
    }
    __device__ __forceinline__ void a_ready(const Unit&) const {}
    __device__ __forceinline__ void done(const Unit&) const {}
};

template <class Epi, class Sched, bool ALIGN_EPI = false, bool SP2 = false>
__device__ __forceinline__ void gemm_phase(PG8_LAS unsigned char* lds, const Gemm g, const Sched& S, const Epi& E) {
    const int tid = threadIdx.x, wid = __builtin_amdgcn_readfirstlane(tid >> 6), lane = tid & 63, wr = wid >> 2, wc = wid & 3, fr = lane & 15, fq = lane >> 4;
    const int K = g.K, nt = K / BK;
    unsigned voffA[2], voffB[2];
#pragma unroll
    for (int i = 0; i < 2; ++i) { int R, C; stage_rc(tid * 16 + i * 8192, R, C); const int Rb = Epi::PERM ? ((R & ~31) + perm32(R & 31)) : R;
        voffA[i] = (unsigned)(R * K + C) * 2u; voffB[i] = (unsigned)(Rb * K + C) * 2u; }
    const size_t kstep = (size_t)(BK * 2);
    const size_t hstep = (size_t)HALF * K * 2;
    const size_t tstep = 2 * hstep;
    const unsigned ldsw = (unsigned)wid * 1024u;
    const int aoff = lds_byte(wr * 64 + fr, fq * 8), boff = lds_byte(wc * 32 + fr, fq * 8);
#define PG8_SA(b, h) (((b) * 2 + (h)) * HTB)
#define PG8_SB(b, h) ((4 + (b) * 2 + (h)) * HTB)
#define PG8_STAGE(bufoff, gbase, voff) do { _Pragma("unroll") for (int _i = 0; _i < 2; ++_i) \
        __builtin_amdgcn_global_load_lds((const unsigned*)((const char*)(gbase) + (voff)[_i]), (PG8_LAS unsigned*)(lds + (bufoff) + ldsw + _i * 8192), 16, 0, 0); } while (0)
#define PG8_LDA(dst, b, h) do { _Pragma("unroll") for (int m = 0; m < 4; ++m) _Pragma("unroll") for (int k = 0; k < 2; ++k) dst[m][k] = *(const PG8_LAS bf16x8*)(lds + PG8_SA(b, h) + aoff + m * 2048 + k * 1024); } while (0)
#define PG8_LDB(dst, b, h) do { _Pragma("unroll") for (int n = 0; n < 2; ++n) _Pragma("unroll") for (int k = 0; k < 2; ++k) dst[n][k] = *(const PG8_LAS bf16x8*)(lds + PG8_SB(b, h) + boff + n * 2048 + k * 1024); } while (0)
#define PG8_MMA(ai, bj, At, Bt) do { __builtin_amdgcn_s_setprio(1); _Pragma("unroll") for (int m = 0; m < 4; ++m) _Pragma("unroll") for (int n = 0; n < 2; ++n) _Pragma("unroll") for (int k = 0; k < 2; ++k) \
        acc[ai][bj][m][n] = __builtin_amdgcn_mfma_f32_16x16x32_bf16(Bt[n][k], At[m][k], acc[ai][bj][m][n], 0, 0, 0); __builtin_amdgcn_s_setprio(0); } while (0)
#define PG8_WAIT_V(n) asm volatile("s_waitcnt vmcnt(" #n ")" ::: "memory")
#define PG8_WAIT_L(n) asm volatile("s_waitcnt lgkmcnt(" #n ")" ::: "memory")
#define PG8_BAR __builtin_amdgcn_s_barrier()
#define PG8_SCHED __builtin_amdgcn_sched_barrier(0)
    Unit cur, nxt; int ui = 0;
    if (!S.next(0, cur)) return;
    f32x4 acc[2][2][4][2];
#pragma unroll
    for (int a = 0; a < 2; ++a)
#pragma unroll
        for (int b = 0; b < 2; ++b)
#pragma unroll
            for (int m = 0; m < 4; ++m)
#pragma unroll
                for (int n = 0; n < 2; ++n) acc[a][b][m][n] = (f32x4){0.f, 0.f, 0.f, 0.f};
    bf16x8 At[4][2], B0[2][2], B1[2][2];
    const char* cA = (const char*)g.A + (size_t)cur.pm * tstep; const char* cB = (const char*)g.Bt + (size_t)cur.pn * tstep;
    S.a_ready(cur);
    if constexpr (SP2) {
        PG8_STAGE(PG8_SB(0, 0), cB, voffB); PG8_STAGE(PG8_SB(0, 1), cB + hstep, voffB); PG8_STAGE(PG8_SA(0, 0), cA, voffA); PG8_STAGE(PG8_SA(0, 1), cA + hstep, voffA);
        if (wr == 1) PG8_BAR;
        PG8_WAIT_V(2); PG8_BAR;
        PG8_STAGE(PG8_SB(1, 0), cB + kstep, voffB); PG8_STAGE(PG8_SA(1, 0), cA + kstep, voffA); PG8_STAGE(PG8_SB(1, 1), cB + hstep + kstep, voffB);
        PG8_WAIT_V(6); PG8_BAR;
    } else {
        PG8_STAGE(PG8_SB(0, 0), cB, voffB); PG8_STAGE(PG8_SA(0, 0), cA, voffA); PG8_STAGE(PG8_SB(0, 1), cB + hstep, voffB); PG8_STAGE(PG8_SA(0, 1), cA + hstep, voffA);
        if (wr == 1) PG8_BAR;
        PG8_WAIT_V(4); PG8_BAR;
        PG8_STAGE(PG8_SB(1, 0), cB + kstep, voffB); PG8_STAGE(PG8_SA(1, 0), cA + kstep, voffA); PG8_STAGE(PG8_SB(1, 1), cB + hstep + kstep, voffB);
        PG8_WAIT_V(6); PG8_BAR;
    }
    for (;;) {
        const bool has_next = S.next(ui + 1, nxt);
        const char* nA = has_next ? (const char*)g.A + (size_t)nxt.pm * tstep : cA; const char* nB = has_next ? (const char*)g.Bt + (size_t)nxt.pn * tstep : cB;
        for (int t = 0; t < nt; t += 2) {
            const bool last = (t == nt - 2);
            const char* a1 = cA + (size_t)(t + 1) * kstep;
            const char* a2 = last ? nA : cA + (size_t)(t + 2) * kstep; const char* b2 = last ? nB : cB + (size_t)(t + 2) * kstep;
            const char* a3 = a2 + kstep; const char* b3 = b2 + kstep;
            if (last && has_next) S.a_ready(nxt);
            if constexpr (SP2) {
            PG8_LDB(B0, 0, 0); PG8_LDB(B1, 0, 1); PG8_SCHED; PG8_LDA(At, 0, 0); PG8_STAGE(PG8_SA(1, 1), a1 + hstep, voffA);
            PG8_WAIT_V(8); PG8_WAIT_L(0); PG8_BAR; PG8_MMA(0, 0, At, B0); PG8_MMA(0, 1, At, B1); PG8_BAR; PG8_SCHED;
            PG8_LDA(At, 0, 1); PG8_STAGE(PG8_SB(0, 0), b2, voffB); PG8_STAGE(PG8_SB(0, 1), b2 + hstep, voffB); PG8_STAGE(PG8_SA(0, 0), a2, voffA);
            PG8_WAIT_V(8); PG8_WAIT_L(0); PG8_BAR; PG8_MMA(1, 0, At, B0); PG8_MMA(1, 1, At, B1); PG8_BAR; PG8_SCHED;
            PG8_LDB(B0, 1, 0); PG8_LDB(B1, 1, 1); PG8_SCHED; PG8_LDA(At, 1, 0); PG8_STAGE(PG8_SA(0, 1), a2 + hstep, voffA);
            PG8_WAIT_V(8); PG8_WAIT_L(0); PG8_BAR; PG8_MMA(0, 0, At, B0); PG8_MMA(0, 1, At, B1); PG8_BAR; PG8_SCHED;
            PG8_LDA(At, 1, 1); PG8_STAGE(PG8_SB(1, 0), b3, voffB); PG8_STAGE(PG8_SB(1, 1), b3 + hstep, voffB); PG8_STAGE(PG8_SA(1, 0), a3, voffA);
            PG8_WAIT_V(8); PG8_WAIT_L(0); PG8_BAR; PG8_MMA(1, 0, At, B0); PG8_MMA(1, 1, At, B1); PG8_BAR; PG8_SCHED;
            } else {
            PG8_LDB(B0, 0, 0); PG8_SCHED; PG8_LDA(At, 0, 0); PG8_STAGE(PG8_SA(1, 1), a1 + hstep, voffA);
            PG8_WAIT_L(8); PG8_BAR; PG8_WAIT_L(0); PG8_MMA(0, 0, At, B0); PG8_BAR; PG8_SCHED;
            PG8_LDB(B1, 0, 1); PG8_STAGE(PG8_SB(0, 0), b2, voffB);
            PG8_BAR; PG8_WAIT_L(0); PG8_MMA(0, 1, At, B1); PG8_BAR;
            PG8_LDA(At, 0, 1); PG8_STAGE(PG8_SA(0, 0), a2, voffA);
            PG8_BAR; PG8_WAIT_L(0); PG8_MMA(1, 0, At, B0); PG8_BAR; PG8_SCHED;
            PG8_STAGE(PG8_SB(0, 1), b2 + hstep, voffB);
            PG8_WAIT_V(6); PG8_BAR; PG8_MMA(1, 1, At, B1); PG8_BAR;
            PG8_LDB(B0, 1, 0); PG8_SCHED; PG8_LDA(At, 1, 0); PG8_STAGE(PG8_SA(0, 1), a2 + hstep, voffA);
            PG8_WAIT_L(8); PG8_BAR; PG8_WAIT_L(0); PG8_MMA(0, 0, At, B0); PG8_BAR; PG8_SCHED;
            PG8_LDB(B1, 1, 1); PG8_STAGE(PG8_SB(1, 0), b3, voffB);
            PG8_BAR; PG8_WAIT_L(0); PG8_MMA(0, 1, At, B1); PG8_BAR;
            PG8_LDA(At, 1, 1); PG8_STAGE(PG8_SA(1, 0), a3, voffA);
            PG8_BAR; PG8_WAIT_L(0); PG8_MMA(1, 0, At, B0); PG8_BAR; PG8_SCHED;
            PG8_STAGE(PG8_SB(1, 1), b3 + hstep, voffB);
            PG8_WAIT_V(6); PG8_BAR; PG8_MMA(1, 1, At, B1); PG8_BAR;
            }
        }
        if constexpr (ALIGN_EPI) { if (wr == 0) PG8_BAR; }
        if constexpr (!Epi::AFTER_DRAIN) { E(acc, cur, wr, wc, fr, fq); S.done(cur); }
        if (!has_next) break;
#pragma unroll
        for (int a = 0; a < 2; ++a)
#pragma unroll
            for (int b = 0; b < 2; ++b)
#pragma unroll
                for (int m = 0; m < 4; ++m)
#pragma unroll
                    for (int n = 0; n < 2; ++n) acc[a][b][m][n] = (f32x4){0.f, 0.f, 0.f, 0.f};
        cur = nxt; cA = nA; cB = nB; ++ui;
        if constexpr (ALIGN_EPI) { if (wr == 1) PG8_BAR; }
    }
    PG8_WAIT_V(0);
    if constexpr (!ALIGN_EPI) { if (wr == 0) PG8_BAR; }
    PG8_BAR;
    if constexpr (Epi::AFTER_DRAIN) { E.fused(acc, cur, wr, wc, fr, fq, lds, wid, lane); S.done(cur); }
#undef PG8_SA
#undef PG8_SB
#undef PG8_STAGE
#undef PG8_LDA
#undef PG8_LDB
#undef PG8_MMA
#undef PG8_WAIT_V
#undef PG8_WAIT_L
#undef PG8_BAR
#undef PG8_SCHED
}
}
#ifndef PG8_SP2
#define PG8_SP2 true
#endif
#ifndef PG8_ALIGN
#define PG8_ALIGN true
#endif
constexpr size_t MiB = 1u << 20;
constexpr size_t WS_CTL = 0, CTL_ZERO_BYTES = 3 * MiB;
constexpr size_t OFF_MOD = 65536, OFF_C2 = 327680, OFF_RSS2 = 589824, OFF_HSS = 1 * MiB;
constexpr size_t WS_WIN = 3 * MiB, WS_WOUT = 7 * MiB, WS_WUP = 9 * MiB, WS_WDN = 20 * MiB, WS_SMALL = 26 * MiB;
constexpr size_t WS_H1 = 32 * MiB, WS_PROJ = 96 * MiB, WS_CAT = 32 * MiB, WS_XG2 = 96 * MiB, WS_UPC = 160 * MiB, WS_ACTC = 32 * MiB;
constexpr size_t WS_END = 248 * MiB;
constexpr int CW_BAR = 4096;
constexpr int RING_OFF = 0, RING_BYTES = 131072, LDSCTL_OFF = RING_BYTES, MISC_OFF = LDSCTL_OFF + 320, LDS_BYTES = 147456;
constexpr int NWAVES = 8;

#define GAS __attribute__((address_space(1)))
#define LAS __attribute__((address_space(3)))
typedef unsigned short bf16;
typedef unsigned v4u __attribute__((ext_vector_type(4)));
typedef unsigned v2u __attribute__((ext_vector_type(2)));
using pg8::f32x4;
#define LDS_WAIT() asm volatile("s_waitcnt lgkmcnt(0)" ::: "memory")
#define VM_WAIT() asm volatile("s_waitcnt vmcnt(0)" ::: "memory")
__device__ __forceinline__ unsigned f2bf(float f) { unsigned u = __builtin_bit_cast(unsigned, f); return (u + 0x7fffu + ((u >> 16) & 1u)) >> 16; }
__device__ __forceinline__ unsigned pk2(float lo, float hi) { return f2bf(lo) | (f2bf(hi) << 16); }
__device__ __forceinline__ float bflo(unsigned w) { return __builtin_bit_cast(float, w << 16); }
__device__ __forceinline__ float bfhi(unsigned w) { return __builtin_bit_cast(float, w & 0xffff0000u); }
__device__ __forceinline__ unsigned cvt_pk(float lo, float hi) { unsigned r; asm volatile("v_cvt_pk_bf16_f32 %0, %1, %2" : "=v"(r) : "v"(lo), "v"(hi)); return r; }
__device__ __forceinline__ int batch_of_row(int row) { return row < NPR ? (row >> 11) : 8 + ((row - NPR) >> 13); }
__device__ __forceinline__ int batch_of_tile(int pm) { return pm < 64 ? (pm >> 3) : 8 + ((pm - 64) >> 5); }
__device__ __forceinline__ int permcol(int n) { const int f = n < FF ? n : n - FF; return (f >> 7) * 256 + (f & 127) + (n < FF ? 0 : 128); }
__device__ __forceinline__ float wave_sum(float v) {
#pragma unroll
    for (int o = 1; o < 64; o <<= 1) v += __shfl_xor(v, o);
    return v;
}
__device__ __forceinline__ float silu_f(float x) { return x / (1.0f + __expf(-x)); }

#define XB_TMO      128
#define XB_XCNT(j)  (256  + 64 * (j))
#define XB_XSUB(j)  (1280 + 64 * (j))
#define XB_XGEN(j)  (2304 + 64 * (j))
#define XB_TOP      3328
#define XB_TOPGEN   3392
#define XCD_BAR_WORDS 3456
#define XB_SPIN_CAP (1u << 18)

__device__ __forceinline__ unsigned xb_ld(unsigned* p)              { return __hip_atomic_load(p, __ATOMIC_RELAXED, __HIP_MEMORY_SCOPE_AGENT); }
__device__ __forceinline__ unsigned xb_add(unsigned* p, unsigned v) { return __hip_atomic_fetch_add(p, v, __ATOMIC_RELAXED, __HIP_MEMORY_SCOPE_AGENT); }
__device__ __forceinline__ unsigned xb_xcc_id() { return (unsigned)__builtin_amdgcn_s_getreg((3 << 11) | 20) & 0xFu; }
#define XB_SPIN(cond, bar) do { unsigned _sp = 0; while (cond) { __builtin_amdgcn_s_sleep(1); \
    if ((++_sp & 255u) == 0u) { if (xb_ld(&(bar)[XB_TMO])) break; if (_sp > XB_SPIN_CAP) { atomicAdd(&(bar)[XB_TMO], 1u); break; } } } } while (0)

struct XcdBarrier {
    unsigned* bar; unsigned x;
    volatile LAS unsigned* st;
};

__device__ __forceinline__ XcdBarrier xcd_barrier_post(unsigned* bar, volatile LAS unsigned* st) {
    XcdBarrier b; b.bar = bar; b.x = xb_xcc_id(); b.st = st;
    if (threadIdx.x == 0) (void)xb_add(&bar[XB_XCNT(b.x)], 1u);
    return b;
}
__device__ __forceinline__ void xcd_barrier_complete(unsigned* bar, unsigned x, unsigned& nloc, unsigned& nx) {
    const unsigned G = gridDim.x * gridDim.y * gridDim.z;
    unsigned sum, cnt, mine, sp = 0u;
    for (;;) {
        sum = 0u; cnt = 0u; mine = 0u;
#pragma unroll
        for (unsigned j = 0; j < 16; ++j) { const unsigned c = xb_ld(&bar[XB_XCNT(j)]); sum += c; cnt += (c > 0u) ? 1u : 0u; mine = (j == x) ? c : mine; }
        if (sum == G) break;
        __builtin_amdgcn_s_sleep(1);
        if ((++sp & 255u) == 0u) { if (xb_ld(&bar[XB_TMO])) break; if (sp > XB_SPIN_CAP) { atomicAdd(&bar[XB_TMO], 1u); break; } }
    }
    nloc = mine > 0u ? mine : 1u; nx = cnt > 0u ? cnt : 1u;
}

__device__ __forceinline__ void xcd_barrier(const XcdBarrier& b) {
    asm volatile("s_waitcnt vmcnt(0)" ::: "memory");
    __syncthreads();
    if (threadIdx.x == 0) {
        unsigned* bar = b.bar;
        __builtin_amdgcn_s_waitcnt(0);
        unsigned nloc = b.st[0], nx = b.st[1];
        if (nloc == 0u) { xcd_barrier_complete(bar, b.x, nloc, nx); b.st[0] = nloc; b.st[1] = nx; }
        const unsigned old = xb_add(&bar[XB_XSUB(b.x)], 1u);
        const unsigned gen = old / nloc;
        if (old + 1u == (gen + 1u) * nloc) {
            __builtin_amdgcn_fence(__ATOMIC_RELEASE, "agent");
            asm volatile("s_waitcnt vmcnt(0)" ::: "memory");
            const unsigned og = xb_add(&bar[XB_TOP], 1u);
            const unsigned tg = og / nx;
            if (og + 1u == (tg + 1u) * nx) xb_add(&bar[XB_TOPGEN], 1u);
            else XB_SPIN(xb_ld(&bar[XB_TOPGEN]) == tg, bar);
            __builtin_amdgcn_fence(__ATOMIC_ACQUIRE, "agent");
            xb_add(&bar[XB_XGEN(b.x)], 1u);
            asm volatile("s_waitcnt vmcnt(0)" ::: "memory");
        } else {
            XB_SPIN(xb_ld(&bar[XB_XGEN(b.x)]) == gen, bar);
            __builtin_amdgcn_fence(__ATOMIC_ACQUIRE, "agent");
            asm volatile("s_waitcnt vmcnt(0)" ::: "memory");
        }
    }
    __syncthreads();
}
typedef const f32x4 (&AccRef)[2][2][4][2];
__device__ __forceinline__ float modv(const float* macc, const float* b_ada, int b, int j) { return macc[b * MODW + j] + b_ada[j]; }
__device__ __forceinline__ f32x4 modv4(const float* macc, const float* b_ada, int b, int j) { return *(const f32x4*)(macc + b * MODW + j) + *(const f32x4*)(b_ada + j); }

struct EpiProj {
    static constexpr bool PERM = true, AFTER_DRAIN = false;
    bf16* O;
    __device__ __forceinline__ void operator()(AccRef acc, const pg8::Unit& u, int wr, int wc, int fr, int fq) const {
        const int row0 = u.pm * 256 + wr * 64 + fr, col0 = u.pn * 256 + wc * 32 + 8 * fq;
#pragma unroll
        for (int ai = 0; ai < 2; ++ai)
#pragma unroll
            for (int m = 0; m < 4; ++m) { bf16* rowp = O + (size_t)(row0 + ai * 128 + m * 16) * INW + col0;
#pragma unroll
                for (int bj = 0; bj < 2; ++bj) { const f32x4 v0 = acc[ai][bj][m][0], v1 = acc[ai][bj][m][1];
                    v4u w; w.x = cvt_pk(v0[0], v0[1]); w.y = cvt_pk(v0[2], v0[3]); w.z = cvt_pk(v1[0], v1[1]); w.w = cvt_pk(v1[2], v1[3]);
                    *(v4u*)(rowp + bj * 128) = w; } }
    }
};
struct EpiOut {
    static constexpr bool PERM = false, AFTER_DRAIN = false;
    const float* xp; const float* xs; float* x1; bf16* xg2; float* rss2; const float* macc; const float* b_ada; const float* n2g;
    __device__ __forceinline__ void operator()(AccRef acc, const pg8::Unit& u, int wr, int wc, int fr, int fq) const {
        const int b = batch_of_tile(u.pm), row0 = u.pm * 256 + wr * 64 + fr, col0 = u.pn * 256 + wc * 32 + 4 * fq;
        float ss[2][4];
#pragma unroll
        for (int ai = 0; ai < 2; ++ai)
#pragma unroll
            for (int m = 0; m < 4; ++m) ss[ai][m] = 0.f;
#pragma unroll
        for (int bj = 0; bj < 2; ++bj)
#pragma unroll
            for (int n = 0; n < 2; ++n) {
                const int c = col0 + bj * 128 + n * 16;
                const f32x4 g1 = modv4(macc, b_ada, b, 2 * D + c), G2 = *(const f32x4*)(n2g + c) * (modv4(macc, b_ada, b, 4 * D + c) + 1.0f);
#pragma unroll
                for (int ai = 0; ai < 2; ++ai)
#pragma unroll
                    for (int m = 0; m < 4; ++m) {
                        const int row = row0 + ai * 128 + m * 16;
                        const float* xrow = row < NPR ? xp + (size_t)row * D : xs + (size_t)(row - NPR) * D;
                        const f32x4 v = *(const f32x4*)(xrow + c) + g1 * acc[ai][bj][m][n];
                        *(f32x4*)(x1 + (size_t)row * D + c) = v;
                        ss[ai][m] += (v[0] * v[0] + v[1] * v[1]) + (v[2] * v[2] + v[3] * v[3]);
                        const f32x4 g = v * G2; v2u w; w.x = cvt_pk(g[0], g[1]); w.y = cvt_pk(g[2], g[3]);
                        *(v2u*)(xg2 + (size_t)row * D + c) = w;
                    }
            }
#pragma unroll
        for (int ai = 0; ai < 2; ++ai)
#pragma unroll
            for (int m = 0; m < 4; ++m) { float s = ss[ai][m]; s += __shfl_xor(s, 16); s += __shfl_xor(s, 32);
                if (fq == 0) atomicAdd(rss2 + row0 + ai * 128 + m * 16, s); }
    }
};
struct EpiUp {
    static constexpr bool PERM = true, AFTER_DRAIN = false;
    bf16* O; const float* rss2; const float* c2; int rowbase;
    __device__ __forceinline__ void operator()(AccRef acc, const pg8::Unit& u, int wr, int wc, int fr, int fq) const {
        const int b = batch_of_row(rowbase + u.pm * 256), rl0 = u.pm * 256 + wr * 64 + fr, col0 = u.pn * 256 + wc * 32 + 8 * fq;
        f32x4 cv[2][2];
#pragma unroll
        for (int bj = 0; bj < 2; ++bj)
#pragma unroll
            for (int n = 0; n < 2; ++n) cv[bj][n] = *(const f32x4*)(c2 + b * FF2 + col0 + bj * 128 + 4 * n);
#pragma unroll
        for (int ai = 0; ai < 2; ++ai)
#pragma unroll
            for (int m = 0; m < 4; ++m) { const int rl = rl0 + ai * 128 + m * 16; const float rs = rsqrtf(rss2[rowbase + rl] * (1.0f / D) + EPS);
                bf16* rowp = O + (size_t)rl * FF2 + col0;
#pragma unroll
                for (int bj = 0; bj < 2; ++bj) { const f32x4 v0 = acc[ai][bj][m][0] * rs + cv[bj][0], v1 = acc[ai][bj][m][1] * rs + cv[bj][1];
                    v4u w; w.x = cvt_pk(v0[0], v0[1]); w.y = cvt_pk(v0[2], v0[3]); w.z = cvt_pk(v1[0], v1[1]); w.w = cvt_pk(v1[2], v1[3]);
                    *(v4u*)(rowp + bj * 128) = w; } }
    }
};
struct EpiDown {
    static constexpr bool PERM = false, AFTER_DRAIN = false;
    float* out; const float* macc; const float* b_ada; int rowbase;
    __device__ __forceinline__ void operator()(AccRef acc, const pg8::Unit& u, int wr, int wc, int fr, int fq) const {
        const int b = batch_of_row(rowbase + u.pm * 256), row0 = rowbase + u.pm * 256 + wr * 64 + fr, col0 = u.pn * 256 + wc * 32 + 4 * fq;
#pragma unroll
        for (int bj = 0; bj < 2; ++bj)
#pragma unroll
            for (int n = 0; n < 2; ++n) {
                const int c = col0 + bj * 128 + n * 16;
                const f32x4 g2 = modv4(macc, b_ada, b, 5 * D + c);
#pragma unroll
                for (int ai = 0; ai < 2; ++ai)
#pragma unroll
                    for (int m = 0; m < 4; ++m) { float* p = out + (size_t)(row0 + ai * 128 + m * 16) * D + c; *(f32x4*)p = *(const f32x4*)p + g2 * acc[ai][bj][m][n]; }
            }
    }
};

__device__ __forceinline__ void transpose_item(const float* W, int ldw, int k0, int n0, bf16* WT, int ldt, int drow0, int kd0, LAS float* scr, int lane) {
#pragma unroll 8
    for (int i = 0; i < 32; ++i) { const int kk = 2 * i + (lane >> 5); scr[kk * 33 + (lane & 31)] = W[(size_t)(k0 + kk) * ldw + n0 + (lane & 31)]; }
    LDS_WAIT(); asm volatile("" ::: "memory");
    const int c = lane & 7;
#pragma unroll
    for (int j = 0; j < 4; ++j) { const int n = (lane >> 3) + 8 * j; const LAS float* s = scr + (8 * c) * 33 + n;
        v4u o; o.x = pk2(s[0 * 33], s[1 * 33]); o.y = pk2(s[2 * 33], s[3 * 33]); o.z = pk2(s[4 * 33], s[5 * 33]); o.w = pk2(s[6 * 33], s[7 * 33]);
        *(v4u*)(WT + (size_t)(drow0 + n) * ldt + kd0 + 8 * c) = o; }
    LDS_WAIT(); asm volatile("" ::: "memory");
}
__device__ __forceinline__ void gemv10_item(const float* W, int ldw, int k0, int n, LAS float* sb, float* dst, int dstride, int dcol) {
    float acc[NBATCH];
#pragma unroll
    for (int b = 0; b < NBATCH; ++b) acc[b] = 0.f;
#pragma unroll 4
    for (int kk = 0; kk < 64; ++kk) {
        const float w = W[(size_t)(k0 + kk) * ldw + n];
        const f32x4 s0 = *(const LAS f32x4*)(sb + kk * 12), s1 = *(const LAS f32x4*)(sb + kk * 12 + 4), s2 = *(const LAS f32x4*)(sb + kk * 12 + 8);
        acc[0] += w * s0[0]; acc[1] += w * s0[1]; acc[2] += w * s0[2]; acc[3] += w * s0[3];
        acc[4] += w * s1[0]; acc[5] += w * s1[1]; acc[6] += w * s1[2]; acc[7] += w * s1[3];
        acc[8] += w * s2[0]; acc[9] += w * s2[1];
    }
#pragma unroll
    for (int b = 0; b < NBATCH; ++b) atomicAdd(dst + (size_t)b * dstride + dcol, acc[b]);
    LDS_WAIT(); asm volatile("" ::: "memory");
}

struct Args { const float* in[19]; float* out; unsigned char* ws; int ph_lo, ph_hi, row0, nrows; };
enum { I_XP = 0, I_XS, I_CP, I_CS, I_WADA, I_BADA, I_N1G, I_N2G, I_WIN, I_QNG, I_KNG, I_RPB, I_WPOOL, I_PSCALE, I_WOUT, I_WUP, I_CONVW, I_CONVB, I_WDOWN };
constexpr int N_PHASES = 8;

__global__ void __launch_bounds__(NWAVES * 64, 2) fwd(Args a) {
    extern __shared__ __attribute__((aligned(16))) unsigned char lds_raw[];
    LAS unsigned char* lds = (LAS unsigned char*)lds_raw;
    volatile LAS unsigned* MISC = (volatile LAS unsigned*)(lds + MISC_OFF);
    const int tid = threadIdx.x, lane = tid & 63, wave = __builtin_amdgcn_readfirstlane(tid >> 6);
    const int G = gridDim.x; const int bx = blockIdx.x; const int vcu = (G % 8 == 0) ? (bx % 8) * (G / 8) + bx / 8 : bx;
    const int gw = vcu * NWAVES + wave, NGW = G * NWAVES;
    unsigned char* ws = a.ws;
    unsigned* ctl = (unsigned*)(ws + WS_CTL);
    float* macc = (float*)(ws + OFF_MOD); float* c2acc = (float*)(ws + OFF_C2); float* rss2 = (float*)(ws + OFF_RSS2);
    bf16* WinT = (bf16*)(ws + WS_WIN); bf16* WoT = (bf16*)(ws + WS_WOUT); bf16* WupT = (bf16*)(ws + WS_WUP); bf16* WdT = (bf16*)(ws + WS_WDN);
    float* convp = (float*)(ws + WS_SMALL); float* cbp = convp + 3 * FF2;
    bf16* H1 = (bf16*)(ws + WS_H1); bf16* PROJ = (bf16*)(ws + WS_PROJ); bf16* CAT = (bf16*)(ws + WS_CAT); bf16* XG2 = (bf16*)(ws + WS_XG2);
    bf16* UPC = (bf16*)(ws + WS_UPC); bf16* ACTC = (bf16*)(ws + WS_ACTC);
    const float* b_ada = a.in[I_BADA];

    for (int u = tid; u < (LDS_BYTES - LDSCTL_OFF) / 4; u += NWAVES * 64) ((LAS unsigned*)(lds + LDSCTL_OFF))[u] = 0u;
    __syncthreads();
    const bool one_launch = (a.ph_lo == 0 && a.ph_hi == N_PHASES);
    XcdBarrier bar; bar.bar = ctl + CW_BAR; bar.x = 0; bar.st = nullptr;
    if (one_launch) bar = xcd_barrier_post(ctl + CW_BAR, MISC + 8);
#define IN(k) (a.ph_lo <= (k) && (k) < a.ph_hi)
#define SEAM(k) do { if (IN(k) && IN((k) + 1)) xcd_barrier(bar); } while (0)

    if (IN(0)) {
        LAS float* scr = (LAS float*)(lds + RING_OFF + wave * 16384);
        constexpr int I0 = 16 * 64, I1 = I0 + 8 * 32, I2 = I1 + 16 * 176, I3 = I2 + 44 * 32, I4 = I3 + 16 * 96, I5 = I4 + 4 * 16 * 16, I6 = I5 + 88;
        for (int it = gw; it < I6; it += NGW) {
            if (it < I0) { const int kb = it / 64, nb = it % 64; transpose_item(a.in[I_WIN], INW, 64 * kb, 32 * nb, WinT, D, 32 * nb, 64 * kb, scr, lane); }
            else if (it < I1) { const int r = it - I0, kb = r / 32, nb = r % 32; transpose_item(a.in[I_WOUT], D, 64 * kb, 32 * nb, WoT, D, 32 * nb, 64 * kb, scr, lane); }
            else if (it < I2) { const int r = it - I1, kb = r / 176, nb = r % 176; transpose_item(a.in[I_WUP], FF2, 64 * kb, 32 * nb, WupT, D, permcol(32 * nb), 64 * kb, scr, lane); }
            else if (it < I3) { const int r = it - I2, kb = r / 32, nb = r % 32; transpose_item(a.in[I_WDOWN], D, 64 * kb, 32 * nb, WdT, FF, 32 * nb, 64 * kb, scr, lane); }
            else if (it < I4) {
                const int r = it - I3, kc = r / 96, nc = r % 96, k = 64 * kc + lane;
#pragma unroll
                for (int b = 0; b < NBATCH; ++b) { const float c = b < 8 ? a.in[I_CP][b * D + k] : a.in[I_CS][(b - 8) * D + k]; scr[lane * 12 + b] = silu_f(c); }
                LDS_WAIT(); asm volatile("" ::: "memory");
                gemv10_item(a.in[I_WADA], MODW, 64 * kc, 64 * nc + lane, scr, macc, MODW, 64 * nc + lane);
            }
            else if (it < I5) {
                const int r = it - I4, g = r / 256, cb = (r / 16) % 16, nb = r % 16, n = 64 * nb + lane;
                float acc[8];
#pragma unroll
                for (int i = 0; i < 8; ++i) acc[i] = 0.f;
                const float* wp = a.in[I_WPOOL] + (size_t)(g * 128 + 8 * cb) * 128;
                for (int d = 0; d < 128; ++d) {
                    const float wo = a.in[I_WOUT][(size_t)(ATTW + g * 128 + d) * D + n] * a.in[I_PSCALE][g * 128 + d];
#pragma unroll
                    for (int i = 0; i < 8; ++i) acc[i] += wp[i * 128 + d] * wo;
                }
                v4u o; o.x = pk2(acc[0], acc[1]); o.y = pk2(acc[2], acc[3]); o.z = pk2(acc[4], acc[5]); o.w = pk2(acc[6], acc[7]);
                *(v4u*)(WoT + (size_t)n * D + ATTW + g * 128 + 8 * cb) = o;
            }
            else { const int n = 64 * (it - I5) + lane, pc = permcol(n);
                convp[pc] = a.in[I_CONVW][n]; convp[FF2 + pc] = a.in[I_CONVW][FF2 + n]; convp[2 * FF2 + pc] = a.in[I_CONVW][2 * FF2 + n]; cbp[pc] = a.in[I_CONVB][n]; }
        }
    }
    SEAM(0);

    if (IN(1)) {
        LAS float* scr = (LAS float*)(lds + RING_OFF + wave * 16384);
        for (int it = gw; it < 16 * 88; it += NGW) {
            const int kc = it / 88, nc = it % 88, k = 64 * kc + lane;
#pragma unroll
            for (int b = 0; b < NBATCH; ++b) scr[lane * 12 + b] = modv(macc, b_ada, b, 3 * D + k);
            LDS_WAIT(); asm volatile("" ::: "memory");
            gemv10_item(a.in[I_WUP], FF2, 64 * kc, 64 * nc + lane, scr, c2acc, FF2, permcol(64 * nc) + lane);
        }
        for (int r0 = gw * 16; r0 < MT; r0 += NGW * 16) {
            const int b = batch_of_row(r0);
            f32x4 Gv[4], Sv[4];
#pragma unroll
            for (int j = 0; j < 4; ++j) { const int c = 4 * lane + 256 * j; Gv[j] = *(const f32x4*)(a.in[I_N1G] + c) * (modv4(macc, b_ada, b, D + c) + 1.0f); Sv[j] = modv4(macc, b_ada, b, c); }
            for (int rr = 0; rr < 16; ++rr) {
                const int row = r0 + rr; const float* xrow = row < NPR ? a.in[I_XP] + (size_t)row * D : a.in[I_XS] + (size_t)(row - NPR) * D;
                f32x4 v[4]; float s = 0.f;
#pragma unroll
                for (int j = 0; j < 4; ++j) { v[j] = *(const f32x4*)(xrow + 4 * lane + 256 * j); s += (v[j][0] * v[j][0] + v[j][1] * v[j][1]) + (v[j][2] * v[j][2] + v[j][3] * v[j][3]); }
                const float rstd = rsqrtf(wave_sum(s) * (1.0f / D) + EPS);
#pragma unroll
                for (int j = 0; j < 4; ++j) { const f32x4 h = v[j] * rstd * Gv[j] + Sv[j]; v2u w; w.x = pk2(h[0], h[1]); w.y = pk2(h[2], h[3]);
                    *(v2u*)(H1 + (size_t)row * D + 4 * lane + 256 * j) = w; }
            }
        }
    }
    SEAM(1);

    if (IN(2)) {
        pg8::Gemm g{H1, WinT, MT, INW, D}; pg8::StaticOrder S; S.init(MT, INW, G, bx);
        EpiProj E{PROJ};
        pg8::gemm_phase<EpiProj, pg8::StaticOrder, PG8_ALIGN, PG8_SP2>(lds + RING_OFF, g, S, E);
    }
    SEAM(2);

    if (IN(3)) {
        for (int u = vcu; u < 512; u += G) {
            int b, r, rows;
            if (u < 256) { b = u >> 5; r = u & 31; rows = 32; } else { b = 8 + ((u - 256) >> 7); r = (u - 256) & 127; rows = 128; }
            const int base = b < 8 ? b * 2048 : NPR + (b - 8) * 8192, T = rows * 64;
            {
                const int h = wave, qc = lane;
                const int rs = min(max(r - 4, 0), rows - 8), cs = min(max(qc - 8, 0), 48);
                const int qrow = base + r * 64 + qc;
                float q[64], o[64];
                { const v4u* qp = (const v4u*)(PROJ + (size_t)qrow * INW + h * 64); float ssq = 0.f;
#pragma unroll
                  for (int i = 0; i < 8; ++i) { const v4u w = qp[i];
                      q[8 * i + 0] = bflo(w.x); q[8 * i + 1] = bfhi(w.x); q[8 * i + 2] = bflo(w.y); q[8 * i + 3] = bfhi(w.y);
                      q[8 * i + 4] = bflo(w.z); q[8 * i + 5] = bfhi(w.z); q[8 * i + 6] = bflo(w.w); q[8 * i + 7] = bfhi(w.w); }
#pragma unroll
                  for (int d = 0; d < 64; ++d) ssq += q[d] * q[d];
                  const float rq = rsqrtf(ssq * (1.0f / 64.0f) + EPS) * 0.125f;
#pragma unroll
                  for (int d = 0; d < 64; ++d) { q[d] *= rq * a.in[I_QNG][d] * a.in[I_KNG][d]; o[d] = 0.f; } }
                float mx = -1e30f, l = 0.f;
                const float* rp = a.in[I_RPB] + h * 465;
#pragma unroll 1
                for (int i = 0; i < 8; ++i) {
                    const int dr = rs + i - r + 7;
#pragma unroll 1
                    for (int j = 0; j < 16; ++j) {
                        const int tk = base + (rs + i) * 64 + cs + j, dc = cs + j - qc + 15;
                        const v4u* kp = (const v4u*)(PROJ + (size_t)tk * INW + ATTW + h * 64);
                        float ssk = 0.f, dot = 0.f;
#pragma unroll
                        for (int c = 0; c < 8; ++c) { const v4u w = kp[c]; float k0;
                            k0 = bflo(w.x); ssk += k0 * k0; dot += k0 * q[8 * c + 0]; k0 = bfhi(w.x); ssk += k0 * k0; dot += k0 * q[8 * c + 1];
                            k0 = bflo(w.y); ssk += k0 * k0; dot += k0 * q[8 * c + 2]; k0 = bfhi(w.y); ssk += k0 * k0; dot += k0 * q[8 * c + 3];
                            k0 = bflo(w.z); ssk += k0 * k0; dot += k0 * q[8 * c + 4]; k0 = bfhi(w.z); ssk += k0 * k0; dot += k0 * q[8 * c + 5];
                            k0 = bflo(w.w); ssk += k0 * k0; dot += k0 * q[8 * c + 6]; k0 = bfhi(w.w); ssk += k0 * k0; dot += k0 * q[8 * c + 7]; }
                        const float s = dot * rsqrtf(ssk * (1.0f / 64.0f) + EPS) + rp[dr * 31 + dc];
                        const float mn = fmaxf(mx, s), al = __expf(mx - mn), p = __expf(s - mn);
                        l = l * al + p; mx = mn;
                        const v4u* vp = (const v4u*)(PROJ + (size_t)tk * INW + 2 * ATTW + h * 64);
#pragma unroll
                        for (int c = 0; c < 8; ++c) { const v4u w = vp[c];
                            o[8 * c + 0] = o[8 * c + 0] * al + p * bflo(w.x); o[8 * c + 1] = o[8 * c + 1] * al + p * bfhi(w.x);
                            o[8 * c + 2] = o[8 * c + 2] * al + p * bflo(w.y); o[8 * c + 3] = o[8 * c + 3] * al + p * bfhi(w.y);
                            o[8 * c + 4] = o[8 * c + 4] * al + p * bflo(w.z); o[8 * c + 5] = o[8 * c + 5] * al + p * bfhi(w.z);
                            o[8 * c + 6] = o[8 * c + 6] * al + p * bflo(w.w); o[8 * c + 7] = o[8 * c + 7] * al + p * bfhi(w.w); }
                    }
                }
                const float il = 1.0f / l;
                v4u* op = (v4u*)(CAT + (size_t)qrow * D + h * 64);
#pragma unroll
                for (int c = 0; c < 8; ++c) { v4u w; w.x = pk2(o[8 * c + 0] * il, o[8 * c + 1] * il); w.y = pk2(o[8 * c + 2] * il, o[8 * c + 3] * il);
                    w.z = pk2(o[8 * c + 4] * il, o[8 * c + 5] * il); w.w = pk2(o[8 * c + 6] * il, o[8 * c + 7] * il); op[c] = w; }
            }
#pragma unroll 1
            for (int k = 0; k < 8; ++k) {
                const int idx = tid + 512 * k, tl = idx >> 6, ch = idx & 63, g = ch >> 4, hw = 1 << g;
                const int t = r * 64 + tl, lo = max(t - hw, 0), hi = min(t + hw, T);
                float sacc[8];
#pragma unroll
                for (int i = 0; i < 8; ++i) sacc[i] = 0.f;
                for (int s = lo; s < hi; ++s) { const v4u w = *(const v4u*)(PROJ + (size_t)(base + s) * INW + 3 * ATTW + 8 * ch);
                    sacc[0] += bflo(w.x); sacc[1] += bfhi(w.x); sacc[2] += bflo(w.y); sacc[3] += bfhi(w.y); sacc[4] += bflo(w.z); sacc[5] += bfhi(w.z); sacc[6] += bflo(w.w); sacc[7] += bfhi(w.w); }
                const float ic = 1.0f / (float)(hi - lo);
                const v4u w = *(const v4u*)(PROJ + (size_t)(base + t) * INW + 3 * ATTW + 8 * ch);
                v4u ow; ow.x = pk2(sacc[0] * ic - bflo(w.x), sacc[1] * ic - bfhi(w.x)); ow.y = pk2(sacc[2] * ic - bflo(w.y), sacc[3] * ic - bfhi(w.y));
                ow.z = pk2(sacc[4] * ic - bflo(w.z), sacc[5] * ic - bfhi(w.z)); ow.w = pk2(sacc[6] * ic - bflo(w.w), sacc[7] * ic - bfhi(w.w));
                *(v4u*)(CAT + (size_t)(base + t) * D + ATTW + 8 * ch) = ow;
            }
        }
    }
    SEAM(3);

    if (IN(4)) {
        pg8::Gemm g{CAT, WoT, MT, D, D}; pg8::StaticOrder S; S.init(MT, D, G, bx);
        EpiOut E{a.in[I_XP], a.in[I_XS], a.out, XG2, rss2, macc, b_ada, a.in[I_N2G]};
        pg8::gemm_phase<EpiOut, pg8::StaticOrder, PG8_ALIGN, PG8_SP2>(lds + RING_OFF, g, S, E);
    }
    SEAM(4);

    if (IN(5)) {
        pg8::Gemm g{XG2 + (size_t)a.row0 * D, WupT, a.nrows, FF2, D}; pg8::StaticOrder S; S.init(a.nrows, FF2, G, bx);
        EpiUp E{UPC, rss2, c2acc, a.row0};
        pg8::gemm_phase<EpiUp, pg8::StaticOrder, PG8_ALIGN, PG8_SP2>(lds + RING_OFF, g, S, E);
    }
    SEAM(5);

    if (IN(6)) {
        const int total = a.nrows * (FF / 8);
        for (int idx = vcu * 512 + tid; idx < total; idx += G * 512) {
            const int rl = idx / (FF / 8), f = 8 * (idx % (FF / 8)), gcol = (f >> 7) * 256 + (f & 127);
            const int row = a.row0 + rl, b = batch_of_row(row), t = row < NPR ? (row & 2047) : ((row - NPR) & 8191), T = b < 8 ? 2048 : 8192;
            const bool hm = t > 0, hp = t < T - 1;
            float res[2][8];
#pragma unroll
            for (int part = 0; part < 2; ++part) {
                const int col = gcol + 128 * part; const bf16* up = UPC + (size_t)rl * FF2 + col;
                const v4u z = {0u, 0u, 0u, 0u};
                const v4u u0 = *(const v4u*)up, um = hm ? *(const v4u*)(up - FF2) : z, upn = hp ? *(const v4u*)(up + FF2) : z;
                const f32x4 w0a = *(const f32x4*)(convp + col), w0b = *(const f32x4*)(convp + col + 4), w1a = *(const f32x4*)(convp + FF2 + col), w1b = *(const f32x4*)(convp + FF2 + col + 4);
                const f32x4 w2a = *(const f32x4*)(convp + 2 * FF2 + col), w2b = *(const f32x4*)(convp + 2 * FF2 + col + 4), cba = *(const f32x4*)(cbp + col), cbb = *(const f32x4*)(cbp + col + 4);
                res[part][0] = w0a[0] * bflo(um.x) + w1a[0] * bflo(u0.x) + w2a[0] * bflo(upn.x) + cba[0];
                res[part][1] = w0a[1] * bfhi(um.x) + w1a[1] * bfhi(u0.x) + w2a[1] * bfhi(upn.x) + cba[1];
                res[part][2] = w0a[2] * bflo(um.y) + w1a[2] * bflo(u0.y) + w2a[2] * bflo(upn.y) + cba[2];
                res[part][3] = w0a[3] * bfhi(um.y) + w1a[3] * bfhi(u0.y) + w2a[3] * bfhi(upn.y) + cba[3];
                res[part][4] = w0b[0] * bflo(um.z) + w1b[0] * bflo(u0.z) + w2b[0] * bflo(upn.z) + cbb[0];
                res[part][5] = w0b[1] * bfhi(um.z) + w1b[1] * bfhi(u0.z) + w2b[1] * bfhi(upn.z) + cbb[1];
                res[part][6] = w0b[2] * bflo(um.w) + w1b[2] * bflo(u0.w) + w2b[2] * bflo(upn.w) + cbb[2];
                res[part][7] = w0b[3] * bfhi(um.w) + w1b[3] * bfhi(u0.w) + w2b[3] * bfhi(upn.w) + cbb[3];
            }
            v4u ow; ow.x = pk2(silu_f(res[0][0]) * res[1][0], silu_f(res[0][1]) * res[1][1]); ow.y = pk2(silu_f(res[0][2]) * res[1][2], silu_f(res[0][3]) * res[1][3]);
            ow.z = pk2(silu_f(res[0][4]) * res[1][4], silu_f(res[0][5]) * res[1][5]); ow.w = pk2(silu_f(res[0][6]) * res[1][6], silu_f(res[0][7]) * res[1][7]);
            *(v4u*)(ACTC + (size_t)rl * FF + f) = ow;
        }
    }
    SEAM(6);

    if (IN(7)) {
        pg8::Gemm g{ACTC, WdT, a.nrows, D, FF}; pg8::StaticOrder S; S.init(a.nrows, D, G, bx);
        EpiDown E{a.out, macc, b_ada, a.row0};
        pg8::gemm_phase<EpiDown, pg8::StaticOrder, PG8_ALIGN, PG8_SP2>(lds + RING_OFF, g, S, E);
    }
#undef IN
#undef SEAM
}

extern "C" void kernel_launch(void* const* d_in, const int* in_sizes, int n_in, void* d_out, int out_size, void* d_ws, size_t ws_size, hipStream_t stream) {
    static int grid = 0;
    if (grid == 0) {
        if (n_in != 19 || out_size != MT * D || ws_size < WS_END) { fprintf(stderr, "kernel_launch: unexpected shapes (n_in %d, out %d, ws %zu)\n", n_in, out_size, ws_size); grid = -1; return; }
        int dev = 0, cus = 0;
        if (hipGetDevice(&dev) != hipSuccess || hipDeviceGetAttribute(&cus, hipDeviceAttributeMultiprocessorCount, dev) != hipSuccess) { grid = -1; return; }
        if (hipFuncSetAttribute((const void*)fwd, hipFuncAttributeMaxDynamicSharedMemorySize, LDS_BYTES) != hipSuccess) { fprintf(stderr, "kernel_launch: hipFuncSetAttribute failed\n"); grid = -1; return; }
        (void)hipGetLastError();
        grid = cus;
    }
    if (grid < 0) return;
    if (hipMemsetAsync((char*)d_ws + WS_CTL, 0, CTL_ZERO_BYTES, stream) != hipSuccess) return;
    Args a{};
    for (int i = 0; i < 19; ++i) a.in[i] = (const float*)d_in[i];
    a.out = (float*)d_out; a.ws = (unsigned char*)d_ws;
    for (int ph = 0; ph < 5; ++ph) { a.ph_lo = ph; a.ph_hi = ph + 1; a.row0 = 0; a.nrows = 0; hipLaunchKernelGGL(fwd, dim3(grid), dim3(NWAVES * 64), LDS_BYTES, stream, a); }
    const int c_row0[6] = {0, 4096, 8192, 12288, 16384, 24576}, c_rows[6] = {4096, 4096, 4096, 4096, 8192, 8192};
    for (int c = 0; c < 6; ++c)
        for (int ph = 5; ph < 8; ++ph) { a.ph_lo = ph; a.ph_hi = ph + 1; a.row0 = c_row0[c]; a.nrows = c_rows[c]; hipLaunchKernelGGL(fwd, dim3(grid), dim3(NWAVES * 64), LDS_BYTES, stream, a); }
}
```

```cpp
#include <hip/hip_runtime.h>
#include <cstdio>
#include <cstdint>

constexpr int D = 1024, MT = 32768, NPR = 16384, INW = 2048, ATTW = 512, HD = 64, NH = 8, FF = 2816, FF2 = 5632, NBATCH = 10, MODW = 6144;
constexpr float EPS = 1e-6f;

namespace pg8 {
#define PG8_LAS __attribute__((address_space(3)))
typedef unsigned short bf16_t;
typedef short bf16x8 __attribute__((ext_vector_type(8)));
typedef float f32x4 __attribute__((ext_vector_type(4)));
typedef unsigned u32x4 __attribute__((ext_vector_type(4)));
constexpr int BM = 256, BK = 64, HALF = 128, HTB = HALF * BK * 2  , STAGE_BYTES = 8 * HTB, NXCD = 8, WGM = 8;

__host__ __device__ __forceinline__ int lds_byte(int r, int c) { const int st = (r >> 4) * 2 + (c >> 5), rr = r & 15, cc = c & 31, ob = rr * 64 + cc * 2; return st * 1024 + (ob ^ (((ob >> 9) & 1) << 5)); }
__host__ __device__ __forceinline__ void stage_rc(int b, int& R, int& C) { const int st = b / 1024, sb = b % 1024, swz = sb ^ (((sb >> 9) & 1) << 5); R = (st >> 1) * 16 + swz / 64; C = (st & 1) * 32 + (swz % 64) / 2; }
__host__ __device__ __forceinline__ int perm32(int rho) { const int n = rho >> 4, i = rho & 15; return 8 * (i >> 2) + 4 * n + (i & 3); }

struct Unit { int pm, pn; };
struct Gemm { const bf16_t* A; const bf16_t* Bt; int M, N, K; };

struct StaticOrder {
    int nM, nN, nwg, G, c;
    __host__ __device__ void init(int M, int N, int G_, int c_) { nM = M / BM; nN = N / BM; nwg = nM * nN; G = G_; c = c_; }
    __host__ __device__ bool next(int i, Unit& u) const {
        const long L = (long)i * G + c; if (L >= nwg) return false;
        int wgid = (int)L; { const int q = nwg / NXCD, r = nwg % NXCD, xcd = wgid % NXCD, off = wgid / NXCD; wgid = (xcd < r ? xcd * (q + 1) : r * (q + 1) + (xcd - r) * q) + off; }
        const int nig = WGM * nN, gid = wgid / nig, fm = gid * WGM, gsz = (nM - fm) < WGM ? (nM - fm) : WGM;
        u.pm = fm + ((wgid % nig) % gsz); u.pn = (wgid % nig) / gsz; return true;
    }
    __device__ __forceinline__ void a_ready(const Unit&) const {}
    __device__ __forceinline__ void done(const Unit&) const {}
};

template <class Epi, class Sched, bool ALIGN_EPI = false, bool SP2 = false>
__device__ __forceinline__ void gemm_phase(PG8_LAS unsigned char* lds, const Gemm g, const Sched& S, const Epi& E) {
    const int tid = threadIdx.x, wid = __builtin_amdgcn_readfirstlane(tid >> 6), lane = tid & 63, wr = wid >> 2, wc = wid & 3, fr = lane & 15, fq = lane >> 4;
    const int K = g.K, nt = K / BK;
    unsigned voffA[2], voffB[2];
#pragma unroll
    for (int i = 0; i < 2; ++i) { int R, C; stage_rc(tid * 16 + i * 8192, R, C); const int Rb = Epi::PERM ? ((R & ~31) + perm32(R & 31)) : R;
        voffA[i] = (unsigned)(R * K + C) * 2u; voffB[i] = (unsigned)(Rb * K + C) * 2u; }
    const size_t kstep = (size_t)(BK * 2);
    const size_t hstep = (size_t)HALF * K * 2;
    const size_t tstep = 2 * hstep;
    const unsigned ldsw = (unsigned)wid * 1024u;
    const int aoff = lds_byte(wr * 64 + fr, fq * 8), boff = lds_byte(wc * 32 + fr, fq * 8);
#define PG8_SA(b, h) (((b) * 2 + (h)) * HTB)
#define PG8_SB(b, h) ((4 + (b) * 2 + (h)) * HTB)
#define PG8_STAGE(bufoff, gbase, voff) do { _Pragma("unroll") for (int _i = 0; _i < 2; ++_i) \
        __builtin_amdgcn_global_load_lds((const unsigned*)((const char*)(gbase) + (voff)[_i]), (PG8_LAS unsigned*)(lds + (bufoff) + ldsw + _i * 8192), 16, 0, 0); } while (0)
#define PG8_LDA(dst, b, h) do { _Pragma("unroll") for (int m = 0; m < 4; ++m) _Pragma("unroll") for (int k = 0; k < 2; ++k) dst[m][k] = *(const PG8_LAS bf16x8*)(lds + PG8_SA(b, h) + aoff + m * 2048 + k * 1024); } while (0)
#define PG8_LDB(dst, b, h) do { _Pragma("unroll") for (int n = 0; n < 2; ++n) _Pragma("unroll") for (int k = 0; k < 2; ++k) dst[n][k] = *(const PG8_LAS bf16x8*)(lds + PG8_SB(b, h) + boff + n * 2048 + k * 1024); } while (0)
#define PG8_MMA(ai, bj, At, Bt) do { __builtin_amdgcn_s_setprio(1); _Pragma("unroll") for (int m = 0; m < 4; ++m) _Pragma("unroll") for (int n = 0; n < 2; ++n) _Pragma("unroll") for (int k = 0; k < 2; ++k) \
        acc[ai][bj][m][n] = __builtin_amdgcn_mfma_f32_16x16x32_bf16(Bt[n][k], At[m][k], acc[ai][bj][m][n], 0, 0, 0); __builtin_amdgcn_s_setprio(0); } while (0)
#define PG8_WAIT_V(n) asm volatile("s_waitcnt vmcnt(" #n ")" ::: "memory")
#define PG8_WAIT_L(n) asm volatile("s_waitcnt lgkmcnt(" #n ")" ::: "memory")
#define PG8_BAR __builtin_amdgcn_s_barrier()
#define PG8_SCHED __builtin_amdgcn_sched_barrier(0)
    Unit cur, nxt; int ui = 0;
    if (!S.next(0, cur)) return;
    f32x4 acc[2][2][4][2];
#pragma unroll
    for (int a = 0; a < 2; ++a)
#pragma unroll
        for (int b = 0; b < 2; ++b)
#pragma unroll
            for (int m = 0; m < 4; ++m)
#pragma unroll
                for (int n = 0; n < 2; ++n) acc[a][b][m][n] = (f32x4){0.f, 0.f, 0.f, 0.f};
    bf16x8 At[4][2], B0[2][2], B1[2][2];
    const char* cA = (const char*)g.A + (size_t)cur.pm * tstep; const char* cB = (const char*)g.Bt + (size_t)cur.pn * tstep;
    S.a_ready(cur);
    if constexpr (SP2) {
        PG8_STAGE(PG8_SB(0, 0), cB, voffB); PG8_STAGE(PG8_SB(0, 1), cB + hstep, voffB); PG8_STAGE(PG8_SA(0, 0), cA, voffA); PG8_STAGE(PG8_SA(0, 1), cA + hstep, voffA);
        if (wr == 1) PG8_BAR;
        PG8_WAIT_V(2); PG8_BAR;
        PG8_STAGE(PG8_SB(1, 0), cB + kstep, voffB); PG8_STAGE(PG8_SA(1, 0), cA + kstep, voffA); PG8_STAGE(PG8_SB(1, 1), cB + hstep + kstep, voffB);
        PG8_WAIT_V(6); PG8_BAR;
    } else {
        PG8_STAGE(PG8_SB(0, 0), cB, voffB); PG8_STAGE(PG8_SA(0, 0), cA, voffA); PG8_STAGE(PG8_SB(0, 1), cB + hstep, voffB); PG8_STAGE(PG8_SA(0, 1), cA + hstep, voffA);
        if (wr == 1) PG8_BAR;
        PG8_WAIT_V(4); PG8_BAR;
        PG8_STAGE(PG8_SB(1, 0), cB + kstep, voffB); PG8_STAGE(PG8_SA(1, 0), cA + kstep, voffA); PG8_STAGE(PG8_SB(1, 1), cB + hstep + kstep, voffB);
        PG8_WAIT_V(6); PG8_BAR;
    }
    for (;;) {
        const bool has_next = S.next(ui + 1, nxt);
        const char* nA = has_next ? (const char*)g.A + (size_t)nxt.pm * tstep : cA; const char* nB = has_next ? (const char*)g.Bt + (size_t)nxt.pn * tstep : cB;
        for (int t = 0; t < nt; t += 2) {
            const bool last = (t == nt - 2);
            const char* a1 = cA + (size_t)(t + 1) * kstep;
            const char* a2 = last ? nA : cA + (size_t)(t + 2) * kstep; const char* b2 = last ? nB : cB + (size_t)(t + 2) * kstep;
            const char* a3 = a2 + kstep; const char* b3 = b2 + kstep;
            if (last && has_next) S.a_ready(nxt);
            if constexpr (SP2) {
            PG8_LDB(B0, 0, 0); PG8_LDB(B1, 0, 1); PG8_SCHED; PG8_LDA(At, 0, 0); PG8_STAGE(PG8_SA(1, 1), a1 + hstep, voffA);
            PG8_WAIT_V(8); PG8_WAIT_L(0); PG8_BAR; PG8_MMA(0, 0, At, B0); PG8_MMA(0, 1, At, B1); PG8_BAR; PG8_SCHED;
            PG8_LDA(At, 0, 1); PG8_STAGE(PG8_SB(0, 0), b2, voffB); PG8_STAGE(PG8_SB(0, 1), b2 + hstep, voffB); PG8_STAGE(PG8_SA(0, 0), a2, voffA);
            PG8_WAIT_V(8); PG8_WAIT_L(0); PG8_BAR; PG8_MMA(1, 0, At, B0); PG8_MMA(1, 1, At, B1); PG8_BAR; PG8_SCHED;
            PG8_LDB(B0, 1, 0); PG8_LDB(B1, 1, 1); PG8_SCHED; PG8_LDA(At, 1, 0); PG8_STAGE(PG8_SA(0, 1), a2 + hstep, voffA);
            PG8_WAIT_V(8); PG8_WAIT_L(0); PG8_BAR; PG8_MMA(0, 0, At, B0); PG8_MMA(0, 1, At, B1); PG8_BAR; PG8_SCHED;
            PG8_LDA(At, 1, 1); PG8_STAGE(PG8_SB(1, 0), b3, voffB); PG8_STAGE(PG8_SB(1, 1), b3 + hstep, voffB); PG8_STAGE(PG8_SA(1, 0), a3, voffA);
            PG8_WAIT_V(8); PG8_WAIT_L(0); PG8_BAR; PG8_MMA(1, 0, At, B0); PG8_MMA(1, 1, At, B1); PG8_BAR; PG8_SCHED;
            } else {
            PG8_LDB(B0, 0, 0); PG8_SCHED; PG8_LDA(At, 0, 0); PG8_STAGE(PG8_SA(1, 1), a1 + hstep, voffA);
            PG8_WAIT_L(8); PG8_BAR; PG8_WAIT_L(0); PG8_MMA(0, 0, At, B0); PG8_BAR; PG8_SCHED;
            PG8_LDB(B1, 0, 1); PG8_STAGE(PG8_SB(0, 0), b2, voffB);
            PG8_BAR; PG8_WAIT_L(0); PG8_MMA(0, 1, At, B1); PG8_BAR;
            PG8_LDA(At, 0, 1); PG8_STAGE(PG8_SA(0, 0), a2, voffA);
            PG8_BAR; PG8_WAIT_L(0); PG8_MMA(1, 0, At, B0); PG8_BAR; PG8_SCHED;
            PG8_STAGE(PG8_SB(0, 1), b2 + hstep, voffB);
            PG8_WAIT_V(6); PG8_BAR; PG8_MMA(1, 1, At, B1); PG8_BAR;
            PG8_LDB(B0, 1, 0); PG8_SCHED; PG8_LDA(At, 1, 0); PG8_STAGE(PG8_SA(0, 1), a2 + hstep, voffA);
            PG8_WAIT_L(8); PG8_BAR; PG8_WAIT_L(0); PG8_MMA(0, 0, At, B0); PG8_BAR; PG8_SCHED;
            PG8_LDB(B1, 1, 1); PG8_STAGE(PG8_SB(1, 0), b3, voffB);
            PG8_BAR; PG8_WAIT_L(0); PG8_MMA(0, 1, At, B1); PG8_BAR;
            PG8_LDA(At, 1, 1); PG8_STAGE(PG8_SA(1, 0), a3, voffA);
            PG8_BAR; PG8_WAIT_L(0); PG8_MMA(1, 0, At, B0); PG8_BAR; PG8_SCHED;
            PG8_STAGE(PG8_SB(1, 1), b3 + hstep, voffB);
            PG8_WAIT_V(6); PG8_BAR; PG8_MMA(1, 1, At, B1); PG8_BAR;
            }
        }
        if constexpr (ALIGN_EPI) { if (wr == 0) PG8_BAR; }
        if constexpr (!Epi::AFTER_DRAIN) { E(acc, cur, wr, wc, fr, fq); S.done(cur); }
        if (!has_next) break;
#pragma unroll
        for (int a = 0; a < 2; ++a)
#pragma unroll
            for (int b = 0; b < 2; ++b)
#pragma unroll
                for (int m = 0; m < 4; ++m)
#pragma unroll
                    for (int n = 0; n < 2; ++n) acc[a][b][m][n] = (f32x4){0.f, 0.f, 0.f, 0.f};
        cur = nxt; cA = nA; cB = nB; ++ui;
        if constexpr (ALIGN_EPI) { if (wr == 1) PG8_BAR; }
    }
    PG8_WAIT_V(0);
    if constexpr (!ALIGN_EPI) { if (wr == 0) PG8_BAR; }
    PG8_BAR;
    if constexpr (Epi::AFTER_DRAIN) { E.fused(acc, cur, wr, wc, fr, fq, lds, wid, lane); S.done(cur); }
#undef PG8_SA
#undef PG8_SB
#undef PG8_STAGE
#undef PG8_LDA
#undef PG8_LDB
#undef PG8_MMA
#undef PG8_WAIT_V
#undef PG8_WAIT_L
#undef PG8_BAR
#undef PG8_SCHED
}
}
#ifndef PG8_SP2
#define PG8_SP2 true
#endif
#ifndef PG8_ALIGN
#define PG8_ALIGN true
#endif
constexpr size_t MiB = 1u << 20;
constexpr size_t WS_CTL = 0, CTL_ZERO_BYTES = 3 * MiB;
constexpr size_t OFF_MOD = 65536, OFF_C2 = 327680, OFF_RSS2 = 589824, OFF_HSS = 1 * MiB;
constexpr size_t WS_WIN = 3 * MiB, WS_WOUT = 7 * MiB, WS_WUP = 9 * MiB, WS_WDN = 20 * MiB, WS_SMALL = 26 * MiB;
constexpr size_t WS_H1 = 32 * MiB, WS_PROJ = 96 * MiB, WS_CAT = 32 * MiB, WS_XG2 = 96 * MiB, WS_UPC = 160 * MiB, WS_ACTC = 32 * MiB;
constexpr size_t WS_END = 248 * MiB;
constexpr int CW_BAR = 4096;
constexpr int RING_OFF = 0, RING_BYTES = 131072, LDSCTL_OFF = RING_BYTES, MISC_OFF = LDSCTL_OFF + 320, LDS_BYTES = 147456;
constexpr int NWAVES = 8;

#define GAS __attribute__((address_space(1)))
#define LAS __attribute__((address_space(3)))
typedef unsigned short bf16;
typedef unsigned v4u __attribute__((ext_vector_type(4)));
typedef unsigned v2u __attribute__((ext_vector_type(2)));
using pg8::f32x4;
#define LDS_WAIT() asm volatile("s_waitcnt lgkmcnt(0)" ::: "memory")
#define VM_WAIT() asm volatile("s_waitcnt vmcnt(0)" ::: "memory")
__device__ __forceinline__ unsigned f2bf(float f) { unsigned u = __builtin_bit_cast(unsigned, f); return (u + 0x7fffu + ((u >> 16) & 1u)) >> 16; }
__device__ __forceinline__ unsigned pk2(float lo, float hi) { return f2bf(lo) | (f2bf(hi) << 16); }
__device__ __forceinline__ float bflo(unsigned w) { return __builtin_bit_cast(float, w << 16); }
__device__ __forceinline__ float bfhi(unsigned w) { return __builtin_bit_cast(float, w & 0xffff0000u); }
__device__ __forceinline__ unsigned cvt_pk(float lo, float hi) { unsigned r; asm volatile("v_cvt_pk_bf16_f32 %0, %1, %2" : "=v"(r) : "v"(lo), "v"(hi)); return r; }
__device__ __forceinline__ int batch_of_row(int row) { return row < NPR ? (row >> 11) : 8 + ((row - NPR) >> 13); }
__device__ __forceinline__ int batch_of_tile(int pm) { return pm < 64 ? (pm >> 3) : 8 + ((pm - 64) >> 5); }
__device__ __forceinline__ int permcol(int n) { const int f = n < FF ? n : n - FF; return (f >> 7) * 256 + (f & 127) + (n < FF ? 0 : 128); }
__device__ __forceinline__ float wave_sum(float v) {
#pragma unroll
    for (int o = 1; o < 64; o <<= 1) v += __shfl_xor(v, o);
    return v;
}
__device__ __forceinline__ float silu_f(float x) { return x / (1.0f + __expf(-x)); }

#define XB_TMO      128
#define XB_XCNT(j)  (256  + 64 * (j))
#define XB_XSUB(j)  (1280 + 64 * (j))
#define XB_XGEN(j)  (2304 + 64 * (j))
#define XB_TOP      3328
#define XB_TOPGEN   3392
#define XCD_BAR_WORDS 3456
#define XB_SPIN_CAP (1u << 18)

__device__ __forceinline__ unsigned xb_ld(unsigned* p)              { return __hip_atomic_load(p, __ATOMIC_RELAXED, __HIP_MEMORY_SCOPE_AGENT); }
__device__ __forceinline__ unsigned xb_add(unsigned* p, unsigned v) { return __hip_atomic_fetch_add(p, v, __ATOMIC_RELAXED, __HIP_MEMORY_SCOPE_AGENT); }
__device__ __forceinline__ unsigned xb_xcc_id() { return (unsigned)__builtin_amdgcn_s_getreg((3 << 11) | 20) & 0xFu; }
#define XB_SPIN(cond, bar) do { unsigned _sp = 0; while (cond) { __builtin_amdgcn_s_sleep(1); \
    if ((++_sp & 255u) == 0u) { if (xb_ld(&(bar)[XB_TMO])) break; if (_sp > XB_SPIN_CAP) { atomicAdd(&(bar)[XB_TMO], 1u); break; } } } } while (0)

struct XcdBarrier {
    unsigned* bar; unsigned x;
    volatile LAS unsigned* st;
};

__device__ __forceinline__ XcdBarrier xcd_barrier_post(unsigned* bar, volatile LAS unsigned* st) {
    XcdBarrier b; b.bar = bar; b.x = xb_xcc_id(); b.st = st;
    if (threadIdx.x == 0) (void)xb_add(&bar[XB_XCNT(b.x)], 1u);
    return b;
}
__device__ __forceinline__ void xcd_barrier_complete(unsigned* bar, unsigned x, unsigned& nloc, unsigned& nx) {
    const unsigned G = gridDim.x * gridDim.y * gridDim.z;
    unsigned sum, cnt, mine, sp = 0u;
    for (;;) {
        sum = 0u; cnt = 0u; mine = 0u;
#pragma unroll
        for (unsigned j = 0; j < 16; ++j) { const unsigned c = xb_ld(&bar[XB_XCNT(j)]); sum += c; cnt += (c > 0u) ? 1u : 0u; mine = (j == x) ? c : mine; }
        if (sum == G) break;
        __builtin_amdgcn_s_sleep(1);
        if ((++sp & 255u) == 0u) { if (xb_ld(&bar[XB_TMO])) break; if (sp > XB_SPIN_CAP) { atomicAdd(&bar[XB_TMO], 1u); break; } }
    }
    nloc = mine > 0u ? mine : 1u; nx = cnt > 0u ? cnt : 1u;
}

__device__ __forceinline__ void xcd_barrier(const XcdBarrier& b) {
    asm volatile("s_waitcnt vmcnt(0)" ::: "memory");
    __syncthreads();
    if (threadIdx.x == 0) {
        unsigned* bar = b.bar;
        __builtin_amdgcn_s_waitcnt(0);
        unsigned nloc = b.st[0], nx = b.st[1];
        if (nloc == 0u) { xcd_barrier_complete(bar, b.x, nloc, nx); b.st[0] = nloc; b.st[1] = nx; }
        const unsigned old = xb_add(&bar[XB_XSUB(b.x)], 1u);
        const unsigned gen = old / nloc;
        if (old + 1u == (gen + 1u) * nloc) {
            __builtin_amdgcn_fence(__ATOMIC_RELEASE, "agent");
            asm volatile("s_waitcnt vmcnt(0)" ::: "memory");
            const unsigned og = xb_add(&bar[XB_TOP], 1u);
            const unsigned tg = og / nx;
            if (og + 1u == (tg + 1u) * nx) xb_add(&bar[XB_TOPGEN], 1u);
            else XB_SPIN(xb_ld(&bar[XB_TOPGEN]) == tg, bar);
            __builtin_amdgcn_fence(__ATOMIC_ACQUIRE, "agent");
            xb_add(&bar[XB_XGEN(b.x)], 1u);
            asm volatile("s_waitcnt vmcnt(0)" ::: "memory");
        } else {
            XB_SPIN(xb_ld(&bar[XB_XGEN(b.x)]) == gen, bar);
            __builtin_amdgcn_fence(__ATOMIC_ACQUIRE, "agent");
            asm volatile("s_waitcnt vmcnt(0)" ::: "memory");
        }
    }
    __syncthreads();
}
typedef const f32x4 (&AccRef)[2][2][4][2];
__device__ __forceinline__ float modv(const float* macc, const float* b_ada, int b, int j) { return macc[b * MODW + j] + b_ada[j]; }
__device__ __forceinline__ f32x4 modv4(const float* macc, const float* b_ada, int b, int j) { return *(const f32x4*)(macc + b * MODW + j) + *(const f32x4*)(b_ada + j); }

struct EpiProj {
    static constexpr bool PERM = true, AFTER_DRAIN = false;
    bf16* O;
    __device__ __forceinline__ void operator()(AccRef acc, const pg8::Unit& u, int wr, int wc, int fr, int fq) const {
        const int row0 = u.pm * 256 + wr * 64 + fr, col0 = u.pn * 256 + wc * 32 + 8 * fq;
#pragma unroll
        for (int ai = 0; ai < 2; ++ai)
#pragma unroll
            for (int m = 0; m < 4; ++m) { bf16* rowp = O + (size_t)(row0 + ai * 128 + m * 16) * INW + col0;
#pragma unroll
                for (int bj = 0; bj < 2; ++bj) { const f32x4 v0 = acc[ai][bj][m][0], v1 = acc[ai][bj][m][1];
                    v4u w; w.x = cvt_pk(v0[0], v0[1]); w.y = cvt_pk(v0[2], v0[3]); w.z = cvt_pk(v1[0], v1[1]); w.w = cvt_pk(v1[2], v1[3]);
                    *(v4u*)(rowp + bj * 128) = w; } }
    }
};
struct EpiOut {
    static constexpr bool PERM = false, AFTER_DRAIN = false;
    const float* xp; const float* xs; float* x1; bf16* xg2; float* rss2; const float* macc; const float* b_ada; const float* n2g;
    __device__ __forceinline__ void operator()(AccRef acc, const pg8::Unit& u, int wr, int wc, int fr, int fq) const {
        const int b = batch_of_tile(u.pm), row0 = u.pm * 256 + wr * 64 + fr, col0 = u.pn * 256 + wc * 32 + 4 * fq;
        float ss[2][4];
#pragma unroll
        for (int ai = 0; ai < 2; ++ai)
#pragma unroll
            for (int m = 0; m < 4; ++m) ss[ai][m] = 0.f;
#pragma unroll
        for (int bj = 0; bj < 2; ++bj)
#pragma unroll
            for (int n = 0; n < 2; ++n) {
                const int c = col0 + bj * 128 + n * 16;
                const f32x4 g1 = modv4(macc, b_ada, b, 2 * D + c), G2 = *(const f32x4*)(n2g + c) * (modv4(macc, b_ada, b, 4 * D + c) + 1.0f);
#pragma unroll
                for (int ai = 0; ai < 2; ++ai)
#pragma unroll
                    for (int m = 0; m < 4; ++m) {
                        const int row = row0 + ai * 128 + m * 16;
                        const float* xrow = row < NPR ? xp + (size_t)row * D : xs + (size_t)(row - NPR) * D;
                        const f32x4 v = *(const f32x4*)(xrow + c) + g1 * acc[ai][bj][m][n];
                        *(f32x4*)(x1 + (size_t)row * D + c) = v;
                        ss[ai][m] += (v[0] * v[0] + v[1] * v[1]) + (v[2] * v[2] + v[3] * v[3]);
                        const f32x4 g = v * G2; v2u w; w.x = cvt_pk(g[0], g[1]); w.y = cvt_pk(g[2], g[3]);
                        *(v2u*)(xg2 + (size_t)row * D + c) = w;
                    }
            }
#pragma unroll
        for (int ai = 0; ai < 2; ++ai)
#pragma unroll
            for (int m = 0; m < 4; ++m) { float s = ss[ai][m]; s += __shfl_xor(s, 16); s += __shfl_xor(s, 32);
                if (fq == 0) atomicAdd(rss2 + row0 + ai * 128 + m * 16, s); }
    }
};
struct EpiUp {
    static constexpr bool PERM = true, AFTER_DRAIN = false;
    bf16* O; const float* rss2; const float* c2; int rowbase;
    __device__ __forceinline__ void operator()(AccRef acc, const pg8::Unit& u, int wr, int wc, int fr, int fq) const {
        const int b = batch_of_row(rowbase + u.pm * 256), rl0 = u.pm * 256 + wr * 64 + fr, col0 = u.pn * 256 + wc * 32 + 8 * fq;
        f32x4 cv[2][2];
#pragma unroll
        for (int bj = 0; bj < 2; ++bj)
#pragma unroll
            for (int n = 0; n < 2; ++n) cv[bj][n] = *(const f32x4*)(c2 + b * FF2 + col0 + bj * 128 + 4 * n);
#pragma unroll
        for (int ai = 0; ai < 2; ++ai)
#pragma unroll
            for (int m = 0; m < 4; ++m) { const int rl = rl0 + ai * 128 + m * 16; const float rs = rsqrtf(rss2[rowbase + rl] * (1.0f / D) + EPS);
                bf16* rowp = O + (size_t)rl * FF2 + col0;
#pragma unroll
                for (int bj = 0; bj < 2; ++bj) { const f32x4 v0 = acc[ai][bj][m][0] * rs + cv[bj][0], v1 = acc[ai][bj][m][1] * rs + cv[bj][1];
                    v4u w; w.x = cvt_pk(v0[0], v0[1]); w.y = cvt_pk(v0[2], v0[3]); w.z = cvt_pk(v1[0], v1[1]); w.w = cvt_pk(v1[2], v1[3]);
                    *(v4u*)(rowp + bj * 128) = w; } }
    }
};
struct EpiDown {
    static constexpr bool PERM = false, AFTER_DRAIN = false;
    float* out; const float* macc; const float* b_ada; int rowbase;
    __device__ __forceinline__ void operator()(AccRef acc, const pg8::Unit& u, int wr, int wc, int fr, int fq) const {
        const int b = batch_of_row(rowbase + u.pm * 256), row0 = rowbase + u.pm * 256 + wr * 64 + fr, col0 = u.pn * 256 + wc * 32 + 4 * fq;
#pragma unroll
        for (int bj = 0; bj < 2; ++bj)
#pragma unroll
            for (int n = 0; n < 2; ++n) {
                const int c = col0 + bj * 128 + n * 16;
                const f32x4 g2 = modv4(macc, b_ada, b, 5 * D + c);
#pragma unroll
                for (int ai = 0; ai < 2; ++ai)
#pragma unroll
                    for (int m = 0; m < 4; ++m) { float* p = out + (size_t)(row0 + ai * 128 + m * 16) * D + c; *(f32x4*)p = *(const f32x4*)p + g2 * acc[ai][bj][m][n]; }
            }
    }
};

__device__ __forceinline__ void transpose_item(const float* W, int ldw, int k0, int n0, bf16* WT, int ldt, int drow0, int kd0, LAS float* scr, int lane) {
#pragma unroll 8
    for (int i = 0; i < 32; ++i) { const int kk = 2 * i + (lane >> 5); scr[kk * 33 + (lane & 31)] = W[(size_t)(k0 + kk) * ldw + n0 + (lane & 31)]; }
    LDS_WAIT(); asm volatile("" ::: "memory");
    const int c = lane & 7;
#pragma unroll
    for (int j = 0; j < 4; ++j) { const int n = (lane >> 3) + 8 * j; const LAS float* s = scr + (8 * c) * 33 + n;
        v4u o; o.x = pk2(s[0 * 33], s[1 * 33]); o.y = pk2(s[2 * 33], s[3 * 33]); o.z = pk2(s[4 * 33], s[5 * 33]); o.w = pk2(s[6 * 33], s[7 * 33]);
        *(v4u*)(WT + (size_t)(drow0 + n) * ldt + kd0 + 8 * c) = o; }
    LDS_WAIT(); asm volatile("" ::: "memory");
}
__device__ __forceinline__ void gemv10_item(const float* W, int ldw, int k0, int n, LAS float* sb, float* dst, int dstride, int dcol) {
    float acc[NBATCH];
#pragma unroll
    for (int b = 0; b < NBATCH; ++b) acc[b] = 0.f;
#pragma unroll 4
    for (int kk = 0; kk < 64; ++kk) {
        const float w = W[(size_t)(k0 + kk) * ldw + n];
        const f32x4 s0 = *(const LAS f32x4*)(sb + kk * 12), s1 = *(const LAS f32x4*)(sb + kk * 12 + 4), s2 = *(const LAS f32x4*)(sb + kk * 12 + 8);
        acc[0] += w * s0[0]; acc[1] += w * s0[1]; acc[2] += w * s0[2]; acc[3] += w * s0[3];
        acc[4] += w * s1[0]; acc[5] += w * s1[1]; acc[6] += w * s1[2]; acc[7] += w * s1[3];
        acc[8] += w * s2[0]; acc[9] += w * s2[1];
    }
#pragma unroll
    for (int b = 0; b < NBATCH; ++b) atomicAdd(dst + (size_t)b * dstride + dcol, acc[b]);
    LDS_WAIT(); asm volatile("" ::: "memory");
}

struct Args { const float* in[19]; float* out; unsigned char* ws; int ph_lo, ph_hi, row0, nrows; };
enum { I_XP = 0, I_XS, I_CP, I_CS, I_WADA, I_BADA, I_N1G, I_N2G, I_WIN, I_QNG, I_KNG, I_RPB, I_WPOOL, I_PSCALE, I_WOUT, I_WUP, I_CONVW, I_CONVB, I_WDOWN };
constexpr int N_PHASES = 8;
#ifndef MK_ONE_LAUNCH
#define MK_ONE_LAUNCH 1
#endif

__global__ void __launch_bounds__(NWAVES * 64, 2) fwd(Args a) {
    extern __shared__ __attribute__((aligned(16))) unsigned char lds_raw[];
    LAS unsigned char* lds = (LAS unsigned char*)lds_raw;
    volatile LAS unsigned* MISC = (volatile LAS unsigned*)(lds + MISC_OFF);
    const int tid = threadIdx.x, lane = tid & 63, wave = __builtin_amdgcn_readfirstlane(tid >> 6);
    const int G = gridDim.x; const int bx = blockIdx.x; const int vcu = (G % 8 == 0) ? (bx % 8) * (G / 8) + bx / 8 : bx;
    const int gw = vcu * NWAVES + wave, NGW = G * NWAVES;
    unsigned char* ws = a.ws;
    unsigned* ctl = (unsigned*)(ws + WS_CTL);
    float* macc = (float*)(ws + OFF_MOD); float* c2acc = (float*)(ws + OFF_C2); float* rss2 = (float*)(ws + OFF_RSS2);
    bf16* WinT = (bf16*)(ws + WS_WIN); bf16* WoT = (bf16*)(ws + WS_WOUT); bf16* WupT = (bf16*)(ws + WS_WUP); bf16* WdT = (bf16*)(ws + WS_WDN);
    float* convp = (float*)(ws + WS_SMALL); float* cbp = convp + 3 * FF2;
    bf16* H1 = (bf16*)(ws + WS_H1); bf16* PROJ = (bf16*)(ws + WS_PROJ); bf16* CAT = (bf16*)(ws + WS_CAT); bf16* XG2 = (bf16*)(ws + WS_XG2);
    bf16* UPC = (bf16*)(ws + WS_UPC); bf16* ACTC = (bf16*)(ws + WS_ACTC);
    const float* b_ada = a.in[I_BADA];

    for (int u = tid; u < (LDS_BYTES - LDSCTL_OFF) / 4; u += NWAVES * 64) ((LAS unsigned*)(lds + LDSCTL_OFF))[u] = 0u;
    __syncthreads();
    const bool one_launch = (a.ph_lo == 0 && a.ph_hi == N_PHASES);
    XcdBarrier bar; bar.bar = ctl + CW_BAR; bar.x = 0; bar.st = nullptr;
    if (one_launch) bar = xcd_barrier_post(ctl + CW_BAR, MISC + 8);
#define IN(k) (a.ph_lo <= (k) && (k) < a.ph_hi)
#define SEAM(k) do { if (IN(k) && IN((k) + 1)) xcd_barrier(bar); } while (0)

    if (IN(0)) {
        LAS float* scr = (LAS float*)(lds + RING_OFF + wave * 16384);
        constexpr int I0 = 16 * 64, I1 = I0 + 8 * 32, I2 = I1 + 16 * 176, I3 = I2 + 44 * 32, I4 = I3 + 16 * 96, I5 = I4 + 4 * 16 * 16, I6 = I5 + 88;
        for (int it = gw; it < I6; it += NGW) {
            if (it < I0) { const int kb = it / 64, nb = it % 64; transpose_item(a.in[I_WIN], INW, 64 * kb, 32 * nb, WinT, D, 32 * nb, 64 * kb, scr, lane); }
            else if (it < I1) { const int r = it - I0, kb = r / 32, nb = r % 32; transpose_item(a.in[I_WOUT], D, 64 * kb, 32 * nb, WoT, D, 32 * nb, 64 * kb, scr, lane); }
            else if (it < I2) { const int r = it - I1, kb = r / 176, nb = r % 176; transpose_item(a.in[I_WUP], FF2, 64 * kb, 32 * nb, WupT, D, permcol(32 * nb), 64 * kb, scr, lane); }
            else if (it < I3) { const int r = it - I2, kb = r / 32, nb = r % 32; transpose_item(a.in[I_WDOWN], D, 64 * kb, 32 * nb, WdT, FF, 32 * nb, 64 * kb, scr, lane); }
            else if (it < I4) {
                const int r = it - I3, kc = r / 96, nc = r % 96, k = 64 * kc + lane;
#pragma unroll
                for (int b = 0; b < NBATCH; ++b) { const float c = b < 8 ? a.in[I_CP][b * D + k] : a.in[I_CS][(b - 8) * D + k]; scr[lane * 12 + b] = silu_f(c); }
                LDS_WAIT(); asm volatile("" ::: "memory");
                gemv10_item(a.in[I_WADA], MODW, 64 * kc, 64 * nc + lane, scr, macc, MODW, 64 * nc + lane);
            }
            else if (it < I5) {
                const int r = it - I4, g = r / 256, cb = (r / 16) % 16, nb = r % 16, n = 64 * nb + lane;
                float acc[8];
#pragma unroll
                for (int i = 0; i < 8; ++i) acc[i] = 0.f;
                const float* wp = a.in[I_WPOOL] + (size_t)(g * 128 + 8 * cb) * 128;
                for (int d = 0; d < 128; ++d) {
                    const float wo = a.in[I_WOUT][(size_t)(ATTW + g * 128 + d) * D + n] * a.in[I_PSCALE][g * 128 + d];
#pragma unroll
                    for (int i = 0; i < 8; ++i) acc[i] += wp[i * 128 + d] * wo;
                }
                v4u o; o.x = pk2(acc[0], acc[1]); o.y = pk2(acc[2], acc[3]); o.z = pk2(acc[4], acc[5]); o.w = pk2(acc[6], acc[7]);
                *(v4u*)(WoT + (size_t)n * D + ATTW + g * 128 + 8 * cb) = o;
            }
            else { const int n = 64 * (it - I5) + lane, pc = permcol(n);
                convp[pc] = a.in[I_CONVW][n]; convp[FF2 + pc] = a.in[I_CONVW][FF2 + n]; convp[2 * FF2 + pc] = a.in[I_CONVW][2 * FF2 + n]; cbp[pc] = a.in[I_CONVB][n]; }
        }
    }
    SEAM(0);

    if (IN(1)) {
        LAS float* scr = (LAS float*)(lds + RING_OFF + wave * 16384);
        for (int it = gw; it < 16 * 88; it += NGW) {
            const int kc = it / 88, nc = it % 88, k = 64 * kc + lane;
#pragma unroll
            for (int b = 0; b < NBATCH; ++b) scr[lane * 12 + b] = modv(macc, b_ada, b, 3 * D + k);
            LDS_WAIT(); asm volatile("" ::: "memory");
            gemv10_item(a.in[I_WUP], FF2, 64 * kc, 64 * nc + lane, scr, c2acc, FF2, permcol(64 * nc) + lane);
        }
        for (int r0 = gw * 16; r0 < MT; r0 += NGW * 16) {
            const int b = batch_of_row(r0);
            f32x4 Gv[4], Sv[4];
#pragma unroll
            for (int j = 0; j < 4; ++j) { const int c = 4 * lane + 256 * j; Gv[j] = *(const f32x4*)(a.in[I_N1G] + c) * (modv4(macc, b_ada, b, D + c) + 1.0f); Sv[j] = modv4(macc, b_ada, b, c); }
            for (int rr = 0; rr < 16; ++rr) {
                const int row = r0 + rr; const float* xrow = row < NPR ? a.in[I_XP] + (size_t)row * D : a.in[I_XS] + (size_t)(row - NPR) * D;
                f32x4 v[4]; float s = 0.f;
#pragma unroll
                for (int j = 0; j < 4; ++j) { v[j] = *(const f32x4*)(xrow + 4 * lane + 256 * j); s += (v[j][0] * v[j][0] + v[j][1] * v[j][1]) + (v[j][2] * v[j][2] + v[j][3] * v[j][3]); }
                const float rstd = rsqrtf(wave_sum(s) * (1.0f / D) + EPS);
#pragma unroll
                for (int j = 0; j < 4; ++j) { const f32x4 h = v[j] * rstd * Gv[j] + Sv[j]; v2u w; w.x = pk2(h[0], h[1]); w.y = pk2(h[2], h[3]);
                    *(v2u*)(H1 + (size_t)row * D + 4 * lane + 256 * j) = w; }
            }
        }
    }
    SEAM(1);

    if (IN(2)) {
        pg8::Gemm g{H1, WinT, MT, INW, D}; pg8::StaticOrder S; S.init(MT, INW, G, bx);
        EpiProj E{PROJ};
        pg8::gemm_phase<EpiProj, pg8::StaticOrder, PG8_ALIGN, PG8_SP2>(lds + RING_OFF, g, S, E);
    }
    SEAM(2);

    if (IN(3)) {
        for (int u = vcu; u < 512; u += G) {
            int b, r, rows;
            if (u < 256) { b = u >> 5; r = u & 31; rows = 32; } else { b = 8 + ((u - 256) >> 7); r = (u - 256) & 127; rows = 128; }
            const int base = b < 8 ? b * 2048 : NPR + (b - 8) * 8192, T = rows * 64;
            {
                const int h = wave, qc = lane;
                const int rs = min(max(r - 4, 0), rows - 8), cs = min(max(qc - 8, 0), 48);
                const int qrow = base + r * 64 + qc;
                float q[64], o[64];
                { const v4u* qp = (const v4u*)(PROJ + (size_t)qrow * INW + h * 64); float ssq = 0.f;
#pragma unroll
                  for (int i = 0; i < 8; ++i) { const v4u w = qp[i];
                      q[8 * i + 0] = bflo(w.x); q[8 * i + 1] = bfhi(w.x); q[8 * i + 2] = bflo(w.y); q[8 * i + 3] = bfhi(w.y);
                      q[8 * i + 4] = bflo(w.z); q[8 * i + 5] = bfhi(w.z); q[8 * i + 6] = bflo(w.w); q[8 * i + 7] = bfhi(w.w); }
#pragma unroll
                  for (int d = 0; d < 64; ++d) ssq += q[d] * q[d];
                  const float rq = rsqrtf(ssq * (1.0f / 64.0f) + EPS) * 0.125f;
#pragma unroll
                  for (int d = 0; d < 64; ++d) { q[d] *= rq * a.in[I_QNG][d] * a.in[I_KNG][d]; o[d] = 0.f; } }
                float mx = -1e30f, l = 0.f;
                const float* rp = a.in[I_RPB] + h * 465;
#pragma unroll 1
                for (int i = 0; i < 8; ++i) {
                    const int dr = rs + i - r + 7;
#pragma unroll 1
                    for (int j = 0; j < 16; ++j) {
                        const int tk = base + (rs + i) * 64 + cs + j, dc = cs + j - qc + 15;
                        const v4u* kp = (const v4u*)(PROJ + (size_t)tk * INW + ATTW + h * 64);
                        float ssk = 0.f, dot = 0.f;
#pragma unroll
                        for (int c = 0; c < 8; ++c) { const v4u w = kp[c]; float k0;
                            k0 = bflo(w.x); ssk += k0 * k0; dot += k0 * q[8 * c + 0]; k0 = bfhi(w.x); ssk += k0 * k0; dot += k0 * q[8 * c + 1];
                            k0 = bflo(w.y); ssk += k0 * k0; dot += k0 * q[8 * c + 2]; k0 = bfhi(w.y); ssk += k0 * k0; dot += k0 * q[8 * c + 3];
                            k0 = bflo(w.z); ssk += k0 * k0; dot += k0 * q[8 * c + 4]; k0 = bfhi(w.z); ssk += k0 * k0; dot += k0 * q[8 * c + 5];
                            k0 = bflo(w.w); ssk += k0 * k0; dot += k0 * q[8 * c + 6]; k0 = bfhi(w.w); ssk += k0 * k0; dot += k0 * q[8 * c + 7]; }
                        const float s = dot * rsqrtf(ssk * (1.0f / 64.0f) + EPS) + rp[dr * 31 + dc];
                        const float mn = fmaxf(mx, s), al = __expf(mx - mn), p = __expf(s - mn);
                        l = l * al + p; mx = mn;
                        const v4u* vp = (const v4u*)(PROJ + (size_t)tk * INW + 2 * ATTW + h * 64);
#pragma unroll
                        for (int c = 0; c < 8; ++c) { const v4u w = vp[c];
                            o[8 * c + 0] = o[8 * c + 0] * al + p * bflo(w.x); o[8 * c + 1] = o[8 * c + 1] * al + p * bfhi(w.x);
                            o[8 * c + 2] = o[8 * c + 2] * al + p * bflo(w.y); o[8 * c + 3] = o[8 * c + 3] * al + p * bfhi(w.y);
                            o[8 * c + 4] = o[8 * c + 4] * al + p * bflo(w.z); o[8 * c + 5] = o[8 * c + 5] * al + p * bfhi(w.z);
                            o[8 * c + 6] = o[8 * c + 6] * al + p * bflo(w.w); o[8 * c + 7] = o[8 * c + 7] * al + p * bfhi(w.w); }
                    }
                }
                const float il = 1.0f / l;
                v4u* op = (v4u*)(CAT + (size_t)qrow * D + h * 64);
#pragma unroll
                for (int c = 0; c < 8; ++c) { v4u w; w.x = pk2(o[8 * c + 0] * il, o[8 * c + 1] * il); w.y = pk2(o[8 * c + 2] * il, o[8 * c + 3] * il);
                    w.z = pk2(o[8 * c + 4] * il, o[8 * c + 5] * il); w.w = pk2(o[8 * c + 6] * il, o[8 * c + 7] * il); op[c] = w; }
            }
#pragma unroll 1
            for (int k = 0; k < 8; ++k) {
                const int idx = tid + 512 * k, tl = idx >> 6, ch = idx & 63, g = ch >> 4, hw = 1 << g;
                const int t = r * 64 + tl, lo = max(t - hw, 0), hi = min(t + hw, T);
                float sacc[8];
#pragma unroll
                for (int i = 0; i < 8; ++i) sacc[i] = 0.f;
                for (int s = lo; s < hi; ++s) { const v4u w = *(const v4u*)(PROJ + (size_t)(base + s) * INW + 3 * ATTW + 8 * ch);
                    sacc[0] += bflo(w.x); sacc[1] += bfhi(w.x); sacc[2] += bflo(w.y); sacc[3] += bfhi(w.y); sacc[4] += bflo(w.z); sacc[5] += bfhi(w.z); sacc[6] += bflo(w.w); sacc[7] += bfhi(w.w); }
                const float ic = 1.0f / (float)(hi - lo);
                const v4u w = *(const v4u*)(PROJ + (size_t)(base + t) * INW + 3 * ATTW + 8 * ch);
                v4u ow; ow.x = pk2(sacc[0] * ic - bflo(w.x), sacc[1] * ic - bfhi(w.x)); ow.y = pk2(sacc[2] * ic - bflo(w.y), sacc[3] * ic - bfhi(w.y));
                ow.z = pk2(sacc[4] * ic - bflo(w.z), sacc[5] * ic - bfhi(w.z)); ow.w = pk2(sacc[6] * ic - bflo(w.w), sacc[7] * ic - bfhi(w.w));
                *(v4u*)(CAT + (size_t)(base + t) * D + ATTW + 8 * ch) = ow;
            }
        }
    }
    SEAM(3);

    if (IN(4)) {
        pg8::Gemm g{CAT, WoT, MT, D, D}; pg8::StaticOrder S; S.init(MT, D, G, bx);
        EpiOut E{a.in[I_XP], a.in[I_XS], a.out, XG2, rss2, macc, b_ada, a.in[I_N2G]};
        pg8::gemm_phase<EpiOut, pg8::StaticOrder, PG8_ALIGN, PG8_SP2>(lds + RING_OFF, g, S, E);
    }
    SEAM(4);

    const int nchunks = one_launch ? 6 : 1;
#pragma unroll 1
    for (int ck = 0; ck < nchunks; ++ck) {
    const int row0 = one_launch ? (ck < 4 ? 4096 * ck : NPR + 8192 * (ck - 4)) : a.row0, nrows = one_launch ? (ck < 4 ? 4096 : 8192) : a.nrows;
    if (IN(5)) {
        pg8::Gemm g{XG2 + (size_t)row0 * D, WupT, nrows, FF2, D}; pg8::StaticOrder S; S.init(nrows, FF2, G, bx);
        EpiUp E{UPC, rss2, c2acc, row0};
        pg8::gemm_phase<EpiUp, pg8::StaticOrder, PG8_ALIGN, PG8_SP2>(lds + RING_OFF, g, S, E);
    }
    SEAM(5);

    if (IN(6)) {
        const int total = nrows * (FF / 8);
        for (int idx = vcu * 512 + tid; idx < total; idx += G * 512) {
            const int rl = idx / (FF / 8), f = 8 * (idx % (FF / 8)), gcol = (f >> 7) * 256 + (f & 127);
            const int row = row0 + rl, b = batch_of_row(row), t = row < NPR ? (row & 2047) : ((row - NPR) & 8191), T = b < 8 ? 2048 : 8192;
            const bool hm = t > 0, hp = t < T - 1;
            float res[2][8];
#pragma unroll
            for (int part = 0; part < 2; ++part) {
                const int col = gcol + 128 * part; const bf16* up = UPC + (size_t)rl * FF2 + col;
                const v4u z = {0u, 0u, 0u, 0u};
                const v4u u0 = *(const v4u*)up, um = hm ? *(const v4u*)(up - FF2) : z, upn = hp ? *(const v4u*)(up + FF2) : z;
                const f32x4 w0a = *(const f32x4*)(convp + col), w0b = *(const f32x4*)(convp + col + 4), w1a = *(const f32x4*)(convp + FF2 + col), w1b = *(const f32x4*)(convp + FF2 + col + 4);
                const f32x4 w2a = *(const f32x4*)(convp + 2 * FF2 + col), w2b = *(const f32x4*)(convp + 2 * FF2 + col + 4), cba = *(const f32x4*)(cbp + col), cbb = *(const f32x4*)(cbp + col + 4);
                res[part][0] = w0a[0] * bflo(um.x) + w1a[0] * bflo(u0.x) + w2a[0] * bflo(upn.x) + cba[0];
                res[part][1] = w0a[1] * bfhi(um.x) + w1a[1] * bfhi(u0.x) + w2a[1] * bfhi(upn.x) + cba[1];
                res[part][2] = w0a[2] * bflo(um.y) + w1a[2] * bflo(u0.y) + w2a[2] * bflo(upn.y) + cba[2];
                res[part][3] = w0a[3] * bfhi(um.y) + w1a[3] * bfhi(u0.y) + w2a[3] * bfhi(upn.y) + cba[3];
                res[part][4] = w0b[0] * bflo(um.z) + w1b[0] * bflo(u0.z) + w2b[0] * bflo(upn.z) + cbb[0];
                res[part][5] = w0b[1] * bfhi(um.z) + w1b[1] * bfhi(u0.z) + w2b[1] * bfhi(upn.z) + cbb[1];
                res[part][6] = w0b[2] * bflo(um.w) + w1b[2] * bflo(u0.w) + w2b[2] * bflo(upn.w) + cbb[2];
                res[part][7] = w0b[3] * bfhi(um.w) + w1b[3] * bfhi(u0.w) + w2b[3] * bfhi(upn.w) + cbb[3];
            }
            v4u ow; ow.x = pk2(silu_f(res[0][0]) * res[1][0], silu_f(res[0][1]) * res[1][1]); ow.y = pk2(silu_f(res[0][2]) * res[1][2], silu_f(res[0][3]) * res[1][3]);
            ow.z = pk2(silu_f(res[0][4]) * res[1][4], silu_f(res[0][5]) * res[1][5]); ow.w = pk2(silu_f(res[0][6]) * res[1][6], silu_f(res[0][7]) * res[1][7]);
            *(v4u*)(ACTC + (size_t)rl * FF + f) = ow;
        }
    }
    SEAM(6);

    if (IN(7)) {
        pg8::Gemm g{ACTC, WdT, nrows, D, FF}; pg8::StaticOrder S; S.init(nrows, D, G, bx);
        EpiDown E{a.out, macc, b_ada, row0};
        pg8::gemm_phase<EpiDown, pg8::StaticOrder, PG8_ALIGN, PG8_SP2>(lds + RING_OFF, g, S, E);
    }
    if (one_launch && ck + 1 < nchunks) xcd_barrier(bar);
    }
#undef IN
#undef SEAM
}

extern "C" void kernel_launch(void* const* d_in, const int* in_sizes, int n_in, void* d_out, int out_size, void* d_ws, size_t ws_size, hipStream_t stream) {
    static int grid = 0;
    if (grid == 0) {
        if (n_in != 19 || out_size != MT * D || ws_size < WS_END) { fprintf(stderr, "kernel_launch: unexpected shapes (n_in %d, out %d, ws %zu)\n", n_in, out_size, ws_size); grid = -1; return; }
        int dev = 0, cus = 0;
        if (hipGetDevice(&dev) != hipSuccess || hipDeviceGetAttribute(&cus, hipDeviceAttributeMultiprocessorCount, dev) != hipSuccess) { grid = -1; return; }
        if (hipFuncSetAttribute((const void*)fwd, hipFuncAttributeMaxDynamicSharedMemorySize, LDS_BYTES) != hipSuccess) { fprintf(stderr, "kernel_launch: hipFuncSetAttribute failed\n"); grid = -1; return; }
        (void)hipGetLastError();
        grid = cus;
    }
    if (grid < 0) return;
    if (hipMemsetAsync((char*)d_ws + WS_CTL, 0, CTL_ZERO_BYTES, stream) != hipSuccess) return;
    Args a{};
    for (int i = 0; i < 19; ++i) a.in[i] = (const float*)d_in[i];
    a.out = (float*)d_out; a.ws = (unsigned char*)d_ws;
#if MK_ONE_LAUNCH
    a.ph_lo = 0; a.ph_hi = N_PHASES; a.row0 = 0; a.nrows = 0; hipLaunchKernelGGL(fwd, dim3(grid), dim3(NWAVES * 64), LDS_BYTES, stream, a);
#else
    for (int ph = 0; ph < 5; ++ph) { a.ph_lo = ph; a.ph_hi = ph + 1; a.row0 = 0; a.nrows = 0; hipLaunchKernelGGL(fwd, dim3(grid), dim3(NWAVES * 64), LDS_BYTES, stream, a); }
    const int c_row0[6] = {0, 4096, 8192, 12288, 16384, 24576}, c_rows[6] = {4096, 4096, 4096, 4096, 8192, 8192};
    for (int c = 0; c < 6; ++c)
        for (int ph = 5; ph < 8; ++ph) { a.ph_lo = ph; a.ph_hi = ph + 1; a.row0 = c_row0[c]; a.nrows = c_rows[c]; hipLaunchKernelGGL(fwd, dim3(grid), dim3(NWAVES * 64), LDS_BYTES, stream, a); }
#endif
}
```

```cpp
#include <hip/hip_runtime.h>
#include <cstdio>
#include <cstdint>

constexpr int D = 1024, MT = 32768, NPR = 16384, INW = 2048, ATTW = 512, HD = 64, NH = 8, FF = 2816, FF2 = 5632, NBATCH = 10, MODW = 6144;
constexpr float EPS = 1e-6f;

namespace pg8 {
#define PG8_LAS __attribute__((address_space(3)))
typedef unsigned short bf16_t;
typedef short bf16x8 __attribute__((ext_vector_type(8)));
typedef float f32x4 __attribute__((ext_vector_type(4)));
typedef unsigned u32x4 __attribute__((ext_vector_type(4)));
constexpr int BM = 256, BK = 64, HALF = 128, HTB = HALF * BK * 2  , STAGE_BYTES = 8 * HTB, NXCD = 8, WGM = 8;

__host__ __device__ __forceinline__ int lds_byte(int r, int c) { const int st = (r >> 4) * 2 + (c >> 5), rr = r & 15, cc = c & 31, ob = rr * 64 + cc * 2; return st * 1024 + (ob ^ (((ob >> 9) & 1) << 5)); }
__host__ __device__ __forceinline__ void stage_rc(int b, int& R, int& C) { const int st = b / 1024, sb = b % 1024, swz = sb ^ (((sb >> 9) & 1) << 5); R = (st >> 1) * 16 + swz / 64; C = (st & 1) * 32 + (swz % 64) / 2; }
__host__ __device__ __forceinline__ int perm32(int rho) { const int n = rho >> 4, i = rho & 15; return 8 * (i >> 2) + 4 * n + (i & 3); }

struct Unit { int pm, pn; };
struct Gemm { const bf16_t* A; const bf16_t* Bt; int M, N, K; };

struct StaticOrder {
    int nM, nN, nwg, G, c;
    __host__ __device__ void init(int M, int N, int G_, int c_) { nM = M / BM; nN = N / BM; nwg = nM * nN; G = G_; c = c_; }
    __host__ __device__ bool next(int i, Unit& u) const {
        const long L = (long)i * G + c; if (L >= nwg) return false;
        int wgid = (int)L; { const int q = nwg / NXCD, r = nwg % NXCD, xcd = wgid % NXCD, off = wgid / NXCD; wgid = (xcd < r ? xcd * (q + 1) : r * (q + 1) + (xcd - r) * q) + off; }
        const int nig = WGM * nN, gid = wgid / nig, fm = gid * WGM, gsz = (nM - fm) < WGM ? (nM - fm) : WGM;
        u.pm = fm + ((wgid % nig) % gsz); u.pn = (wgid % nig) / gsz; return true;
    }
    __device__ __forceinline__ void a_ready(const Unit&) const {}
    __device__ __forceinline__ void done(const Unit&) const {}
};

template <class Epi, class Sched, bool ALIGN_EPI = false, bool SP2 = false>
__device__ __forceinline__ void gemm_phase(PG8_LAS unsigned char* lds, const Gemm g, const Sched& S, const Epi& E) {
    const int tid = threadIdx.x, wid = __builtin_amdgcn_readfirstlane(tid >> 6), lane = tid & 63, wr = wid >> 2, wc = wid & 3, fr = lane & 15, fq = lane >> 4;
    const int K = g.K, nt = K / BK;
    unsigned voffA[2], voffB[2];
#pragma unroll
    for (int i = 0; i < 2; ++i) { int R, C; stage_rc(tid * 16 + i * 8192, R, C); const int Rb = Epi::PERM ? ((R & ~31) + perm32(R & 31)) : R;
        voffA[i] = (unsigned)(R * K + C) * 2u; voffB[i] = (unsigned)(Rb * K + C) * 2u; }
    const size_t kstep = (size_t)(BK * 2);
    const size_t hstep = (size_t)HALF * K * 2;
    const size_t tstep = 2 * hstep;
    const unsigned ldsw = (unsigned)wid * 1024u;
    const int aoff = lds_byte(wr * 64 + fr, fq * 8), boff = lds_byte(wc * 32 + fr, fq * 8);
#define PG8_SA(b, h) (((b) * 2 + (h)) * HTB)
#define PG8_SB(b, h) ((4 + (b) * 2 + (h)) * HTB)
#define PG8_STAGE(bufoff, gbase, voff) do { _Pragma("unroll") for (int _i = 0; _i < 2; ++_i) \
        __builtin_amdgcn_global_load_lds((const unsigned*)((const char*)(gbase) + (voff)[_i]), (PG8_LAS unsigned*)(lds + (bufoff) + ldsw + _i * 8192), 16, 0, 0); } while (0)
#define PG8_LDA(dst, b, h) do { _Pragma("unroll") for (int m = 0; m < 4; ++m) _Pragma("unroll") for (int k = 0; k < 2; ++k) dst[m][k] = *(const PG8_LAS bf16x8*)(lds + PG8_SA(b, h) + aoff + m * 2048 + k * 1024); } while (0)
#define PG8_LDB(dst, b, h) do { _Pragma("unroll") for (int n = 0; n < 2; ++n) _Pragma("unroll") for (int k = 0; k < 2; ++k) dst[n][k] = *(const PG8_LAS bf16x8*)(lds + PG8_SB(b, h) + boff + n * 2048 + k * 1024); } while (0)
#define PG8_MMA(ai, bj, At, Bt) do { __builtin_amdgcn_s_setprio(1); _Pragma("unroll") for (int m = 0; m < 4; ++m) _Pragma("unroll") for (int n = 0; n < 2; ++n) _Pragma("unroll") for (int k = 0; k < 2; ++k) \
        acc[ai][bj][m][n] = __builtin_amdgcn_mfma_f32_16x16x32_bf16(Bt[n][k], At[m][k], acc[ai][bj][m][n], 0, 0, 0); __builtin_amdgcn_s_setprio(0); } while (0)
#define PG8_WAIT_V(n) asm volatile("s_waitcnt vmcnt(" #n ")" ::: "memory")
#define PG8_WAIT_L(n) asm volatile("s_waitcnt lgkmcnt(" #n ")" ::: "memory")
#define PG8_BAR __builtin_amdgcn_s_barrier()
#define PG8_SCHED __builtin_amdgcn_sched_barrier(0)
    Unit cur, nxt; int ui = 0;
    if (!S.next(0, cur)) return;
    f32x4 acc[2][2][4][2];
#pragma unroll
    for (int a = 0; a < 2; ++a)
#pragma unroll
        for (int b = 0; b < 2; ++b)
#pragma unroll
            for (int m = 0; m < 4; ++m)
#pragma unroll
                for (int n = 0; n < 2; ++n) acc[a][b][m][n] = (f32x4){0.f, 0.f, 0.f, 0.f};
    bf16x8 At[4][2], B0[2][2], B1[2][2];
    const char* cA = (const char*)g.A + (size_t)cur.pm * tstep; const char* cB = (const char*)g.Bt + (size_t)cur.pn * tstep;
    S.a_ready(cur);
    if constexpr (SP2) {
        PG8_STAGE(PG8_SB(0, 0), cB, voffB); PG8_STAGE(PG8_SB(0, 1), cB + hstep, voffB); PG8_STAGE(PG8_SA(0, 0), cA, voffA); PG8_STAGE(PG8_SA(0, 1), cA + hstep, voffA);
        if (wr == 1) PG8_BAR;
        PG8_WAIT_V(2); PG8_BAR;
        PG8_STAGE(PG8_SB(1, 0), cB + kstep, voffB); PG8_STAGE(PG8_SA(1, 0), cA + kstep, voffA); PG8_STAGE(PG8_SB(1, 1), cB + hstep + kstep, voffB);
        PG8_WAIT_V(6); PG8_BAR;
    } else {
        PG8_STAGE(PG8_SB(0, 0), cB, voffB); PG8_STAGE(PG8_SA(0, 0), cA, voffA); PG8_STAGE(PG8_SB(0, 1), cB + hstep, voffB); PG8_STAGE(PG8_SA(0, 1), cA + hstep, voffA);
        if (wr == 1) PG8_BAR;
        PG8_WAIT_V(4); PG8_BAR;
        PG8_STAGE(PG8_SB(1, 0), cB + kstep, voffB); PG8_STAGE(PG8_SA(1, 0), cA + kstep, voffA); PG8_STAGE(PG8_SB(1, 1), cB + hstep + kstep, voffB);
        PG8_WAIT_V(6); PG8_BAR;
    }
    for (;;) {
        const bool has_next = S.next(ui + 1, nxt);
        const char* nA = has_next ? (const char*)g.A + (size_t)nxt.pm * tstep : cA; const char* nB = has_next ? (const char*)g.Bt + (size_t)nxt.pn * tstep : cB;
        for (int t = 0; t < nt; t += 2) {
            const bool last = (t == nt - 2);
            const char* a1 = cA + (size_t)(t + 1) * kstep;
            const char* a2 = last ? nA : cA + (size_t)(t + 2) * kstep; const char* b2 = last ? nB : cB + (size_t)(t + 2) * kstep;
            const char* a3 = a2 + kstep; const char* b3 = b2 + kstep;
            if (last && has_next) S.a_ready(nxt);
            if constexpr (SP2) {
            PG8_LDB(B0, 0, 0); PG8_LDB(B1, 0, 1); PG8_SCHED; PG8_LDA(At, 0, 0); PG8_STAGE(PG8_SA(1, 1), a1 + hstep, voffA);
            PG8_WAIT_V(8); PG8_WAIT_L(0); PG8_BAR; PG8_MMA(0, 0, At, B0); PG8_MMA(0, 1, At, B1); PG8_BAR; PG8_SCHED;
            PG8_LDA(At, 0, 1); PG8_STAGE(PG8_SB(0, 0), b2, voffB); PG8_STAGE(PG8_SB(0, 1), b2 + hstep, voffB); PG8_STAGE(PG8_SA(0, 0), a2, voffA);
            PG8_WAIT_V(8); PG8_WAIT_L(0); PG8_BAR; PG8_MMA(1, 0, At, B0); PG8_MMA(1, 1, At, B1); PG8_BAR; PG8_SCHED;
            PG8_LDB(B0, 1, 0); PG8_LDB(B1, 1, 1); PG8_SCHED; PG8_LDA(At, 1, 0); PG8_STAGE(PG8_SA(0, 1), a2 + hstep, voffA);
            PG8_WAIT_V(8); PG8_WAIT_L(0); PG8_BAR; PG8_MMA(0, 0, At, B0); PG8_MMA(0, 1, At, B1); PG8_BAR; PG8_SCHED;
            PG8_LDA(At, 1, 1); PG8_STAGE(PG8_SB(1, 0), b3, voffB); PG8_STAGE(PG8_SB(1, 1), b3 + hstep, voffB); PG8_STAGE(PG8_SA(1, 0), a3, voffA);
            PG8_WAIT_V(8); PG8_WAIT_L(0); PG8_BAR; PG8_MMA(1, 0, At, B0); PG8_MMA(1, 1, At, B1); PG8_BAR; PG8_SCHED;
            } else {
            PG8_LDB(B0, 0, 0); PG8_SCHED; PG8_LDA(At, 0, 0); PG8_STAGE(PG8_SA(1, 1), a1 + hstep, voffA);
            PG8_WAIT_L(8); PG8_BAR; PG8_WAIT_L(0); PG8_MMA(0, 0, At, B0); PG8_BAR; PG8_SCHED;
            PG8_LDB(B1, 0, 1); PG8_STAGE(PG8_SB(0, 0), b2, voffB);
            PG8_BAR; PG8_WAIT_L(0); PG8_MMA(0, 1, At, B1); PG8_BAR;
            PG8_LDA(At, 0, 1); PG8_STAGE(PG8_SA(0, 0), a2, voffA);
            PG8_BAR; PG8_WAIT_L(0); PG8_MMA(1, 0, At, B0); PG8_BAR; PG8_SCHED;
            PG8_STAGE(PG8_SB(0, 1), b2 + hstep, voffB);
            PG8_WAIT_V(6); PG8_BAR; PG8_MMA(1, 1, At, B1); PG8_BAR;
            PG8_LDB(B0, 1, 0); PG8_SCHED; PG8_LDA(At, 1, 0); PG8_STAGE(PG8_SA(0, 1), a2 + hstep, voffA);
            PG8_WAIT_L(8); PG8_BAR; PG8_WAIT_L(0); PG8_MMA(0, 0, At, B0); PG8_BAR; PG8_SCHED;
            PG8_LDB(B1, 1, 1); PG8_STAGE(PG8_SB(1, 0), b3, voffB);
            PG8_BAR; PG8_WAIT_L(0); PG8_MMA(0, 1, At, B1); PG8_BAR;
            PG8_LDA(At, 1, 1); PG8_STAGE(PG8_SA(1, 0), a3, voffA);
            PG8_BAR; PG8_WAIT_L(0); PG8_MMA(1, 0, At, B0); PG8_BAR; PG8_SCHED;
            PG8_STAGE(PG8_SB(1, 1), b3 + hstep, voffB);
            PG8_WAIT_V(6); PG8_BAR; PG8_MMA(1, 1, At, B1); PG8_BAR;
            }
        }
        if constexpr (ALIGN_EPI) { if (wr == 0) PG8_BAR; }
        if constexpr (!Epi::AFTER_DRAIN) { E(acc, cur, wr, wc, fr, fq); S.done(cur); }
        if (!has_next) break;
#pragma unroll
        for (int a = 0; a < 2; ++a)
#pragma unroll
            for (int b = 0; b < 2; ++b)
#pragma unroll
                for (int m = 0; m < 4; ++m)
#pragma unroll
                    for (int n = 0; n < 2; ++n) acc[a][b][m][n] = (f32x4){0.f, 0.f, 0.f, 0.f};
        cur = nxt; cA = nA; cB = nB; ++ui;
        if constexpr (ALIGN_EPI) { if (wr == 1) PG8_BAR; }
    }
    PG8_WAIT_V(0);
    if constexpr (!ALIGN_EPI) { if (wr == 0) PG8_BAR; }
    PG8_BAR;
    if constexpr (Epi::AFTER_DRAIN) { E.fused(acc, cur, wr, wc, fr, fq, lds, wid, lane); S.done(cur); }
#undef PG8_SA
#undef PG8_SB
#undef PG8_STAGE
#undef PG8_LDA
#undef PG8_LDB
#undef PG8_MMA
#undef PG8_WAIT_V
#undef PG8_WAIT_L
#undef PG8_BAR
#undef PG8_SCHED
}
}
#ifndef PG8_SP2
#define PG8_SP2 true
#endif
#ifndef PG8_ALIGN
#define PG8_ALIGN true
#endif
constexpr size_t MiB = 1u << 20;
constexpr size_t WS_CTL = 0, CTL_ZERO_BYTES = 3 * MiB;
constexpr size_t OFF_MOD = 65536, OFF_C2 = 327680, OFF_RSS2 = 589824, OFF_HSS = 1 * MiB;
constexpr size_t WS_WIN = 3 * MiB, WS_WOUT = 7 * MiB, WS_WUP = 9 * MiB, WS_WDN = 20 * MiB, WS_SMALL = 26 * MiB;
constexpr size_t WS_H1 = 32 * MiB, WS_PROJ = 96 * MiB, WS_CAT = 32 * MiB, WS_XG2 = 96 * MiB, WS_UPC = 160 * MiB, WS_ACTC = 32 * MiB;
constexpr size_t WS_END = 248 * MiB;
constexpr int CW_BAR = 4096;
constexpr int RING_OFF = 0, RING_BYTES = 131072, LDSCTL_OFF = RING_BYTES, MISC_OFF = LDSCTL_OFF + 320, LDS_BYTES = 147456;
constexpr int NWAVES = 8;
constexpr int BIAS_OFF = LDSCTL_OFF + 1024, RK_OFF = LDSCTL_OFF + 4096;

#define GAS __attribute__((address_space(1)))
#define LAS __attribute__((address_space(3)))
typedef unsigned short bf16;
typedef unsigned v4u __attribute__((ext_vector_type(4)));
typedef unsigned v2u __attribute__((ext_vector_type(2)));
using pg8::f32x4;
#define LDS_WAIT() asm volatile("s_waitcnt lgkmcnt(0)" ::: "memory")
#define VM_WAIT() asm volatile("s_waitcnt vmcnt(0)" ::: "memory")
__device__ __forceinline__ unsigned f2bf(float f) { unsigned u = __builtin_bit_cast(unsigned, f); return (u + 0x7fffu + ((u >> 16) & 1u)) >> 16; }
__device__ __forceinline__ unsigned pk2(float lo, float hi) { return f2bf(lo) | (f2bf(hi) << 16); }
__device__ __forceinline__ float bflo(unsigned w) { return __builtin_bit_cast(float, w << 16); }
__device__ __forceinline__ float bfhi(unsigned w) { return __builtin_bit_cast(float, w & 0xffff0000u); }
__device__ __forceinline__ unsigned cvt_pk(float lo, float hi) { unsigned r; asm volatile("v_cvt_pk_bf16_f32 %0, %1, %2" : "=v"(r) : "v"(lo), "v"(hi)); return r; }
__device__ __forceinline__ int batch_of_row(int row) { return row < NPR ? (row >> 11) : 8 + ((row - NPR) >> 13); }
__device__ __forceinline__ int batch_of_tile(int pm) { return pm < 64 ? (pm >> 3) : 8 + ((pm - 64) >> 5); }
__device__ __forceinline__ int permcol(int n) { const int f = n < FF ? n : n - FF; return (f >> 7) * 256 + (f & 127) + (n < FF ? 0 : 128); }
__device__ __forceinline__ float wave_sum(float v) {
#pragma unroll
    for (int o = 1; o < 64; o <<= 1) v += __shfl_xor(v, o);
    return v;
}
__device__ __forceinline__ float silu_f(float x) { return x / (1.0f + __expf(-x)); }

#define XB_TMO      128
#define XB_XCNT(j)  (256  + 64 * (j))
#define XB_XSUB(j)  (1280 + 64 * (j))
#define XB_XGEN(j)  (2304 + 64 * (j))
#define XB_TOP      3328
#define XB_TOPGEN   3392
#define XCD_BAR_WORDS 3456
#define XB_SPIN_CAP (1u << 18)

__device__ __forceinline__ unsigned xb_ld(unsigned* p)              { return __hip_atomic_load(p, __ATOMIC_RELAXED, __HIP_MEMORY_SCOPE_AGENT); }
__device__ __forceinline__ unsigned xb_add(unsigned* p, unsigned v) { return __hip_atomic_fetch_add(p, v, __ATOMIC_RELAXED, __HIP_MEMORY_SCOPE_AGENT); }
__device__ __forceinline__ unsigned xb_xcc_id() { return (unsigned)__builtin_amdgcn_s_getreg((3 << 11) | 20) & 0xFu; }
#define XB_SPIN(cond, bar) do { unsigned _sp = 0; while (cond) { __builtin_amdgcn_s_sleep(1); \
    if ((++_sp & 255u) == 0u) { if (xb_ld(&(bar)[XB_TMO])) break; if (_sp > XB_SPIN_CAP) { atomicAdd(&(bar)[XB_TMO], 1u); break; } } } } while (0)

struct XcdBarrier {
    unsigned* bar; unsigned x;
    volatile LAS unsigned* st;
};

__device__ __forceinline__ XcdBarrier xcd_barrier_post(unsigned* bar, volatile LAS unsigned* st) {
    XcdBarrier b; b.bar = bar; b.x = xb_xcc_id(); b.st = st;
    if (threadIdx.x == 0) (void)xb_add(&bar[XB_XCNT(b.x)], 1u);
    return b;
}
__device__ __forceinline__ void xcd_barrier_complete(unsigned* bar, unsigned x, unsigned& nloc, unsigned& nx) {
    const unsigned G = gridDim.x * gridDim.y * gridDim.z;
    unsigned sum, cnt, mine, sp = 0u;
    for (;;) {
        sum = 0u; cnt = 0u; mine = 0u;
#pragma unroll
        for (unsigned j = 0; j < 16; ++j) { const unsigned c = xb_ld(&bar[XB_XCNT(j)]); sum += c; cnt += (c > 0u) ? 1u : 0u; mine = (j == x) ? c : mine; }
        if (sum == G) break;
        __builtin_amdgcn_s_sleep(1);
        if ((++sp & 255u) == 0u) { if (xb_ld(&bar[XB_TMO])) break; if (sp > XB_SPIN_CAP) { atomicAdd(&bar[XB_TMO], 1u); break; } }
    }
    nloc = mine > 0u ? mine : 1u; nx = cnt > 0u ? cnt : 1u;
}

__device__ __forceinline__ void xcd_barrier(const XcdBarrier& b) {
    asm volatile("s_waitcnt vmcnt(0)" ::: "memory");
    __syncthreads();
    if (threadIdx.x == 0) {
        unsigned* bar = b.bar;
        __builtin_amdgcn_s_waitcnt(0);
        unsigned nloc = b.st[0], nx = b.st[1];
        if (nloc == 0u) { xcd_barrier_complete(bar, b.x, nloc, nx); b.st[0] = nloc; b.st[1] = nx; }
        const unsigned old = xb_add(&bar[XB_XSUB(b.x)], 1u);
        const unsigned gen = old / nloc;
        if (old + 1u == (gen + 1u) * nloc) {
            __builtin_amdgcn_fence(__ATOMIC_RELEASE, "agent");
            asm volatile("s_waitcnt vmcnt(0)" ::: "memory");
            const unsigned og = xb_add(&bar[XB_TOP], 1u);
            const unsigned tg = og / nx;
            if (og + 1u == (tg + 1u) * nx) xb_add(&bar[XB_TOPGEN], 1u);
            else XB_SPIN(xb_ld(&bar[XB_TOPGEN]) == tg, bar);
            __builtin_amdgcn_fence(__ATOMIC_ACQUIRE, "agent");
            xb_add(&bar[XB_XGEN(b.x)], 1u);
            asm volatile("s_waitcnt vmcnt(0)" ::: "memory");
        } else {
            XB_SPIN(xb_ld(&bar[XB_XGEN(b.x)]) == gen, bar);
            __builtin_amdgcn_fence(__ATOMIC_ACQUIRE, "agent");
            asm volatile("s_waitcnt vmcnt(0)" ::: "memory");
        }
    }
    __syncthreads();
}
typedef const f32x4 (&AccRef)[2][2][4][2];
__device__ __forceinline__ float modv(const float* macc, const float* b_ada, int b, int j) { return macc[b * MODW + j] + b_ada[j]; }
__device__ __forceinline__ f32x4 modv4(const float* macc, const float* b_ada, int b, int j) { return *(const f32x4*)(macc + b * MODW + j) + *(const f32x4*)(b_ada + j); }

struct EpiProj {
    static constexpr bool PERM = true, AFTER_DRAIN = false;
    bf16* O; float* hss;
    __device__ __forceinline__ void operator()(AccRef acc, const pg8::Unit& u, int wr, int wc, int fr, int fq) const {
        const int row0 = u.pm * 256 + wr * 64 + fr, col0 = u.pn * 256 + wc * 32 + 8 * fq;
#pragma unroll
        for (int ai = 0; ai < 2; ++ai)
#pragma unroll
            for (int m = 0; m < 4; ++m) { bf16* rowp = O + (size_t)(row0 + ai * 128 + m * 16) * INW + col0;
#pragma unroll
                for (int bj = 0; bj < 2; ++bj) { const f32x4 v0 = acc[ai][bj][m][0], v1 = acc[ai][bj][m][1];
                    v4u w; w.x = cvt_pk(v0[0], v0[1]); w.y = cvt_pk(v0[2], v0[3]); w.z = cvt_pk(v1[0], v1[1]); w.w = cvt_pk(v1[2], v1[3]);
                    *(v4u*)(rowp + bj * 128) = w; } }
        if (u.pn < 4) {
#pragma unroll
            for (int ai = 0; ai < 2; ++ai)
#pragma unroll
                for (int m = 0; m < 4; ++m)
#pragma unroll
                    for (int bj = 0; bj < 2; ++bj) { const f32x4 v0 = acc[ai][bj][m][0], v1 = acc[ai][bj][m][1];
                        float s = ((v0[0] * v0[0] + v0[1] * v0[1]) + (v0[2] * v0[2] + v0[3] * v0[3])) + ((v1[0] * v1[0] + v1[1] * v1[1]) + (v1[2] * v1[2] + v1[3] * v1[3]));
                        s += __shfl_xor(s, 16); s += __shfl_xor(s, 32);
                        if (fq == 0) atomicAdd(hss + (size_t)(4 * u.pn + 2 * bj + (wc >> 1)) * MT + row0 + ai * 128 + m * 16, s); }
        }
    }
};
struct EpiOut {
    static constexpr bool PERM = false, AFTER_DRAIN = false;
    const float* xp; const float* xs; float* x1; bf16* xg2; float* rss2; const float* macc; const float* b_ada; const float* n2g;
    __device__ __forceinline__ void operator()(AccRef acc, const pg8::Unit& u, int wr, int wc, int fr, int fq) const {
        const int b = batch_of_tile(u.pm), row0 = u.pm * 256 + wr * 64 + fr, col0 = u.pn * 256 + wc * 32 + 4 * fq;
        float ss[2][4];
#pragma unroll
        for (int ai = 0; ai < 2; ++ai)
#pragma unroll
            for (int m = 0; m < 4; ++m) ss[ai][m] = 0.f;
#pragma unroll
        for (int bj = 0; bj < 2; ++bj)
#pragma unroll
            for (int n = 0; n < 2; ++n) {
                const int c = col0 + bj * 128 + n * 16;
                const f32x4 g1 = modv4(macc, b_ada, b, 2 * D + c), G2 = *(const f32x4*)(n2g + c) * (modv4(macc, b_ada, b, 4 * D + c) + 1.0f);
#pragma unroll
                for (int ai = 0; ai < 2; ++ai)
#pragma unroll
                    for (int m = 0; m < 4; ++m) {
                        const int row = row0 + ai * 128 + m * 16;
                        const float* xrow = row < NPR ? xp + (size_t)row * D : xs + (size_t)(row - NPR) * D;
                        const f32x4 v = *(const f32x4*)(xrow + c) + g1 * acc[ai][bj][m][n];
                        *(f32x4*)(x1 + (size_t)row * D + c) = v;
                        ss[ai][m] += (v[0] * v[0] + v[1] * v[1]) + (v[2] * v[2] + v[3] * v[3]);
                        const f32x4 g = v * G2; v2u w; w.x = cvt_pk(g[0], g[1]); w.y = cvt_pk(g[2], g[3]);
                        *(v2u*)(xg2 + (size_t)row * D + c) = w;
                    }
            }
#pragma unroll
        for (int ai = 0; ai < 2; ++ai)
#pragma unroll
            for (int m = 0; m < 4; ++m) { float s = ss[ai][m]; s += __shfl_xor(s, 16); s += __shfl_xor(s, 32);
                if (fq == 0) atomicAdd(rss2 + row0 + ai * 128 + m * 16, s); }
    }
};
struct EpiUp {
    static constexpr bool PERM = true, AFTER_DRAIN = false;
    bf16* O; const float* rss2; const float* c2; int rowbase;
    __device__ __forceinline__ void operator()(AccRef acc, const pg8::Unit& u, int wr, int wc, int fr, int fq) const {
        const int b = batch_of_row(rowbase + u.pm * 256), rl0 = u.pm * 256 + wr * 64 + fr, col0 = u.pn * 256 + wc * 32 + 8 * fq;
        f32x4 cv[2][2];
#pragma unroll
        for (int bj = 0; bj < 2; ++bj)
#pragma unroll
            for (int n = 0; n < 2; ++n) cv[bj][n] = *(const f32x4*)(c2 + b * FF2 + col0 + bj * 128 + 4 * n);
#pragma unroll
        for (int ai = 0; ai < 2; ++ai)
#pragma unroll
            for (int m = 0; m < 4; ++m) { const int rl = rl0 + ai * 128 + m * 16; const float rs = rsqrtf(rss2[rowbase + rl] * (1.0f / D) + EPS);
                bf16* rowp = O + (size_t)rl * FF2 + col0;
#pragma unroll
                for (int bj = 0; bj < 2; ++bj) { const f32x4 v0 = acc[ai][bj][m][0] * rs + cv[bj][0], v1 = acc[ai][bj][m][1] * rs + cv[bj][1];
                    v4u w; w.x = cvt_pk(v0[0], v0[1]); w.y = cvt_pk(v0[2], v0[3]); w.z = cvt_pk(v1[0], v1[1]); w.w = cvt_pk(v1[2], v1[3]);
                    *(v4u*)(rowp + bj * 128) = w; } }
    }
};
struct EpiDown {
    static constexpr bool PERM = false, AFTER_DRAIN = false;
    float* out; const float* macc; const float* b_ada; int rowbase;
    __device__ __forceinline__ void operator()(AccRef acc, const pg8::Unit& u, int wr, int wc, int fr, int fq) const {
        const int b = batch_of_row(rowbase + u.pm * 256), row0 = rowbase + u.pm * 256 + wr * 64 + fr, col0 = u.pn * 256 + wc * 32 + 4 * fq;
#pragma unroll
        for (int bj = 0; bj < 2; ++bj)
#pragma unroll
            for (int n = 0; n < 2; ++n) {
                const int c = col0 + bj * 128 + n * 16;
                const f32x4 g2 = modv4(macc, b_ada, b, 5 * D + c);
#pragma unroll
                for (int ai = 0; ai < 2; ++ai)
#pragma unroll
                    for (int m = 0; m < 4; ++m) { float* p = out + (size_t)(row0 + ai * 128 + m * 16) * D + c; *(f32x4*)p = *(const f32x4*)p + g2 * acc[ai][bj][m][n]; }
            }
    }
};

__device__ __forceinline__ void transpose_item(const float* W, int ldw, int k0, int n0, bf16* WT, int ldt, int drow0, int kd0, LAS float* scr, int lane) {
#pragma unroll 8
    for (int i = 0; i < 32; ++i) { const int kk = 2 * i + (lane >> 5); scr[kk * 33 + (lane & 31)] = W[(size_t)(k0 + kk) * ldw + n0 + (lane & 31)]; }
    LDS_WAIT(); asm volatile("" ::: "memory");
    const int c = lane & 7;
#pragma unroll
    for (int j = 0; j < 4; ++j) { const int n = (lane >> 3) + 8 * j; const LAS float* s = scr + (8 * c) * 33 + n;
        v4u o; o.x = pk2(s[0 * 33], s[1 * 33]); o.y = pk2(s[2 * 33], s[3 * 33]); o.z = pk2(s[4 * 33], s[5 * 33]); o.w = pk2(s[6 * 33], s[7 * 33]);
        *(v4u*)(WT + (size_t)(drow0 + n) * ldt + kd0 + 8 * c) = o; }
    LDS_WAIT(); asm volatile("" ::: "memory");
}
__device__ __forceinline__ void gemv10_item(const float* W, int ldw, int k0, int n, LAS float* sb, float* dst, int dstride, int dcol) {
    float acc[NBATCH];
#pragma unroll
    for (int b = 0; b < NBATCH; ++b) acc[b] = 0.f;
#pragma unroll 4
    for (int kk = 0; kk < 64; ++kk) {
        const float w = W[(size_t)(k0 + kk) * ldw + n];
        const f32x4 s0 = *(const LAS f32x4*)(sb + kk * 12), s1 = *(const LAS f32x4*)(sb + kk * 12 + 4), s2 = *(const LAS f32x4*)(sb + kk * 12 + 8);
        acc[0] += w * s0[0]; acc[1] += w * s0[1]; acc[2] += w * s0[2]; acc[3] += w * s0[3];
        acc[4] += w * s1[0]; acc[5] += w * s1[1]; acc[6] += w * s1[2]; acc[7] += w * s1[3];
        acc[8] += w * s2[0]; acc[9] += w * s2[1];
    }
#pragma unroll
    for (int b = 0; b < NBATCH; ++b) atomicAdd(dst + (size_t)b * dstride + dcol, acc[b]);
    LDS_WAIT(); asm volatile("" ::: "memory");
}

struct Args { const float* in[19]; float* out; unsigned char* ws; int ph_lo, ph_hi, row0, nrows; };
enum { I_XP = 0, I_XS, I_CP, I_CS, I_WADA, I_BADA, I_N1G, I_N2G, I_WIN, I_QNG, I_KNG, I_RPB, I_WPOOL, I_PSCALE, I_WOUT, I_WUP, I_CONVW, I_CONVB, I_WDOWN };
constexpr int N_PHASES = 8;
#ifndef MK_ONE_LAUNCH
#define MK_ONE_LAUNCH 1
#endif

__global__ void __launch_bounds__(NWAVES * 64, 2) fwd(Args a) {
    extern __shared__ __attribute__((aligned(16))) unsigned char lds_raw[];
    LAS unsigned char* lds = (LAS unsigned char*)lds_raw;
    volatile LAS unsigned* MISC = (volatile LAS unsigned*)(lds + MISC_OFF);
    const int tid = threadIdx.x, lane = tid & 63, wave = __builtin_amdgcn_readfirstlane(tid >> 6);
    const int G = gridDim.x; const int bx = blockIdx.x; const int vcu = (G % 8 == 0) ? (bx % 8) * (G / 8) + bx / 8 : bx;
    const int gw = vcu * NWAVES + wave, NGW = G * NWAVES;
    unsigned char* ws = a.ws;
    unsigned* ctl = (unsigned*)(ws + WS_CTL);
    float* macc = (float*)(ws + OFF_MOD); float* c2acc = (float*)(ws + OFF_C2); float* rss2 = (float*)(ws + OFF_RSS2); float* hss = (float*)(ws + OFF_HSS);
    bf16* WinT = (bf16*)(ws + WS_WIN); bf16* WoT = (bf16*)(ws + WS_WOUT); bf16* WupT = (bf16*)(ws + WS_WUP); bf16* WdT = (bf16*)(ws + WS_WDN);
    float* convp = (float*)(ws + WS_SMALL); float* cbp = convp + 3 * FF2;
    bf16* H1 = (bf16*)(ws + WS_H1); bf16* PROJ = (bf16*)(ws + WS_PROJ); bf16* CAT = (bf16*)(ws + WS_CAT); bf16* XG2 = (bf16*)(ws + WS_XG2);
    bf16* UPC = (bf16*)(ws + WS_UPC); bf16* ACTC = (bf16*)(ws + WS_ACTC);
    const float* b_ada = a.in[I_BADA];

    for (int u = tid; u < (LDS_BYTES - LDSCTL_OFF) / 4; u += NWAVES * 64) ((LAS unsigned*)(lds + LDSCTL_OFF))[u] = 0u;
    __syncthreads();
    const bool one_launch = (a.ph_lo == 0 && a.ph_hi == N_PHASES);
    XcdBarrier bar; bar.bar = ctl + CW_BAR; bar.x = 0; bar.st = nullptr;
    if (one_launch) bar = xcd_barrier_post(ctl + CW_BAR, MISC + 8);
#define IN(k) (a.ph_lo <= (k) && (k) < a.ph_hi)
#define SEAM(k) do { if (IN(k) && IN((k) + 1)) xcd_barrier(bar); } while (0)

    if (IN(0)) {
        LAS float* scr = (LAS float*)(lds + RING_OFF + wave * 16384);
        constexpr int I0 = 16 * 64, I1 = I0 + 8 * 32, I2 = I1 + 16 * 176, I3 = I2 + 44 * 32, I4 = I3 + 16 * 96, I5 = I4 + 4 * 16 * 16, I6 = I5 + 88;
        for (int it = gw; it < I6; it += NGW) {
            if (it < I0) { const int kb = it / 64, nb = it % 64; transpose_item(a.in[I_WIN], INW, 64 * kb, 32 * nb, WinT, D, 32 * nb, 64 * kb, scr, lane); }
            else if (it < I1) { const int r = it - I0, kb = r / 32, nb = r % 32; transpose_item(a.in[I_WOUT], D, 64 * kb, 32 * nb, WoT, D, 32 * nb, 64 * kb, scr, lane); }
            else if (it < I2) { const int r = it - I1, kb = r / 176, nb = r % 176; transpose_item(a.in[I_WUP], FF2, 64 * kb, 32 * nb, WupT, D, permcol(32 * nb), 64 * kb, scr, lane); }
            else if (it < I3) { const int r = it - I2, kb = r / 32, nb = r % 32; transpose_item(a.in[I_WDOWN], D, 64 * kb, 32 * nb, WdT, FF, 32 * nb, 64 * kb, scr, lane); }
            else if (it < I4) {
                const int r = it - I3, kc = r / 96, nc = r % 96, k = 64 * kc + lane;
#pragma unroll
                for (int b = 0; b < NBATCH; ++b) { const float c = b < 8 ? a.in[I_CP][b * D + k] : a.in[I_CS][(b - 8) * D + k]; scr[lane * 12 + b] = silu_f(c); }
                LDS_WAIT(); asm volatile("" ::: "memory");
                gemv10_item(a.in[I_WADA], MODW, 64 * kc, 64 * nc + lane, scr, macc, MODW, 64 * nc + lane);
            }
            else if (it < I5) {
                const int r = it - I4, g = r / 256, cb = (r / 16) % 16, nb = r % 16, n = 64 * nb + lane;
                float acc[8];
#pragma unroll
                for (int i = 0; i < 8; ++i) acc[i] = 0.f;
                const float* wp = a.in[I_WPOOL] + (size_t)(g * 128 + 8 * cb) * 128;
                for (int d = 0; d < 128; ++d) {
                    const float wo = a.in[I_WOUT][(size_t)(ATTW + g * 128 + d) * D + n] * a.in[I_PSCALE][g * 128 + d];
#pragma unroll
                    for (int i = 0; i < 8; ++i) acc[i] += wp[i * 128 + d] * wo;
                }
                v4u o; o.x = pk2(acc[0], acc[1]); o.y = pk2(acc[2], acc[3]); o.z = pk2(acc[4], acc[5]); o.w = pk2(acc[6], acc[7]);
                *(v4u*)(WoT + (size_t)n * D + ATTW + g * 128 + 8 * cb) = o;
            }
            else { const int n = 64 * (it - I5) + lane, pc = permcol(n);
                convp[pc] = a.in[I_CONVW][n]; convp[FF2 + pc] = a.in[I_CONVW][FF2 + n]; convp[2 * FF2 + pc] = a.in[I_CONVW][2 * FF2 + n]; cbp[pc] = a.in[I_CONVB][n]; }
        }
    }
    SEAM(0);

    if (IN(1)) {
        LAS float* scr = (LAS float*)(lds + RING_OFF + wave * 16384);
        for (int it = gw; it < 16 * 88; it += NGW) {
            const int kc = it / 88, nc = it % 88, k = 64 * kc + lane;
#pragma unroll
            for (int b = 0; b < NBATCH; ++b) scr[lane * 12 + b] = modv(macc, b_ada, b, 3 * D + k);
            LDS_WAIT(); asm volatile("" ::: "memory");
            gemv10_item(a.in[I_WUP], FF2, 64 * kc, 64 * nc + lane, scr, c2acc, FF2, permcol(64 * nc) + lane);
        }
        for (int r0 = gw * 16; r0 < MT; r0 += NGW * 16) {
            const int b = batch_of_row(r0);
            f32x4 Gv[4], Sv[4];
#pragma unroll
            for (int j = 0; j < 4; ++j) { const int c = 4 * lane + 256 * j; Gv[j] = *(const f32x4*)(a.in[I_N1G] + c) * (modv4(macc, b_ada, b, D + c) + 1.0f); Sv[j] = modv4(macc, b_ada, b, c); }
            for (int rr = 0; rr < 16; ++rr) {
                const int row = r0 + rr; const float* xrow = row < NPR ? a.in[I_XP] + (size_t)row * D : a.in[I_XS] + (size_t)(row - NPR) * D;
                f32x4 v[4]; float s = 0.f;
#pragma unroll
                for (int j = 0; j < 4; ++j) { v[j] = *(const f32x4*)(xrow + 4 * lane + 256 * j); s += (v[j][0] * v[j][0] + v[j][1] * v[j][1]) + (v[j][2] * v[j][2] + v[j][3] * v[j][3]); }
                const float rstd = rsqrtf(wave_sum(s) * (1.0f / D) + EPS);
#pragma unroll
                for (int j = 0; j < 4; ++j) { const f32x4 h = v[j] * rstd * Gv[j] + Sv[j]; v2u w; w.x = pk2(h[0], h[1]); w.y = pk2(h[2], h[3]);
                    *(v2u*)(H1 + (size_t)row * D + 4 * lane + 256 * j) = w; }
            }
        }
    }
    SEAM(1);

    if (IN(2)) {
        pg8::Gemm g{H1, WinT, MT, INW, D}; pg8::StaticOrder S; S.init(MT, INW, G, bx);
        EpiProj E{PROJ, hss};
        pg8::gemm_phase<EpiProj, pg8::StaticOrder, PG8_ALIGN, PG8_SP2>(lds + RING_OFF, g, S, E);
    }
    SEAM(2);

    if (IN(3)) {
        typedef short bf16x8 __attribute__((ext_vector_type(8)));
        typedef short s16x4 __attribute__((ext_vector_type(4)));
        LAS float* tbl = (LAS float*)(lds + BIAS_OFF);
        LAS float* rkr = (LAS float*)(lds + RK_OFF);
        const int fq = lane >> 4, l15 = lane & 15, tq = l15 >> 2, tp = lane & 3;
        const int pr = wave >> 2, j = wave & 3, cb0 = j < 2 ? 0 : 1;
        for (int task = vcu; task < 256; task += G) {
            int b, h, r0, rows;
            if (task < 128) { b = task >> 4; h = (task >> 1) & 7; r0 = (task & 1) * 16; rows = 32; }
            else { const int t2 = task - 128; b = 8 + (t2 >> 6); h = (t2 >> 3) & 7; r0 = (t2 & 7) * 16; rows = 128; }
            const int base = b < 8 ? b * 2048 : NPR + (b - 8) * 8192;
            __syncthreads();
            { const int dr = tid >> 5, dc = tid & 31; tbl[tid] = (dr < 15 && dc < 31) ? a.in[I_RPB][h * 465 + dr * 31 + dc] * 1.4426950408889634f : -1e30f; }
            int dco[3][4];
            { const int qc = 16 * j + l15, cs = min(max(qc - 8, 0), 48);
#pragma unroll
              for (int cbk = 0; cbk < 3; ++cbk)
#pragma unroll
                  for (int e = 0; e < 4; ++e) { const int kc = 16 * (cb0 + cbk) + 4 * fq + e; dco[cbk][e] = (kc >= cs && kc < cs + 16) ? (kc - qc + 15) : 31; } }
            int voff[4];
#pragma unroll
            for (int db = 0; db < 4; ++db) voff[db] = (4 * fq + tq) * 128 + 16 * ((2 * db + (tp >> 1)) ^ (4 * (fq & 1) + tq)) + 8 * (tp & 1);
#define STAGE_VROW(kr) do { const int kr_ = (kr); const int slot_ = kr_ & 15; const int tc_ = 8 * wave + (lane >> 3), c16_ = (lane & 7) ^ (tc_ & 7); \
                const bf16* src_ = PROJ + (size_t)(base + kr_ * 64 + tc_) * INW + 2 * ATTW + h * 64 + 8 * c16_; \
                __builtin_amdgcn_global_load_lds((const unsigned*)src_, (LAS unsigned*)(lds + RING_OFF + slot_ * 8192 + wave * 1024), 16, 0, 0); \
                if (wave == 0) rkr[slot_ * 64 + lane] = rsqrtf(hss[(size_t)(8 + h) * MT + base + kr_ * 64 + lane] * (1.0f / 64.0f) + EPS) * 1.4426950408889634f; } while (0)
            int staged_hi;
            { const int lo0 = min(max(r0 - 4, 0), rows - 8), hi0 = min(max(r0 + 1 - 4, 0), rows - 8) + 7;
              for (int kr = lo0; kr <= hi0; ++kr) STAGE_VROW(kr);
              staged_hi = hi0; }
#pragma unroll 1
            for (int p = 0; p < 8; ++p) {
                VM_WAIT(); LDS_WAIT(); __syncthreads();
                if (p < 7) { const int hin = min(max(r0 + 2 * p + 3 - 4, 0), rows - 8) + 7; for (int kr = staged_hi + 1; kr <= hin; ++kr) STAGE_VROW(kr); staged_hi = max(staged_hi, hin); }
                const int r = r0 + 2 * p + pr, rs = min(max(r - 4, 0), rows - 8), dr0 = rs - r + 7;
                const int qrow = base + r * 64 + 16 * j + l15;
                bf16x8 qf[2];
                { const float rqs = rsqrtf(hss[(size_t)h * MT + qrow] * (1.0f / 64.0f) + EPS) * 0.125f;
#pragma unroll
                  for (int ks = 0; ks < 2; ++ks) { const int d0 = 32 * ks + 8 * fq;
                      const v4u w = *(const v4u*)(PROJ + (size_t)qrow * INW + h * 64 + d0);
                      const f32x4 g0 = *(const f32x4*)(a.in[I_QNG] + d0) * *(const f32x4*)(a.in[I_KNG] + d0) * rqs, g1 = *(const f32x4*)(a.in[I_QNG] + d0 + 4) * *(const f32x4*)(a.in[I_KNG] + d0 + 4) * rqs;
                      v4u o; o.x = pk2(bflo(w.x) * g0[0], bfhi(w.x) * g0[1]); o.y = pk2(bflo(w.y) * g0[2], bfhi(w.y) * g0[3]); o.z = pk2(bflo(w.z) * g1[0], bfhi(w.z) * g1[1]); o.w = pk2(bflo(w.w) * g1[2], bfhi(w.w) * g1[3]);
                      qf[ks] = __builtin_bit_cast(bf16x8, o); } }
                f32x4 sc[24]; float mx = -3e38f;
#pragma unroll
                for (int i = 0; i < 8; ++i)
#pragma unroll
                    for (int cbk = 0; cbk < 3; ++cbk) {
                        const int tok = base + (rs + i) * 64 + 16 * (cb0 + cbk) + l15;
                        const bf16* kp = PROJ + (size_t)tok * INW + ATTW + h * 64 + 8 * fq;
                        const bf16x8 k0 = *(const bf16x8*)kp, k1 = *(const bf16x8*)(kp + 32);
                        f32x4 c = {0.f, 0.f, 0.f, 0.f};
                        c = __builtin_amdgcn_mfma_f32_16x16x32_bf16(k0, qf[0], c, 0, 0, 0);
                        c = __builtin_amdgcn_mfma_f32_16x16x32_bf16(k1, qf[1], c, 0, 0, 0);
                        const f32x4 rk = *(const LAS f32x4*)(rkr + ((rs + i) & 15) * 64 + 16 * (cb0 + cbk) + 4 * fq);
                        const LAS float* tb = tbl + (dr0 + i) * 32;
                        f32x4 s; s[0] = c[0] * rk[0] + tb[dco[cbk][0]]; s[1] = c[1] * rk[1] + tb[dco[cbk][1]]; s[2] = c[2] * rk[2] + tb[dco[cbk][2]]; s[3] = c[3] * rk[3] + tb[dco[cbk][3]];
                        sc[3 * i + cbk] = s; mx = fmaxf(fmaxf(mx, fmaxf(s[0], s[1])), fmaxf(s[2], s[3]));
                    }
                mx = fmaxf(mx, __shfl_xor(mx, 16)); mx = fmaxf(mx, __shfl_xor(mx, 32));
                float lsum = 0.f;
#pragma unroll
                for (int kb = 0; kb < 24; ++kb) { f32x4 e; e[0] = __builtin_amdgcn_exp2f(sc[kb][0] - mx); e[1] = __builtin_amdgcn_exp2f(sc[kb][1] - mx); e[2] = __builtin_amdgcn_exp2f(sc[kb][2] - mx); e[3] = __builtin_amdgcn_exp2f(sc[kb][3] - mx);
                    sc[kb] = e; lsum += (e[0] + e[1]) + (e[2] + e[3]); }
                lsum += __shfl_xor(lsum, 16); lsum += __shfl_xor(lsum, 32);
                f32x4 oacc[4];
#pragma unroll
                for (int db = 0; db < 4; ++db) oacc[db] = (f32x4){0.f, 0.f, 0.f, 0.f};
#pragma unroll
                for (int t = 0; t < 12; ++t) {
                    const int kbA = 2 * t, kbB = 2 * t + 1, iA = kbA / 3, cA = kbA % 3, iB = kbB / 3, cB = kbB % 3;
                    v4u pw; pw.x = cvt_pk(sc[kbA][0], sc[kbA][1]); pw.y = cvt_pk(sc[kbA][2], sc[kbA][3]); pw.z = cvt_pk(sc[kbB][0], sc[kbB][1]); pw.w = cvt_pk(sc[kbB][2], sc[kbB][3]);
                    const bf16x8 pf = __builtin_bit_cast(bf16x8, pw);
                    const LAS unsigned char* vA = lds + RING_OFF + ((rs + iA) & 15) * 8192 + (cb0 + cA) * 2048, * vB = lds + RING_OFF + ((rs + iB) & 15) * 8192 + (cb0 + cB) * 2048;
#pragma unroll
                    for (int db = 0; db < 4; ++db) {
                        const s16x4 va = __builtin_bit_cast(s16x4, __builtin_amdgcn_ds_read_tr16_b64_v4i16((LAS s16x4*)(vA + voff[db])));
                        const s16x4 vb = __builtin_bit_cast(s16x4, __builtin_amdgcn_ds_read_tr16_b64_v4i16((LAS s16x4*)(vB + voff[db])));
                        bf16x8 vf; vf[0] = va[0]; vf[1] = va[1]; vf[2] = va[2]; vf[3] = va[3]; vf[4] = vb[0]; vf[5] = vb[1]; vf[6] = vb[2]; vf[7] = vb[3];
                        oacc[db] = __builtin_amdgcn_mfma_f32_16x16x32_bf16(vf, pf, oacc[db], 0, 0, 0);
                    }
                }
                const float il = 1.0f / lsum;
#pragma unroll
                for (int db = 0; db < 4; ++db) { v2u w; w.x = cvt_pk(oacc[db][0] * il, oacc[db][1] * il); w.y = cvt_pk(oacc[db][2] * il, oacc[db][3] * il);
                    *(v2u*)(CAT + (size_t)qrow * D + h * 64 + 16 * db + 4 * fq) = w; }
            }
#undef STAGE_VROW
        }
        for (int u = vcu; u < 512; u += G) {
            int b, r, rows;
            if (u < 256) { b = u >> 5; r = u & 31; rows = 32; } else { b = 8 + ((u - 256) >> 7); r = (u - 256) & 127; rows = 128; }
            const int base = b < 8 ? b * 2048 : NPR + (b - 8) * 8192, T = rows * 64;
#pragma unroll 1
            for (int k = 0; k < 8; ++k) {
                const int idx = tid + 512 * k, tl = idx >> 6, ch = idx & 63, g = ch >> 4, hw = 1 << g;
                const int t = r * 64 + tl, lo = max(t - hw, 0), hi = min(t + hw, T);
                float sacc[8];
#pragma unroll
                for (int i = 0; i < 8; ++i) sacc[i] = 0.f;
                for (int s = lo; s < hi; ++s) { const v4u w = *(const v4u*)(PROJ + (size_t)(base + s) * INW + 3 * ATTW + 8 * ch);
                    sacc[0] += bflo(w.x); sacc[1] += bfhi(w.x); sacc[2] += bflo(w.y); sacc[3] += bfhi(w.y); sacc[4] += bflo(w.z); sacc[5] += bfhi(w.z); sacc[6] += bflo(w.w); sacc[7] += bfhi(w.w); }
                const float ic = 1.0f / (float)(hi - lo);
                const v4u w = *(const v4u*)(PROJ + (size_t)(base + t) * INW + 3 * ATTW + 8 * ch);
                v4u ow; ow.x = pk2(sacc[0] * ic - bflo(w.x), sacc[1] * ic - bfhi(w.x)); ow.y = pk2(sacc[2] * ic - bflo(w.y), sacc[3] * ic - bfhi(w.y));
                ow.z = pk2(sacc[4] * ic - bflo(w.z), sacc[5] * ic - bfhi(w.z)); ow.w = pk2(sacc[6] * ic - bflo(w.w), sacc[7] * ic - bfhi(w.w));
                *(v4u*)(CAT + (size_t)(base + t) * D + ATTW + 8 * ch) = ow;
            }
        }
    }
    SEAM(3);

    if (IN(4)) {
        pg8::Gemm g{CAT, WoT, MT, D, D}; pg8::StaticOrder S; S.init(MT, D, G, bx);
        EpiOut E{a.in[I_XP], a.in[I_XS], a.out, XG2, rss2, macc, b_ada, a.in[I_N2G]};
        pg8::gemm_phase<EpiOut, pg8::StaticOrder, PG8_ALIGN, PG8_SP2>(lds + RING_OFF, g, S, E);
    }
    SEAM(4);

    const int nchunks = one_launch ? 6 : 1;
#pragma unroll 1
    for (int ck = 0; ck < nchunks; ++ck) {
    const int row0 = one_launch ? (ck < 4 ? 4096 * ck : NPR + 8192 * (ck - 4)) : a.row0, nrows = one_launch ? (ck < 4 ? 4096 : 8192) : a.nrows;
    if (IN(5)) {
        pg8::Gemm g{XG2 + (size_t)row0 * D, WupT, nrows, FF2, D}; pg8::StaticOrder S; S.init(nrows, FF2, G, bx);
        EpiUp E{UPC, rss2, c2acc, row0};
        pg8::gemm_phase<EpiUp, pg8::StaticOrder, PG8_ALIGN, PG8_SP2>(lds + RING_OFF, g, S, E);
    }
    SEAM(5);

    if (IN(6)) {
        const int total = nrows * (FF / 8);
        for (int idx = vcu * 512 + tid; idx < total; idx += G * 512) {
            const int rl = idx / (FF / 8), f = 8 * (idx % (FF / 8)), gcol = (f >> 7) * 256 + (f & 127);
            const int row = row0 + rl, b = batch_of_row(row), t = row < NPR ? (row & 2047) : ((row - NPR) & 8191), T = b < 8 ? 2048 : 8192;
            const bool hm = t > 0, hp = t < T - 1;
            float res[2][8];
#pragma unroll
            for (int part = 0; part < 2; ++part) {
                const int col = gcol + 128 * part; const bf16* up = UPC + (size_t)rl * FF2 + col;
                const v4u z = {0u, 0u, 0u, 0u};
                const v4u u0 = *(const v4u*)up, um = hm ? *(const v4u*)(up - FF2) : z, upn = hp ? *(const v4u*)(up + FF2) : z;
                const f32x4 w0a = *(const f32x4*)(convp + col), w0b = *(const f32x4*)(convp + col + 4), w1a = *(const f32x4*)(convp + FF2 + col), w1b = *(const f32x4*)(convp + FF2 + col + 4);
                const f32x4 w2a = *(const f32x4*)(convp + 2 * FF2 + col), w2b = *(const f32x4*)(convp + 2 * FF2 + col + 4), cba = *(const f32x4*)(cbp + col), cbb = *(const f32x4*)(cbp + col + 4);
                res[part][0] = w0a[0] * bflo(um.x) + w1a[0] * bflo(u0.x) + w2a[0] * bflo(upn.x) + cba[0];
                res[part][1] = w0a[1] * bfhi(um.x) + w1a[1] * bfhi(u0.x) + w2a[1] * bfhi(upn.x) + cba[1];
                res[part][2] = w0a[2] * bflo(um.y) + w1a[2] * bflo(u0.y) + w2a[2] * bflo(upn.y) + cba[2];
                res[part][3] = w0a[3] * bfhi(um.y) + w1a[3] * bfhi(u0.y) + w2a[3] * bfhi(upn.y) + cba[3];
                res[part][4] = w0b[0] * bflo(um.z) + w1b[0] * bflo(u0.z) + w2b[0] * bflo(upn.z) + cbb[0];
                res[part][5] = w0b[1] * bfhi(um.z) + w1b[1] * bfhi(u0.z) + w2b[1] * bfhi(upn.z) + cbb[1];
                res[part][6] = w0b[2] * bflo(um.w) + w1b[2] * bflo(u0.w) + w2b[2] * bflo(upn.w) + cbb[2];
                res[part][7] = w0b[3] * bfhi(um.w) + w1b[3] * bfhi(u0.w) + w2b[3] * bfhi(upn.w) + cbb[3];
            }
            v4u ow; ow.x = pk2(silu_f(res[0][0]) * res[1][0], silu_f(res[0][1]) * res[1][1]); ow.y = pk2(silu_f(res[0][2]) * res[1][2], silu_f(res[0][3]) * res[1][3]);
            ow.z = pk2(silu_f(res[0][4]) * res[1][4], silu_f(res[0][5]) * res[1][5]); ow.w = pk2(silu_f(res[0][6]) * res[1][6], silu_f(res[0][7]) * res[1][7]);
            *(v4u*)(ACTC + (size_t)rl * FF + f) = ow;
        }
    }
    SEAM(6);

    if (IN(7)) {
        pg8::Gemm g{ACTC, WdT, nrows, D, FF}; pg8::StaticOrder S; S.init(nrows, D, G, bx);
        EpiDown E{a.out, macc, b_ada, row0};
        pg8::gemm_phase<EpiDown, pg8::StaticOrder, PG8_ALIGN, PG8_SP2>(lds + RING_OFF, g, S, E);
    }
    if (one_launch && ck + 1 < nchunks) xcd_barrier(bar);
    }
#undef IN
#undef SEAM
}

extern "C" void kernel_launch(void* const* d_in, const int* in_sizes, int n_in, void* d_out, int out_size, void* d_ws, size_t ws_size, hipStream_t stream) {
    static int grid = 0;
    if (grid == 0) {
        if (n_in != 19 || out_size != MT * D || ws_size < WS_END) { fprintf(stderr, "kernel_launch: unexpected shapes (n_in %d, out %d, ws %zu)\n", n_in, out_size, ws_size); grid = -1; return; }
        int dev = 0, cus = 0;
        if (hipGetDevice(&dev) != hipSuccess || hipDeviceGetAttribute(&cus, hipDeviceAttributeMultiprocessorCount, dev) != hipSuccess) { grid = -1; return; }
        if (hipFuncSetAttribute((const void*)fwd, hipFuncAttributeMaxDynamicSharedMemorySize, LDS_BYTES) != hipSuccess) { fprintf(stderr, "kernel_launch: hipFuncSetAttribute failed\n"); grid = -1; return; }
        (void)hipGetLastError();
        grid = cus;
    }
    if (grid < 0) return;
    if (hipMemsetAsync((char*)d_ws + WS_CTL, 0, CTL_ZERO_BYTES, stream) != hipSuccess) return;
    Args a{};
    for (int i = 0; i < 19; ++i) a.in[i] = (const float*)d_in[i];
    a.out = (float*)d_out; a.ws = (unsigned char*)d_ws;
#if MK_ONE_LAUNCH
    a.ph_lo = 0; a.ph_hi = N_PHASES; a.row0 = 0; a.nrows = 0; hipLaunchKernelGGL(fwd, dim3(grid), dim3(NWAVES * 64), LDS_BYTES, stream, a);
#else
    for (int ph = 0; ph < 5; ++ph) { a.ph_lo = ph; a.ph_hi = ph + 1; a.row0 = 0; a.nrows = 0; hipLaunchKernelGGL(fwd, dim3(grid), dim3(NWAVES * 64), LDS_BYTES, stream, a); }
    const int c_row0[6] = {0, 4096, 8192, 12288, 16384, 24576}, c_rows[6] = {4096, 4096, 4096, 4096, 8192, 8192};
    for (int c = 0; c < 6; ++c)
        for (int ph = 5; ph < 8; ++ph) { a.ph_lo = ph; a.ph_hi = ph + 1; a.row0 = c_row0[c]; a.nrows = c_rows[c]; hipLaunchKernelGGL(fwd, dim3(grid), dim3(NWAVES * 64), LDS_BYTES, stream, a); }
#endif
}
```

```cpp
#include <hip/hip_runtime.h>
#include <cstdio>
#include <cstdint>

constexpr int D = 1024, MT = 32768, NPR = 16384, INW = 2048, ATTW = 512, HD = 64, NH = 8, FF = 2816, FF2 = 5632, NBATCH = 10, MODW = 6144;
constexpr float EPS = 1e-6f;

namespace pg8 {
#define PG8_LAS __attribute__((address_space(3)))
typedef unsigned short bf16_t;
typedef short bf16x8 __attribute__((ext_vector_type(8)));
typedef float f32x4 __attribute__((ext_vector_type(4)));
typedef unsigned u32x4 __attribute__((ext_vector_type(4)));
constexpr int BM = 256, BK = 64, HALF = 128, HTB = HALF * BK * 2  , STAGE_BYTES = 8 * HTB, NXCD = 8, WGM = 8;

__host__ __device__ __forceinline__ int lds_byte(int r, int c) { const int st = (r >> 4) * 2 + (c >> 5), rr = r & 15, cc = c & 31, ob = rr * 64 + cc * 2; return st * 1024 + (ob ^ (((ob >> 9) & 1) << 5)); }
__host__ __device__ __forceinline__ void stage_rc(int b, int& R, int& C) { const int st = b / 1024, sb = b % 1024, swz = sb ^ (((sb >> 9) & 1) << 5); R = (st >> 1) * 16 + swz / 64; C = (st & 1) * 32 + (swz % 64) / 2; }
__host__ __device__ __forceinline__ int perm32(int rho) { const int n = rho >> 4, i = rho & 15; return 8 * (i >> 2) + 4 * n + (i & 3); }

struct Unit { int pm, pn; };
struct Gemm { const bf16_t* A; const bf16_t* Bt; int M, N, K; };

struct StaticOrder {
    int nM, nN, nwg, G, c;
    __host__ __device__ void init(int M, int N, int G_, int c_) { nM = M / BM; nN = N / BM; nwg = nM * nN; G = G_; c = c_; }
    __host__ __device__ bool next(int i, Unit& u) const {
        const long L = (long)i * G + c; if (L >= nwg) return false;
        int wgid = (int)L; { const int q = nwg / NXCD, r = nwg % NXCD, xcd = wgid % NXCD, off = wgid / NXCD; wgid = (xcd < r ? xcd * (q + 1) : r * (q + 1) + (xcd - r) * q) + off; }
        const int nig = WGM * nN, gid = wgid / nig, fm = gid * WGM, gsz = (nM - fm) < WGM ? (nM - fm) : WGM;
        u.pm = fm + ((wgid % nig) % gsz); u.pn = (wgid % nig) / gsz; return true;
    }
    __device__ __forceinline__ void a_ready(const Unit&) const {}
    __device__ __forceinline__ void done(const Unit&) const {}
};

template <class Epi, class Sched, bool ALIGN_EPI = false, bool SP2 = false>
__device__ __forceinline__ void gemm_phase(PG8_LAS unsigned char* lds, const Gemm g, const Sched& S, const Epi& E) {
    const int tid = threadIdx.x, wid = __builtin_amdgcn_readfirstlane(tid >> 6), lane = tid & 63, wr = wid >> 2, wc = wid & 3, fr = lane & 15, fq = lane >> 4;
    const int K = g.K, nt = K / BK;
    unsigned voffA[2], voffB[2];
#pragma unroll
    for (int i = 0; i < 2; ++i) { int R, C; stage_rc(tid * 16 + i * 8192, R, C); const int Rb = Epi::PERM ? ((R & ~31) + perm32(R & 31)) : R;
        const int Ra = Epi::PERMA ? ((R & 64) + 4 * (R & 15) + ((R >> 4) & 3)) : R;
        voffA[i] = (unsigned)(Ra * K + C) * 2u; voffB[i] = (unsigned)(Rb * K + C) * 2u; }
    const size_t kstep = (size_t)(BK * 2);
    const size_t hstep = (size_t)HALF * K * 2;
    const size_t tstep = 2 * hstep;
    const unsigned ldsw = (unsigned)wid * 1024u;
    const int aoff = lds_byte(wr * 64 + fr, fq * 8), boff = lds_byte(wc * 32 + fr, fq * 8);
#define PG8_SA(b, h) (((b) * 2 + (h)) * HTB)
#define PG8_SB(b, h) ((4 + (b) * 2 + (h)) * HTB)
#define PG8_STAGE(bufoff, gbase, voff) do { _Pragma("unroll") for (int _i = 0; _i < 2; ++_i) \
        __builtin_amdgcn_global_load_lds((const unsigned*)((const char*)(gbase) + (voff)[_i]), (PG8_LAS unsigned*)(lds + (bufoff) + ldsw + _i * 8192), 16, 0, 0); } while (0)
#define PG8_LDA(dst, b, h) do { _Pragma("unroll") for (int m = 0; m < 4; ++m) _Pragma("unroll") for (int k = 0; k < 2; ++k) dst[m][k] = *(const PG8_LAS bf16x8*)(lds + PG8_SA(b, h) + aoff + m * 2048 + k * 1024); } while (0)
#define PG8_LDB(dst, b, h) do { _Pragma("unroll") for (int n = 0; n < 2; ++n) _Pragma("unroll") for (int k = 0; k < 2; ++k) dst[n][k] = *(const PG8_LAS bf16x8*)(lds + PG8_SB(b, h) + boff + n * 2048 + k * 1024); } while (0)
#define PG8_MMA(ai, bj, At, Bt) do { __builtin_amdgcn_s_setprio(1); _Pragma("unroll") for (int m = 0; m < 4; ++m) _Pragma("unroll") for (int n = 0; n < 2; ++n) _Pragma("unroll") for (int k = 0; k < 2; ++k) \
        acc[ai][bj][m][n] = __builtin_amdgcn_mfma_f32_16x16x32_bf16(Bt[n][k], At[m][k], acc[ai][bj][m][n], 0, 0, 0); __builtin_amdgcn_s_setprio(0); } while (0)
#define PG8_WAIT_V(n) asm volatile("s_waitcnt vmcnt(" #n ")" ::: "memory")
#define PG8_WAIT_L(n) asm volatile("s_waitcnt lgkmcnt(" #n ")" ::: "memory")
#define PG8_BAR __builtin_amdgcn_s_barrier()
#define PG8_SCHED __builtin_amdgcn_sched_barrier(0)
    Unit cur, nxt; int ui = 0;
    if (!S.next(0, cur)) return;
    f32x4 acc[2][2][4][2];
#pragma unroll
    for (int a = 0; a < 2; ++a)
#pragma unroll
        for (int b = 0; b < 2; ++b)
#pragma unroll
            for (int m = 0; m < 4; ++m)
#pragma unroll
                for (int n = 0; n < 2; ++n) acc[a][b][m][n] = (f32x4){0.f, 0.f, 0.f, 0.f};
    bf16x8 At[4][2], B0[2][2], B1[2][2];
    const char* cA = (const char*)g.A + (size_t)cur.pm * tstep; const char* cB = (const char*)g.Bt + (size_t)cur.pn * tstep;
    S.a_ready(cur);
    if constexpr (SP2) {
        PG8_STAGE(PG8_SB(0, 0), cB, voffB); PG8_STAGE(PG8_SB(0, 1), cB + hstep, voffB); PG8_STAGE(PG8_SA(0, 0), cA, voffA); PG8_STAGE(PG8_SA(0, 1), cA + hstep, voffA);
        if (wr == 1) PG8_BAR;
        PG8_WAIT_V(2); PG8_BAR;
        PG8_STAGE(PG8_SB(1, 0), cB + kstep, voffB); PG8_STAGE(PG8_SA(1, 0), cA + kstep, voffA); PG8_STAGE(PG8_SB(1, 1), cB + hstep + kstep, voffB);
        PG8_WAIT_V(6); PG8_BAR;
    } else {
        PG8_STAGE(PG8_SB(0, 0), cB, voffB); PG8_STAGE(PG8_SA(0, 0), cA, voffA); PG8_STAGE(PG8_SB(0, 1), cB + hstep, voffB); PG8_STAGE(PG8_SA(0, 1), cA + hstep, voffA);
        if (wr == 1) PG8_BAR;
        PG8_WAIT_V(4); PG8_BAR;
        PG8_STAGE(PG8_SB(1, 0), cB + kstep, voffB); PG8_STAGE(PG8_SA(1, 0), cA + kstep, voffA); PG8_STAGE(PG8_SB(1, 1), cB + hstep + kstep, voffB);
        PG8_WAIT_V(6); PG8_BAR;
    }
    for (;;) {
        const bool has_next = S.next(ui + 1, nxt);
        const char* nA = has_next ? (const char*)g.A + (size_t)nxt.pm * tstep : cA; const char* nB = has_next ? (const char*)g.Bt + (size_t)nxt.pn * tstep : cB;
        for (int t = 0; t < nt; t += 2) {
            const bool last = (t == nt - 2);
            const char* a1 = cA + (size_t)(t + 1) * kstep;
            const char* a2 = last ? nA : cA + (size_t)(t + 2) * kstep; const char* b2 = last ? nB : cB + (size_t)(t + 2) * kstep;
            const char* a3 = a2 + kstep; const char* b3 = b2 + kstep;
            if (last && has_next) S.a_ready(nxt);
            if constexpr (SP2) {
            PG8_LDB(B0, 0, 0); PG8_LDB(B1, 0, 1); PG8_SCHED; PG8_LDA(At, 0, 0); PG8_STAGE(PG8_SA(1, 1), a1 + hstep, voffA);
            PG8_WAIT_V(8); PG8_WAIT_L(0); PG8_BAR; PG8_MMA(0, 0, At, B0); PG8_MMA(0, 1, At, B1); PG8_BAR; PG8_SCHED;
            PG8_LDA(At, 0, 1); PG8_STAGE(PG8_SB(0, 0), b2, voffB); PG8_STAGE(PG8_SB(0, 1), b2 + hstep, voffB); PG8_STAGE(PG8_SA(0, 0), a2, voffA);
            PG8_WAIT_V(8); PG8_WAIT_L(0); PG8_BAR; PG8_MMA(1, 0, At, B0); PG8_MMA(1, 1, At, B1); PG8_BAR; PG8_SCHED;
            PG8_LDB(B0, 1, 0); PG8_LDB(B1, 1, 1); PG8_SCHED; PG8_LDA(At, 1, 0); PG8_STAGE(PG8_SA(0, 1), a2 + hstep, voffA);
            PG8_WAIT_V(8); PG8_WAIT_L(0); PG8_BAR; PG8_MMA(0, 0, At, B0); PG8_MMA(0, 1, At, B1); PG8_BAR; PG8_SCHED;
            PG8_LDA(At, 1, 1); PG8_STAGE(PG8_SB(1, 0), b3, voffB); PG8_STAGE(PG8_SB(1, 1), b3 + hstep, voffB); PG8_STAGE(PG8_SA(1, 0), a3, voffA);
            PG8_WAIT_V(8); PG8_WAIT_L(0); PG8_BAR; PG8_MMA(1, 0, At, B0); PG8_MMA(1, 1, At, B1); PG8_BAR; PG8_SCHED;
            } else {
            PG8_LDB(B0, 0, 0); PG8_SCHED; PG8_LDA(At, 0, 0); PG8_STAGE(PG8_SA(1, 1), a1 + hstep, voffA);
            PG8_WAIT_L(8); PG8_BAR; PG8_WAIT_L(0); PG8_MMA(0, 0, At, B0); PG8_BAR; PG8_SCHED;
            PG8_LDB(B1, 0, 1); PG8_STAGE(PG8_SB(0, 0), b2, voffB);
            PG8_BAR; PG8_WAIT_L(0); PG8_MMA(0, 1, At, B1); PG8_BAR;
            PG8_LDA(At, 0, 1); PG8_STAGE(PG8_SA(0, 0), a2, voffA);
            PG8_BAR; PG8_WAIT_L(0); PG8_MMA(1, 0, At, B0); PG8_BAR; PG8_SCHED;
            PG8_STAGE(PG8_SB(0, 1), b2 + hstep, voffB);
            PG8_WAIT_V(6); PG8_BAR; PG8_MMA(1, 1, At, B1); PG8_BAR;
            PG8_LDB(B0, 1, 0); PG8_SCHED; PG8_LDA(At, 1, 0); PG8_STAGE(PG8_SA(0, 1), a2 + hstep, voffA);
            PG8_WAIT_L(8); PG8_BAR; PG8_WAIT_L(0); PG8_MMA(0, 0, At, B0); PG8_BAR; PG8_SCHED;
            PG8_LDB(B1, 1, 1); PG8_STAGE(PG8_SB(1, 0), b3, voffB);
            PG8_BAR; PG8_WAIT_L(0); PG8_MMA(0, 1, At, B1); PG8_BAR;
            PG8_LDA(At, 1, 1); PG8_STAGE(PG8_SA(1, 0), a3, voffA);
            PG8_BAR; PG8_WAIT_L(0); PG8_MMA(1, 0, At, B0); PG8_BAR; PG8_SCHED;
            PG8_STAGE(PG8_SB(1, 1), b3 + hstep, voffB);
            PG8_WAIT_V(6); PG8_BAR; PG8_MMA(1, 1, At, B1); PG8_BAR;
            }
        }
        if constexpr (ALIGN_EPI) { if (wr == 0) PG8_BAR; }
        if constexpr (!Epi::AFTER_DRAIN) { E(acc, cur, wr, wc, fr, fq); S.done(cur); }
        if (!has_next) break;
#pragma unroll
        for (int a = 0; a < 2; ++a)
#pragma unroll
            for (int b = 0; b < 2; ++b)
#pragma unroll
                for (int m = 0; m < 4; ++m)
#pragma unroll
                    for (int n = 0; n < 2; ++n) acc[a][b][m][n] = (f32x4){0.f, 0.f, 0.f, 0.f};
        cur = nxt; cA = nA; cB = nB; ++ui;
        if constexpr (ALIGN_EPI) { if (wr == 1) PG8_BAR; }
    }
    PG8_WAIT_V(0);
    if constexpr (!ALIGN_EPI) { if (wr == 0) PG8_BAR; }
    PG8_BAR;
    if constexpr (Epi::AFTER_DRAIN) { E.fused(acc, cur, wr, wc, fr, fq, lds, wid, lane); S.done(cur); }
#undef PG8_SA
#undef PG8_SB
#undef PG8_STAGE
#undef PG8_LDA
#undef PG8_LDB
#undef PG8_MMA
#undef PG8_WAIT_V
#undef PG8_WAIT_L
#undef PG8_BAR
#undef PG8_SCHED
}
}
#ifndef PG8_SP2
#define PG8_SP2 true
#endif
#ifndef PG8_ALIGN
#define PG8_ALIGN true
#endif
constexpr size_t MiB = 1u << 20;
constexpr size_t WS_CTL = 0, CTL_ZERO_BYTES = 3 * MiB;
constexpr size_t OFF_MOD = 65536, OFF_C2 = 327680, OFF_RSS2 = 589824, OFF_HSS = 1 * MiB;
constexpr size_t WS_WUP = 3 * MiB, WS_WDN = 3 * MiB, WS_SMALL = 14 * MiB, WS_H1 = 16 * MiB, WS_MIXB = 16 * MiB, WS_ACT = 80 * MiB, WS_CAT = 80 * MiB, WS_WIN = 144 * MiB, WS_WOUT = 148 * MiB;
constexpr size_t DO_PROJ = 0, DO_XG2 = 0, DO_EDGE = 64 * MiB;
constexpr size_t WS_END = 256 * MiB;
constexpr int CW_BAR = 4096;
constexpr int RING_OFF = 0, RING_BYTES = 131072, LDSCTL_OFF = RING_BYTES, MISC_OFF = LDSCTL_OFF + 320, LDS_BYTES = 147456;
constexpr int NWAVES = 8;
constexpr int XCH_OFF = LDSCTL_OFF + 1024;
constexpr int BIAS_OFF = LDSCTL_OFF + 1024, RK_OFF = LDSCTL_OFF + 4096;

#define GAS __attribute__((address_space(1)))
#define LAS __attribute__((address_space(3)))
typedef unsigned short bf16;
typedef unsigned v4u __attribute__((ext_vector_type(4)));
typedef unsigned v2u __attribute__((ext_vector_type(2)));
using pg8::f32x4;
#define LDS_WAIT() asm volatile("s_waitcnt lgkmcnt(0)" ::: "memory")
#define VM_WAIT() asm volatile("s_waitcnt vmcnt(0)" ::: "memory")
__device__ __forceinline__ unsigned f2bf(float f) { unsigned u = __builtin_bit_cast(unsigned, f); return (u + 0x7fffu + ((u >> 16) & 1u)) >> 16; }
__device__ __forceinline__ unsigned pk2(float lo, float hi) { return f2bf(lo) | (f2bf(hi) << 16); }
__device__ __forceinline__ float bflo(unsigned w) { return __builtin_bit_cast(float, w << 16); }
__device__ __forceinline__ float bfhi(unsigned w) { return __builtin_bit_cast(float, w & 0xffff0000u); }
__device__ __forceinline__ unsigned cvt_pk(float lo, float hi) { unsigned r; asm volatile("v_cvt_pk_bf16_f32 %0, %1, %2" : "=v"(r) : "v"(lo), "v"(hi)); return r; }
__device__ __forceinline__ int batch_of_row(int row) { return row < NPR ? (row >> 11) : 8 + ((row - NPR) >> 13); }
__device__ __forceinline__ int batch_of_tile(int pm) { return pm < 64 ? (pm >> 3) : 8 + ((pm - 64) >> 5); }
__device__ __forceinline__ int permcol(int n) { const int f = n < FF ? n : n - FF; return (f >> 7) * 256 + (f & 127) + (n < FF ? 0 : 128); }
__device__ __forceinline__ float wave_sum(float v) {
#pragma unroll
    for (int o = 1; o < 64; o <<= 1) v += __shfl_xor(v, o);
    return v;
}
__device__ __forceinline__ float silu_f(float x) { return x / (1.0f + __expf(-x)); }

#define XB_TMO      128
#define XB_XCNT(j)  (256  + 64 * (j))
#define XB_XSUB(j)  (1280 + 64 * (j))
#define XB_XGEN(j)  (2304 + 64 * (j))
#define XB_TOP      3328
#define XB_TOPGEN   3392
#define XCD_BAR_WORDS 3456
#define XB_SPIN_CAP (1u << 18)

__device__ __forceinline__ unsigned xb_ld(unsigned* p)              { return __hip_atomic_load(p, __ATOMIC_RELAXED, __HIP_MEMORY_SCOPE_AGENT); }
__device__ __forceinline__ unsigned xb_add(unsigned* p, unsigned v) { return __hip_atomic_fetch_add(p, v, __ATOMIC_RELAXED, __HIP_MEMORY_SCOPE_AGENT); }
__device__ __forceinline__ unsigned xb_xcc_id() { return (unsigned)__builtin_amdgcn_s_getreg((3 << 11) | 20) & 0xFu; }
#define XB_SPIN(cond, bar) do { unsigned _sp = 0; while (cond) { __builtin_amdgcn_s_sleep(1); \
    if ((++_sp & 255u) == 0u) { if (xb_ld(&(bar)[XB_TMO])) break; if (_sp > XB_SPIN_CAP) { atomicAdd(&(bar)[XB_TMO], 1u); break; } } } } while (0)

struct XcdBarrier {
    unsigned* bar; unsigned x;
    volatile LAS unsigned* st;
};

__device__ __forceinline__ XcdBarrier xcd_barrier_post(unsigned* bar, volatile LAS unsigned* st) {
    XcdBarrier b; b.bar = bar; b.x = xb_xcc_id(); b.st = st;
    if (threadIdx.x == 0) (void)xb_add(&bar[XB_XCNT(b.x)], 1u);
    return b;
}
__device__ __forceinline__ void xcd_barrier_complete(unsigned* bar, unsigned x, unsigned& nloc, unsigned& nx) {
    const unsigned G = gridDim.x * gridDim.y * gridDim.z;
    unsigned sum, cnt, mine, sp = 0u;
    for (;;) {
        sum = 0u; cnt = 0u; mine = 0u;
#pragma unroll
        for (unsigned j = 0; j < 16; ++j) { const unsigned c = xb_ld(&bar[XB_XCNT(j)]); sum += c; cnt += (c > 0u) ? 1u : 0u; mine = (j == x) ? c : mine; }
        if (sum == G) break;
        __builtin_amdgcn_s_sleep(1);
        if ((++sp & 255u) == 0u) { if (xb_ld(&bar[XB_TMO])) break; if (sp > XB_SPIN_CAP) { atomicAdd(&bar[XB_TMO], 1u); break; } }
    }
    nloc = mine > 0u ? mine : 1u; nx = cnt > 0u ? cnt : 1u;
}

__device__ __forceinline__ void xcd_barrier(const XcdBarrier& b) {
    asm volatile("s_waitcnt vmcnt(0)" ::: "memory");
    __syncthreads();
    if (threadIdx.x == 0) {
        unsigned* bar = b.bar;
        __builtin_amdgcn_s_waitcnt(0);
        unsigned nloc = b.st[0], nx = b.st[1];
        if (nloc == 0u) { xcd_barrier_complete(bar, b.x, nloc, nx); b.st[0] = nloc; b.st[1] = nx; }
        const unsigned old = xb_add(&bar[XB_XSUB(b.x)], 1u);
        const unsigned gen = old / nloc;
        if (old + 1u == (gen + 1u) * nloc) {
            __builtin_amdgcn_fence(__ATOMIC_RELEASE, "agent");
            asm volatile("s_waitcnt vmcnt(0)" ::: "memory");
            const unsigned og = xb_add(&bar[XB_TOP], 1u);
            const unsigned tg = og / nx;
            if (og + 1u == (tg + 1u) * nx) xb_add(&bar[XB_TOPGEN], 1u);
            else XB_SPIN(xb_ld(&bar[XB_TOPGEN]) == tg, bar);
            __builtin_amdgcn_fence(__ATOMIC_ACQUIRE, "agent");
            xb_add(&bar[XB_XGEN(b.x)], 1u);
            asm volatile("s_waitcnt vmcnt(0)" ::: "memory");
        } else {
            XB_SPIN(xb_ld(&bar[XB_XGEN(b.x)]) == gen, bar);
            __builtin_amdgcn_fence(__ATOMIC_ACQUIRE, "agent");
            asm volatile("s_waitcnt vmcnt(0)" ::: "memory");
        }
    }
    __syncthreads();
}
typedef const f32x4 (&AccRef)[2][2][4][2];
__device__ __forceinline__ float modv(const float* macc, const float* b_ada, int b, int j) { return macc[b * MODW + j] + b_ada[j]; }
__device__ __forceinline__ f32x4 modv4(const float* macc, const float* b_ada, int b, int j) { return *(const f32x4*)(macc + b * MODW + j) + *(const f32x4*)(b_ada + j); }

struct EpiProj {
    static constexpr bool PERM = true, PERMA = false, AFTER_DRAIN = false;
    bf16* O; float* hss;
    __device__ __forceinline__ void operator()(AccRef acc, const pg8::Unit& u, int wr, int wc, int fr, int fq) const {
        const int row0 = u.pm * 256 + wr * 64 + fr, col0 = u.pn * 256 + wc * 32 + 8 * fq;
#pragma unroll
        for (int ai = 0; ai < 2; ++ai)
#pragma unroll
            for (int m = 0; m < 4; ++m) { bf16* rowp = O + (size_t)(row0 + ai * 128 + m * 16) * INW + col0;
#pragma unroll
                for (int bj = 0; bj < 2; ++bj) { const f32x4 v0 = acc[ai][bj][m][0], v1 = acc[ai][bj][m][1];
                    v4u w; w.x = cvt_pk(v0[0], v0[1]); w.y = cvt_pk(v0[2], v0[3]); w.z = cvt_pk(v1[0], v1[1]); w.w = cvt_pk(v1[2], v1[3]);
                    *(v4u*)(rowp + bj * 128) = w; } }
        if (u.pn < 4) {
#pragma unroll
            for (int ai = 0; ai < 2; ++ai)
#pragma unroll
                for (int m = 0; m < 4; ++m)
#pragma unroll
                    for (int bj = 0; bj < 2; ++bj) { const f32x4 v0 = acc[ai][bj][m][0], v1 = acc[ai][bj][m][1];
                        float s = ((v0[0] * v0[0] + v0[1] * v0[1]) + (v0[2] * v0[2] + v0[3] * v0[3])) + ((v1[0] * v1[0] + v1[1] * v1[1]) + (v1[2] * v1[2] + v1[3] * v1[3]));
                        s += __shfl_xor(s, 16); s += __shfl_xor(s, 32);
                        if (fq == 0) atomicAdd(hss + (size_t)(4 * u.pn + 2 * bj + (wc >> 1)) * MT + row0 + ai * 128 + m * 16, s); }
        }
    }
};
struct EpiOut {
    static constexpr bool PERM = false, PERMA = false, AFTER_DRAIN = false;
    const float* xp; const float* xs; bf16* mixb; bf16* xg2; float* rss2; const float* macc; const float* b_ada; const float* n2g;
    __device__ __forceinline__ void operator()(AccRef acc, const pg8::Unit& u, int wr, int wc, int fr, int fq) const {
        const int b = batch_of_tile(u.pm), row0 = u.pm * 256 + wr * 64 + fr, col0 = u.pn * 256 + wc * 32 + 4 * fq;
        float ss[2][4];
#pragma unroll
        for (int ai = 0; ai < 2; ++ai)
#pragma unroll
            for (int m = 0; m < 4; ++m) ss[ai][m] = 0.f;
#pragma unroll
        for (int bj = 0; bj < 2; ++bj)
#pragma unroll
            for (int n = 0; n < 2; ++n) {
                const int c = col0 + bj * 128 + n * 16;
                const f32x4 g1 = modv4(macc, b_ada, b, 2 * D + c), G2 = *(const f32x4*)(n2g + c) * (modv4(macc, b_ada, b, 4 * D + c) + 1.0f);
#pragma unroll
                for (int ai = 0; ai < 2; ++ai)
#pragma unroll
                    for (int m = 0; m < 4; ++m) {
                        const int row = row0 + ai * 128 + m * 16;
                        const float* xrow = row < NPR ? xp + (size_t)row * D : xs + (size_t)(row - NPR) * D;
                        const f32x4 av = acc[ai][bj][m][n];
                        const f32x4 v = *(const f32x4*)(xrow + c) + g1 * av;
                        v2u mw; mw.x = cvt_pk(av[0], av[1]); mw.y = cvt_pk(av[2], av[3]);
                        *(v2u*)(mixb + (size_t)row * D + c) = mw;
                        ss[ai][m] += (v[0] * v[0] + v[1] * v[1]) + (v[2] * v[2] + v[3] * v[3]);
                        const f32x4 g = v * G2; v2u w; w.x = cvt_pk(g[0], g[1]); w.y = cvt_pk(g[2], g[3]);
                        *(v2u*)(xg2 + (size_t)row * D + c) = w;
                    }
            }
#pragma unroll
        for (int ai = 0; ai < 2; ++ai)
#pragma unroll
            for (int m = 0; m < 4; ++m) { float s = ss[ai][m]; s += __shfl_xor(s, 16); s += __shfl_xor(s, 32);
                if (fq == 0) atomicAdd(rss2 + row0 + ai * 128 + m * 16, s); }
    }
};
__device__ __forceinline__ float dpp_shr1(float old, float src) { return __builtin_bit_cast(float, __builtin_amdgcn_update_dpp(__builtin_bit_cast(int, old), __builtin_bit_cast(int, src), 0x111, 0xf, 0xf, false)); }
__device__ __forceinline__ float dpp_shl1(float old, float src) { return __builtin_bit_cast(float, __builtin_amdgcn_update_dpp(__builtin_bit_cast(int, old), __builtin_bit_cast(int, src), 0x101, 0xf, 0xf, false)); }
struct EpiConvAct {
    static constexpr bool PERM = true, PERMA = true, AFTER_DRAIN = false;
    bf16* act; float* edge; const float* rss2; const float* c2; const float* convp; const float* cbp; LAS float* X;
    __device__ __forceinline__ void operator()(AccRef acc, const pg8::Unit& u, int wr, int wc, int fr, int fq) const {
        const int b = batch_of_tile(u.pm), colL = wc * 32 + 8 * fq, colg = u.pn * 256 + colL;
        f32x4 rs[2];
#pragma unroll
        for (int ai = 0; ai < 2; ++ai) { const f32x4 q = *(const f32x4*)(rss2 + u.pm * 256 + 128 * ai + 64 * wr + 4 * fr);
            rs[ai][0] = rsqrtf(q[0] * (1.0f / D) + EPS); rs[ai][1] = rsqrtf(q[1] * (1.0f / D) + EPS); rs[ai][2] = rsqrtf(q[2] * (1.0f / D) + EPS); rs[ai][3] = rsqrtf(q[3] * (1.0f / D) + EPS); }
#pragma unroll
        for (int bj = 0; bj < 2; ++bj)
#pragma unroll
            for (int n = 0; n < 2; ++n) { const f32x4 c2v = *(const f32x4*)(c2 + b * FF2 + colg + 128 * bj + 4 * n);
#pragma unroll
                for (int ai = 0; ai < 2; ++ai) { const int rb = 2 * ai + wr;
                    if (fr == 0)  *(LAS f32x4*)(X + (rb * 2 + 0) * 256 + 128 * bj + colL + 4 * n) = acc[ai][bj][0][n] * rs[ai][0] + c2v;
                    if (fr == 15) *(LAS f32x4*)(X + (rb * 2 + 1) * 256 + 128 * bj + colL + 4 * n) = acc[ai][bj][3][n] * rs[ai][3] + c2v; } }
        asm volatile("s_waitcnt lgkmcnt(0)" ::: "memory"); __builtin_amdgcn_s_barrier(); asm volatile("" ::: "memory");
#pragma unroll
        for (int ai = 0; ai < 2; ++ai) { const int rb = 2 * ai + wr;
#pragma unroll
            for (int n = 0; n < 2; ++n) {
                f32x4 cv[2][4];
#pragma unroll
                for (int bj = 0; bj < 2; ++bj) { const int col = colg + 128 * bj + 4 * n;
                    const f32x4 c2v = *(const f32x4*)(c2 + b * FF2 + col);
                    const f32x4 w0 = *(const f32x4*)(convp + col), w1 = *(const f32x4*)(convp + FF2 + col), w2 = *(const f32x4*)(convp + 2 * FF2 + col), cb = *(const f32x4*)(cbp + col);
                    f32x4 U[4];
#pragma unroll
                    for (int m = 0; m < 4; ++m) U[m] = acc[ai][bj][m][n] * rs[ai][m] + c2v;
                    const f32x4 zero = {0.f, 0.f, 0.f, 0.f};
                    const f32x4 above = rb > 0 ? *(const LAS f32x4*)(X + ((rb - 1) * 2 + 1) * 256 + 128 * bj + colL + 4 * n) : zero;
                    const f32x4 below = rb < 3 ? *(const LAS f32x4*)(X + ((rb + 1) * 2 + 0) * 256 + 128 * bj + colL + 4 * n) : zero;
                    f32x4 up0, dn3;
#pragma unroll
                    for (int e = 0; e < 4; ++e) { up0[e] = dpp_shr1(above[e], U[3][e]); dn3[e] = dpp_shl1(below[e], U[0][e]); }
                    cv[bj][0] = w0 * up0 + w1 * U[0] + w2 * U[1] + cb;
                    cv[bj][1] = w0 * U[0] + w1 * U[1] + w2 * U[2] + cb;
                    cv[bj][2] = w0 * U[1] + w1 * U[2] + w2 * U[3] + cb;
                    cv[bj][3] = w0 * U[2] + w1 * U[3] + w2 * dn3 + cb;
                    if (rb == 0 && fr == 0) { float* ep = edge + ((size_t)u.pm * 4 + 0) * FF2 + col; *(f32x4*)ep = U[0]; *(f32x4*)(ep + FF2) = U[1]; }
                    if (rb == 3 && fr == 15) { float* ep = edge + ((size_t)u.pm * 4 + 2) * FF2 + col; *(f32x4*)ep = U[2]; *(f32x4*)(ep + FF2) = U[3]; }
                }
#pragma unroll
                for (int m = 0; m < 4; ++m) {
                    const int tr = 128 * ai + 64 * wr + 4 * fr + m;
                    f32x4 av;
#pragma unroll
                    for (int e = 0; e < 4; ++e) { const float g = cv[0][m][e]; av[e] = g * __builtin_amdgcn_rcpf(1.0f + __builtin_amdgcn_exp2f(g * -1.4426950408889634f)) * cv[1][m][e]; }
                    v2u w; w.x = cvt_pk(av[0], av[1]); w.y = cvt_pk(av[2], av[3]);
                    if (tr != 0 && tr != 255) *(v2u*)(act + (size_t)(u.pm * 256 + tr) * FF + u.pn * 128 + colL + 4 * n) = w;
                }
            }
        }
    }
};
struct EpiDown {
    static constexpr bool PERM = false, PERMA = false, AFTER_DRAIN = false;
    const float* xp; const float* xs; const bf16* mixb; float* out; const float* macc; const float* b_ada;
    __device__ __forceinline__ void operator()(AccRef acc, const pg8::Unit& u, int wr, int wc, int fr, int fq) const {
        const int b = batch_of_tile(u.pm), row0 = u.pm * 256 + wr * 64 + fr, col0 = u.pn * 256 + wc * 32 + 4 * fq;
#pragma unroll
        for (int bj = 0; bj < 2; ++bj)
#pragma unroll
            for (int n = 0; n < 2; ++n) {
                const int c = col0 + bj * 128 + n * 16;
                const f32x4 g1 = modv4(macc, b_ada, b, 2 * D + c), g2 = modv4(macc, b_ada, b, 5 * D + c);
#pragma unroll
                for (int ai = 0; ai < 2; ++ai)
#pragma unroll
                    for (int m = 0; m < 4; ++m) { const int row = row0 + ai * 128 + m * 16;
                        const float* xrow = row < NPR ? xp + (size_t)row * D : xs + (size_t)(row - NPR) * D;
                        const v2u mw = *(const v2u*)(mixb + (size_t)row * D + c);
                        f32x4 mv; mv[0] = bflo(mw.x); mv[1] = bfhi(mw.x); mv[2] = bflo(mw.y); mv[3] = bfhi(mw.y);
                        *(f32x4*)(out + (size_t)row * D + c) = *(const f32x4*)(xrow + c) + g1 * mv + g2 * acc[ai][bj][m][n]; }
            }
    }
};

__device__ __forceinline__ void transpose_item(const float* W, int ldw, int k0, int n0, bf16* WT, int ldt, int drow0, int kd0, LAS float* scr, int lane) {
#pragma unroll 8
    for (int i = 0; i < 32; ++i) { const int kk = 2 * i + (lane >> 5); scr[kk * 33 + (lane & 31)] = W[(size_t)(k0 + kk) * ldw + n0 + (lane & 31)]; }
    LDS_WAIT(); asm volatile("" ::: "memory");
    const int c = lane & 7;
#pragma unroll
    for (int j = 0; j < 4; ++j) { const int n = (lane >> 3) + 8 * j; const LAS float* s = scr + (8 * c) * 33 + n;
        v4u o; o.x = pk2(s[0 * 33], s[1 * 33]); o.y = pk2(s[2 * 33], s[3 * 33]); o.z = pk2(s[4 * 33], s[5 * 33]); o.w = pk2(s[6 * 33], s[7 * 33]);
        *(v4u*)(WT + (size_t)(drow0 + n) * ldt + kd0 + 8 * c) = o; }
    LDS_WAIT(); asm volatile("" ::: "memory");
}
__device__ __forceinline__ void gemv10_item(const float* W, int ldw, int k0, int n, LAS float* sb, float* dst, int dstride, int dcol) {
    float acc[NBATCH];
#pragma unroll
    for (int b = 0; b < NBATCH; ++b) acc[b] = 0.f;
#pragma unroll 4
    for (int kk = 0; kk < 64; ++kk) {
        const float w = W[(size_t)(k0 + kk) * ldw + n];
        const f32x4 s0 = *(const LAS f32x4*)(sb + kk * 12), s1 = *(const LAS f32x4*)(sb + kk * 12 + 4), s2 = *(const LAS f32x4*)(sb + kk * 12 + 8);
        acc[0] += w * s0[0]; acc[1] += w * s0[1]; acc[2] += w * s0[2]; acc[3] += w * s0[3];
        acc[4] += w * s1[0]; acc[5] += w * s1[1]; acc[6] += w * s1[2]; acc[7] += w * s1[3];
        acc[8] += w * s2[0]; acc[9] += w * s2[1];
    }
#pragma unroll
    for (int b = 0; b < NBATCH; ++b) atomicAdd(dst + (size_t)b * dstride + dcol, acc[b]);
    LDS_WAIT(); asm volatile("" ::: "memory");
}

struct Args { const float* in[19]; float* out; unsigned char* ws; int ph_lo, ph_hi, row0, nrows; };
enum { I_XP = 0, I_XS, I_CP, I_CS, I_WADA, I_BADA, I_N1G, I_N2G, I_WIN, I_QNG, I_KNG, I_RPB, I_WPOOL, I_PSCALE, I_WOUT, I_WUP, I_CONVW, I_CONVB, I_WDOWN };
constexpr int N_PHASES = 8;
#ifndef MK_ONE_LAUNCH
#define MK_ONE_LAUNCH 1
#endif

__global__ void __launch_bounds__(NWAVES * 64, 2) fwd(Args a) {
    extern __shared__ __attribute__((aligned(16))) unsigned char lds_raw[];
    LAS unsigned char* lds = (LAS unsigned char*)lds_raw;
    volatile LAS unsigned* MISC = (volatile LAS unsigned*)(lds + MISC_OFF);
    const int tid = threadIdx.x, lane = tid & 63, wave = __builtin_amdgcn_readfirstlane(tid >> 6);
    const int G = gridDim.x; const int bx = blockIdx.x; const int vcu = (G % 8 == 0) ? (bx % 8) * (G / 8) + bx / 8 : bx;
    const int gw = vcu * NWAVES + wave, NGW = G * NWAVES;
    unsigned char* ws = a.ws;
    unsigned* ctl = (unsigned*)(ws + WS_CTL);
    float* macc = (float*)(ws + OFF_MOD); float* c2acc = (float*)(ws + OFF_C2); float* rss2 = (float*)(ws + OFF_RSS2); float* hss = (float*)(ws + OFF_HSS);
    bf16* WinT = (bf16*)(ws + WS_WIN); bf16* WoT = (bf16*)(ws + WS_WOUT); bf16* WupT = (bf16*)(ws + WS_WUP); bf16* WdT = (bf16*)(ws + WS_WDN);
    float* convp = (float*)(ws + WS_SMALL); float* cbp = convp + 3 * FF2;
    bf16* H1 = (bf16*)(ws + WS_H1); bf16* MIXB = (bf16*)(ws + WS_MIXB); bf16* CAT = (bf16*)(ws + WS_CAT); bf16* ACT = (bf16*)(ws + WS_ACT);
    unsigned char* dob = (unsigned char*)a.out;
    bf16* PROJ = (bf16*)(dob + DO_PROJ); bf16* XG2 = (bf16*)(dob + DO_XG2); float* EDGE = (float*)(dob + DO_EDGE);
    const float* b_ada = a.in[I_BADA];

    for (int u = tid; u < (LDS_BYTES - LDSCTL_OFF) / 4; u += NWAVES * 64) ((LAS unsigned*)(lds + LDSCTL_OFF))[u] = 0u;
    __syncthreads();
    const bool one_launch = (a.ph_lo == 0 && a.ph_hi == N_PHASES);
    XcdBarrier bar; bar.bar = ctl + CW_BAR; bar.x = 0; bar.st = nullptr;
    if (one_launch) bar = xcd_barrier_post(ctl + CW_BAR, MISC + 8);
#define IN(k) (a.ph_lo <= (k) && (k) < a.ph_hi)
#define SEAM(k) do { if (IN(k) && IN((k) + 1)) xcd_barrier(bar); } while (0)

    if (IN(0)) {
        LAS float* scr = (LAS float*)(lds + RING_OFF + wave * 16384);
        constexpr int I0 = 16 * 64, I1 = I0 + 8 * 32, I2 = I1 + 16 * 176, I3 = I2, I4 = I3 + 16 * 96, I5 = I4 + 4 * 16 * 16, I6 = I5 + 88;
        for (int it = gw; it < I6; it += NGW) {
            if (it < I0) { const int kb = it / 64, nb = it % 64; transpose_item(a.in[I_WIN], INW, 64 * kb, 32 * nb, WinT, D, 32 * nb, 64 * kb, scr, lane); }
            else if (it < I1) { const int r = it - I0, kb = r / 32, nb = r % 32; transpose_item(a.in[I_WOUT], D, 64 * kb, 32 * nb, WoT, D, 32 * nb, 64 * kb, scr, lane); }
            else if (it < I2) { const int r = it - I1, kb = r / 176, nb = r % 176; transpose_item(a.in[I_WUP], FF2, 64 * kb, 32 * nb, WupT, D, permcol(32 * nb), 64 * kb, scr, lane); }
            else if (it < I4) {
                const int r = it - I3, kc = r / 96, nc = r % 96, k = 64 * kc + lane;
#pragma unroll
                for (int b = 0; b < NBATCH; ++b) { const float c = b < 8 ? a.in[I_CP][b * D + k] : a.in[I_CS][(b - 8) * D + k]; scr[lane * 12 + b] = silu_f(c); }
                LDS_WAIT(); asm volatile("" ::: "memory");
                gemv10_item(a.in[I_WADA], MODW, 64 * kc, 64 * nc + lane, scr, macc, MODW, 64 * nc + lane);
            }
            else if (it < I5) {
                const int r = it - I4, g = r / 256, cb = (r / 16) % 16, nb = r % 16, n = 64 * nb + lane;
                float acc[8];
#pragma unroll
                for (int i = 0; i < 8; ++i) acc[i] = 0.f;
                const float* wp = a.in[I_WPOOL] + (size_t)(g * 128 + 8 * cb) * 128;
                for (int d = 0; d < 128; ++d) {
                    const float wo = a.in[I_WOUT][(size_t)(ATTW + g * 128 + d) * D + n] * a.in[I_PSCALE][g * 128 + d];
#pragma unroll
                    for (int i = 0; i < 8; ++i) acc[i] += wp[i * 128 + d] * wo;
                }
                v4u o; o.x = pk2(acc[0], acc[1]); o.y = pk2(acc[2], acc[3]); o.z = pk2(acc[4], acc[5]); o.w = pk2(acc[6], acc[7]);
                *(v4u*)(WoT + (size_t)n * D + ATTW + g * 128 + 8 * cb) = o;
            }
            else { const int n = 64 * (it - I5) + lane, pc = permcol(n);
                convp[pc] = a.in[I_CONVW][n]; convp[FF2 + pc] = a.in[I_CONVW][FF2 + n]; convp[2 * FF2 + pc] = a.in[I_CONVW][2 * FF2 + n]; cbp[pc] = a.in[I_CONVB][n]; }
        }
    }
    SEAM(0);

    if (IN(1)) {
        LAS float* scr = (LAS float*)(lds + RING_OFF + wave * 16384);
        for (int it = gw; it < 16 * 88; it += NGW) {
            const int kc = it / 88, nc = it % 88, k = 64 * kc + lane;
#pragma unroll
            for (int b = 0; b < NBATCH; ++b) scr[lane * 12 + b] = modv(macc, b_ada, b, 3 * D + k);
            LDS_WAIT(); asm volatile("" ::: "memory");
            gemv10_item(a.in[I_WUP], FF2, 64 * kc, 64 * nc + lane, scr, c2acc, FF2, permcol(64 * nc) + lane);
        }
        for (int r0 = gw * 16; r0 < MT; r0 += NGW * 16) {
            const int b = batch_of_row(r0);
            f32x4 Gv[4], Sv[4];
#pragma unroll
            for (int j = 0; j < 4; ++j) { const int c = 4 * lane + 256 * j; Gv[j] = *(const f32x4*)(a.in[I_N1G] + c) * (modv4(macc, b_ada, b, D + c) + 1.0f); Sv[j] = modv4(macc, b_ada, b, c); }
            for (int rr = 0; rr < 16; ++rr) {
                const int row = r0 + rr; const float* xrow = row < NPR ? a.in[I_XP] + (size_t)row * D : a.in[I_XS] + (size_t)(row - NPR) * D;
                f32x4 v[4]; float s = 0.f;
#pragma unroll
                for (int j = 0; j < 4; ++j) { v[j] = *(const f32x4*)(xrow + 4 * lane + 256 * j); s += (v[j][0] * v[j][0] + v[j][1] * v[j][1]) + (v[j][2] * v[j][2] + v[j][3] * v[j][3]); }
                const float rstd = rsqrtf(wave_sum(s) * (1.0f / D) + EPS);
#pragma unroll
                for (int j = 0; j < 4; ++j) { const f32x4 h = v[j] * rstd * Gv[j] + Sv[j]; v2u w; w.x = pk2(h[0], h[1]); w.y = pk2(h[2], h[3]);
                    *(v2u*)(H1 + (size_t)row * D + 4 * lane + 256 * j) = w; }
            }
        }
    }
    SEAM(1);

    if (IN(2)) {
        pg8::Gemm g{H1, WinT, MT, INW, D}; pg8::StaticOrder S; S.init(MT, INW, G, bx);
        EpiProj E{PROJ, hss};
        pg8::gemm_phase<EpiProj, pg8::StaticOrder, PG8_ALIGN, PG8_SP2>(lds + RING_OFF, g, S, E);
    }
    SEAM(2);

    if (IN(3)) {
        typedef short bf16x8 __attribute__((ext_vector_type(8)));
        typedef short s16x4 __attribute__((ext_vector_type(4)));
        LAS float* tbl = (LAS float*)(lds + BIAS_OFF);
        LAS float* rkr = (LAS float*)(lds + RK_OFF);
        const int fq = lane >> 4, l15 = lane & 15, tq = l15 >> 2, tp = lane & 3;
        const int pr = wave >> 2, j = wave & 3, cb0 = j < 2 ? 0 : 1;
        for (int task = vcu; task < 256; task += G) {
            int b, h, r0, rows;
            if (task < 128) { b = task >> 4; h = (task >> 1) & 7; r0 = (task & 1) * 16; rows = 32; }
            else { const int t2 = task - 128; b = 8 + (t2 >> 6); h = (t2 >> 3) & 7; r0 = (t2 & 7) * 16; rows = 128; }
            const int base = b < 8 ? b * 2048 : NPR + (b - 8) * 8192;
            __syncthreads();
            { const int dr = tid >> 5, dc = tid & 31; tbl[tid] = (dr < 15 && dc < 31) ? a.in[I_RPB][h * 465 + dr * 31 + dc] * 1.4426950408889634f : -1e30f; }
            int dco[3][4];
            { const int qc = 16 * j + l15, cs = min(max(qc - 8, 0), 48);
#pragma unroll
              for (int cbk = 0; cbk < 3; ++cbk)
#pragma unroll
                  for (int e = 0; e < 4; ++e) { const int kc = 16 * (cb0 + cbk) + 4 * fq + e; dco[cbk][e] = (kc >= cs && kc < cs + 16) ? (kc - qc + 15) : 31; } }
            int voff[4];
#pragma unroll
            for (int db = 0; db < 4; ++db) voff[db] = (4 * fq + tq) * 128 + 16 * ((2 * db + (tp >> 1)) ^ (4 * (fq & 1) + tq)) + 8 * (tp & 1);
#define STAGE_VROW(kr) do { const int kr_ = (kr); const int slot_ = kr_ & 15; const int tc_ = 8 * wave + (lane >> 3), c16_ = (lane & 7) ^ (tc_ & 7); \
                const bf16* src_ = PROJ + (size_t)(base + kr_ * 64 + tc_) * INW + 2 * ATTW + h * 64 + 8 * c16_; \
                __builtin_amdgcn_global_load_lds((const unsigned*)src_, (LAS unsigned*)(lds + RING_OFF + slot_ * 8192 + wave * 1024), 16, 0, 0); \
                if (wave == 0) rkr[slot_ * 64 + lane] = rsqrtf(hss[(size_t)(8 + h) * MT + base + kr_ * 64 + lane] * (1.0f / 64.0f) + EPS) * 1.4426950408889634f; } while (0)
            int staged_hi;
            { const int lo0 = min(max(r0 - 4, 0), rows - 8), hi0 = min(max(r0 + 1 - 4, 0), rows - 8) + 7;
              for (int kr = lo0; kr <= hi0; ++kr) STAGE_VROW(kr);
              staged_hi = hi0; }
#pragma unroll 1
            for (int p = 0; p < 8; ++p) {
                VM_WAIT(); LDS_WAIT(); __syncthreads();
                if (p < 7) { const int hin = min(max(r0 + 2 * p + 3 - 4, 0), rows - 8) + 7; for (int kr = staged_hi + 1; kr <= hin; ++kr) STAGE_VROW(kr); staged_hi = max(staged_hi, hin); }
                const int r = r0 + 2 * p + pr, rs = min(max(r - 4, 0), rows - 8), dr0 = rs - r + 7;
                const int qrow = base + r * 64 + 16 * j + l15;
                bf16x8 qf[2];
                { const float rqs = rsqrtf(hss[(size_t)h * MT + qrow] * (1.0f / 64.0f) + EPS) * 0.125f;
#pragma unroll
                  for (int ks = 0; ks < 2; ++ks) { const int d0 = 32 * ks + 8 * fq;
                      const v4u w = *(const v4u*)(PROJ + (size_t)qrow * INW + h * 64 + d0);
                      const f32x4 g0 = *(const f32x4*)(a.in[I_QNG] + d0) * *(const f32x4*)(a.in[I_KNG] + d0) * rqs, g1 = *(const f32x4*)(a.in[I_QNG] + d0 + 4) * *(const f32x4*)(a.in[I_KNG] + d0 + 4) * rqs;
                      v4u o; o.x = pk2(bflo(w.x) * g0[0], bfhi(w.x) * g0[1]); o.y = pk2(bflo(w.y) * g0[2], bfhi(w.y) * g0[3]); o.z = pk2(bflo(w.z) * g1[0], bfhi(w.z) * g1[1]); o.w = pk2(bflo(w.w) * g1[2], bfhi(w.w) * g1[3]);
                      qf[ks] = __builtin_bit_cast(bf16x8, o); } }
                f32x4 sc[24]; float mx = -3e38f;
#pragma unroll
                for (int i = 0; i < 8; ++i)
#pragma unroll
                    for (int cbk = 0; cbk < 3; ++cbk) {
                        const int tok = base + (rs + i) * 64 + 16 * (cb0 + cbk) + l15;
                        const bf16* kp = PROJ + (size_t)tok * INW + ATTW + h * 64 + 8 * fq;
                        const bf16x8 k0 = *(const bf16x8*)kp, k1 = *(const bf16x8*)(kp + 32);
                        f32x4 c = {0.f, 0.f, 0.f, 0.f};
                        c = __builtin_amdgcn_mfma_f32_16x16x32_bf16(k0, qf[0], c, 0, 0, 0);
                        c = __builtin_amdgcn_mfma_f32_16x16x32_bf16(k1, qf[1], c, 0, 0, 0);
                        const f32x4 rk = *(const LAS f32x4*)(rkr + ((rs + i) & 15) * 64 + 16 * (cb0 + cbk) + 4 * fq);
                        const LAS float* tb = tbl + (dr0 + i) * 32;
                        f32x4 s; s[0] = c[0] * rk[0] + tb[dco[cbk][0]]; s[1] = c[1] * rk[1] + tb[dco[cbk][1]]; s[2] = c[2] * rk[2] + tb[dco[cbk][2]]; s[3] = c[3] * rk[3] + tb[dco[cbk][3]];
                        sc[3 * i + cbk] = s; mx = fmaxf(fmaxf(mx, fmaxf(s[0], s[1])), fmaxf(s[2], s[3]));
                    }
                mx = fmaxf(mx, __shfl_xor(mx, 16)); mx = fmaxf(mx, __shfl_xor(mx, 32));
                float lsum = 0.f;
#pragma unroll
                for (int kb = 0; kb < 24; ++kb) { f32x4 e; e[0] = __builtin_amdgcn_exp2f(sc[kb][0] - mx); e[1] = __builtin_amdgcn_exp2f(sc[kb][1] - mx); e[2] = __builtin_amdgcn_exp2f(sc[kb][2] - mx); e[3] = __builtin_amdgcn_exp2f(sc[kb][3] - mx);
                    sc[kb] = e; lsum += (e[0] + e[1]) + (e[2] + e[3]); }
                lsum += __shfl_xor(lsum, 16); lsum += __shfl_xor(lsum, 32);
                f32x4 oacc[4];
#pragma unroll
                for (int db = 0; db < 4; ++db) oacc[db] = (f32x4){0.f, 0.f, 0.f, 0.f};
#pragma unroll
                for (int t = 0; t < 12; ++t) {
                    const int kbA = 2 * t, kbB = 2 * t + 1, iA = kbA / 3, cA = kbA % 3, iB = kbB / 3, cB = kbB % 3;
                    v4u pw; pw.x = cvt_pk(sc[kbA][0], sc[kbA][1]); pw.y = cvt_pk(sc[kbA][2], sc[kbA][3]); pw.z = cvt_pk(sc[kbB][0], sc[kbB][1]); pw.w = cvt_pk(sc[kbB][2], sc[kbB][3]);
                    const bf16x8 pf = __builtin_bit_cast(bf16x8, pw);
                    const LAS unsigned char* vA = lds + RING_OFF + ((rs + iA) & 15) * 8192 + (cb0 + cA) * 2048, * vB = lds + RING_OFF + ((rs + iB) & 15) * 8192 + (cb0 + cB) * 2048;
#pragma unroll
                    for (int db = 0; db < 4; ++db) {
                        const s16x4 va = __builtin_bit_cast(s16x4, __builtin_amdgcn_ds_read_tr16_b64_v4i16((LAS s16x4*)(vA + voff[db])));
                        const s16x4 vb = __builtin_bit_cast(s16x4, __builtin_amdgcn_ds_read_tr16_b64_v4i16((LAS s16x4*)(vB + voff[db])));
                        bf16x8 vf; vf[0] = va[0]; vf[1] = va[1]; vf[2] = va[2]; vf[3] = va[3]; vf[4] = vb[0]; vf[5] = vb[1]; vf[6] = vb[2]; vf[7] = vb[3];
                        oacc[db] = __builtin_amdgcn_mfma_f32_16x16x32_bf16(vf, pf, oacc[db], 0, 0, 0);
                    }
                }
                const float il = 1.0f / lsum;
#pragma unroll
                for (int db = 0; db < 4; ++db) { v2u w; w.x = cvt_pk(oacc[db][0] * il, oacc[db][1] * il); w.y = cvt_pk(oacc[db][2] * il, oacc[db][3] * il);
                    *(v2u*)(CAT + (size_t)qrow * D + h * 64 + 16 * db + 4 * fq) = w; }
            }
#undef STAGE_VROW
        }
        for (int u = vcu; u < 512; u += G) {
            int b, r, rows;
            if (u < 256) { b = u >> 5; r = u & 31; rows = 32; } else { b = 8 + ((u - 256) >> 7); r = (u - 256) & 127; rows = 128; }
            const int base = b < 8 ? b * 2048 : NPR + (b - 8) * 8192, T = rows * 64;
#pragma unroll 1
            for (int k = 0; k < 8; ++k) {
                const int idx = tid + 512 * k, tl = idx >> 6, ch = idx & 63, g = ch >> 4, hw = 1 << g;
                const int t = r * 64 + tl, lo = max(t - hw, 0), hi = min(t + hw, T);
                float sacc[8];
#pragma unroll
                for (int i = 0; i < 8; ++i) sacc[i] = 0.f;
                for (int s = lo; s < hi; ++s) { const v4u w = *(const v4u*)(PROJ + (size_t)(base + s) * INW + 3 * ATTW + 8 * ch);
                    sacc[0] += bflo(w.x); sacc[1] += bfhi(w.x); sacc[2] += bflo(w.y); sacc[3] += bfhi(w.y); sacc[4] += bflo(w.z); sacc[5] += bfhi(w.z); sacc[6] += bflo(w.w); sacc[7] += bfhi(w.w); }
                const float ic = 1.0f / (float)(hi - lo);
                const v4u w = *(const v4u*)(PROJ + (size_t)(base + t) * INW + 3 * ATTW + 8 * ch);
                v4u ow; ow.x = pk2(sacc[0] * ic - bflo(w.x), sacc[1] * ic - bfhi(w.x)); ow.y = pk2(sacc[2] * ic - bflo(w.y), sacc[3] * ic - bfhi(w.y));
                ow.z = pk2(sacc[4] * ic - bflo(w.z), sacc[5] * ic - bfhi(w.z)); ow.w = pk2(sacc[6] * ic - bflo(w.w), sacc[7] * ic - bfhi(w.w));
                *(v4u*)(CAT + (size_t)(base + t) * D + ATTW + 8 * ch) = ow;
            }
        }
    }
    SEAM(3);

    if (IN(4)) {
        pg8::Gemm g{CAT, WoT, MT, D, D}; pg8::StaticOrder S; S.init(MT, D, G, bx);
        EpiOut E{a.in[I_XP], a.in[I_XS], MIXB, XG2, rss2, macc, b_ada, a.in[I_N2G]};
        pg8::gemm_phase<EpiOut, pg8::StaticOrder, PG8_ALIGN, PG8_SP2>(lds + RING_OFF, g, S, E);
    }
    SEAM(4);

    if (IN(5)) {
        pg8::Gemm g{XG2, WupT, MT, FF2, D}; pg8::StaticOrder S; S.init(MT, FF2, G, bx);
        EpiConvAct E{ACT, EDGE, rss2, c2acc, convp, cbp, (LAS float*)(lds + XCH_OFF)};
        pg8::gemm_phase<EpiConvAct, pg8::StaticOrder, PG8_ALIGN, PG8_SP2>(lds + RING_OFF, g, S, E);
    }
    SEAM(5);

    if (IN(6)) {
        LAS float* scr = (LAS float*)(lds + RING_OFF + wave * 16384);
        for (int it = gw; it < 44 * 32; it += NGW) { const int kb = it / 32, nb = it % 32; transpose_item(a.in[I_WDOWN], D, 64 * kb, 32 * nb, WdT, FF, 32 * nb, 64 * kb, scr, lane); }
        for (int idx = vcu * 512 + tid; idx < 256 * (FF / 8); idx += G * 512) {
            const int br = idx / (FF / 8), f = 8 * (idx % (FF / 8)), gcol = (f >> 7) * 256 + (f & 127);
            const int pm = br >> 1, last = br & 1, row = pm * 256 + (last ? 255 : 0);
            const int b = batch_of_row(row), t = row < NPR ? (row & 2047) : ((row - NPR) & 8191), T = b < 8 ? 2048 : 8192;
            const float* em; const float* e0; const float* ep;
            if (!last) { em = EDGE + ((size_t)(pm - 1) * 4 + 3) * FF2; e0 = EDGE + ((size_t)pm * 4 + 0) * FF2; ep = EDGE + ((size_t)pm * 4 + 1) * FF2; }
            else       { em = EDGE + ((size_t)pm * 4 + 2) * FF2; e0 = EDGE + ((size_t)pm * 4 + 3) * FF2; ep = EDGE + ((size_t)(pm + 1) * 4 + 0) * FF2; }
            const bool hm = t > 0, hp = t < T - 1;
            float res[2][8];
#pragma unroll
            for (int part = 0; part < 2; ++part) {
                const int col = gcol + 128 * part;
#pragma unroll
                for (int hh = 0; hh < 2; ++hh) {
                    const int c = col + 4 * hh; const f32x4 zero = {0.f, 0.f, 0.f, 0.f};
                    const f32x4 um = hm ? *(const f32x4*)(em + c) : zero, u0 = *(const f32x4*)(e0 + c), up = hp ? *(const f32x4*)(ep + c) : zero;
                    const f32x4 w0 = *(const f32x4*)(convp + c), w1 = *(const f32x4*)(convp + FF2 + c), w2 = *(const f32x4*)(convp + 2 * FF2 + c), cb = *(const f32x4*)(cbp + c);
                    const f32x4 r = w0 * um + w1 * u0 + w2 * up + cb;
                    res[part][4 * hh + 0] = r[0]; res[part][4 * hh + 1] = r[1]; res[part][4 * hh + 2] = r[2]; res[part][4 * hh + 3] = r[3];
                }
            }
            v4u ow; ow.x = pk2(silu_f(res[0][0]) * res[1][0], silu_f(res[0][1]) * res[1][1]); ow.y = pk2(silu_f(res[0][2]) * res[1][2], silu_f(res[0][3]) * res[1][3]);
            ow.z = pk2(silu_f(res[0][4]) * res[1][4], silu_f(res[0][5]) * res[1][5]); ow.w = pk2(silu_f(res[0][6]) * res[1][6], silu_f(res[0][7]) * res[1][7]);
            *(v4u*)(ACT + (size_t)row * FF + f) = ow;
        }
    }
    SEAM(6);

    if (IN(7)) {
        pg8::Gemm g{ACT, WdT, MT, D, FF}; pg8::StaticOrder S; S.init(MT, D, G, bx);
        EpiDown E{a.in[I_XP], a.in[I_XS], MIXB, a.out, macc, b_ada};
        pg8::gemm_phase<EpiDown, pg8::StaticOrder, PG8_ALIGN, PG8_SP2>(lds + RING_OFF, g, S, E);
    }
#undef IN
#undef SEAM
}

extern "C" void kernel_launch(void* const* d_in, const int* in_sizes, int n_in, void* d_out, int out_size, void* d_ws, size_t ws_size, hipStream_t stream) {
    static int grid = 0;
    if (grid == 0) {
        if (n_in != 19 || out_size != MT * D || ws_size < WS_END) { fprintf(stderr, "kernel_launch: unexpected shapes (n_in %d, out %d, ws %zu)\n", n_in, out_size, ws_size); grid = -1; return; }
        int dev = 0, cus = 0;
        if (hipGetDevice(&dev) != hipSuccess || hipDeviceGetAttribute(&cus, hipDeviceAttributeMultiprocessorCount, dev) != hipSuccess) { grid = -1; return; }
        if (hipFuncSetAttribute((const void*)fwd, hipFuncAttributeMaxDynamicSharedMemorySize, LDS_BYTES) != hipSuccess) { fprintf(stderr, "kernel_launch: hipFuncSetAttribute failed\n"); grid = -1; return; }
        (void)hipGetLastError();
        grid = cus;
    }
    if (grid < 0) return;
    if (hipMemsetAsync((char*)d_ws + WS_CTL, 0, CTL_ZERO_BYTES, stream) != hipSuccess) return;
    Args a{};
    for (int i = 0; i < 19; ++i) a.in[i] = (const float*)d_in[i];
    a.out = (float*)d_out; a.ws = (unsigned char*)d_ws;
#if MK_ONE_LAUNCH
    a.ph_lo = 0; a.ph_hi = N_PHASES; a.row0 = 0; a.nrows = 0; hipLaunchKernelGGL(fwd, dim3(grid), dim3(NWAVES * 64), LDS_BYTES, stream, a);
#else
    for (int ph = 0; ph < N_PHASES; ++ph) { a.ph_lo = ph; a.ph_hi = ph + 1; hipLaunchKernelGGL(fwd, dim3(grid), dim3(NWAVES * 64), LDS_BYTES, stream, a); }
#endif
}
```

```cpp
#include <hip/hip_runtime.h>
#include <cstdio>
#include <cstdint>

constexpr int D = 1024, MT = 32768, NPR = 16384, INW = 2048, ATTW = 512, HD = 64, NH = 8, FF = 2816, FF2 = 5632, NBATCH = 10, MODW = 6144;
constexpr float EPS = 1e-6f;

namespace pg8 {
#define PG8_LAS __attribute__((address_space(3)))
typedef unsigned short bf16_t;
typedef short bf16x8 __attribute__((ext_vector_type(8)));
typedef float f32x4 __attribute__((ext_vector_type(4)));
typedef unsigned u32x4 __attribute__((ext_vector_type(4)));
constexpr int BM = 256, BK = 64, HALF = 128, HTB = HALF * BK * 2  , STAGE_BYTES = 8 * HTB, NXCD = 8, WGM = 8;

__host__ __device__ __forceinline__ int lds_byte(int r, int c) { const int st = (r >> 4) * 2 + (c >> 5), rr = r & 15, cc = c & 31, ob = rr * 64 + cc * 2; return st * 1024 + (ob ^ (((ob >> 9) & 1) << 5)); }
__host__ __device__ __forceinline__ void stage_rc(int b, int& R, int& C) { const int st = b / 1024, sb = b % 1024, swz = sb ^ (((sb >> 9) & 1) << 5); R = (st >> 1) * 16 + swz / 64; C = (st & 1) * 32 + (swz % 64) / 2; }
__host__ __device__ __forceinline__ int perm32(int rho) { const int n = rho >> 4, i = rho & 15; return 8 * (i >> 2) + 4 * n + (i & 3); }

struct Unit { int pm, pn; };
struct Gemm { const bf16_t* A; const bf16_t* Bt; int M, N, K; };

struct StaticOrder {
    int nM, nN, nwg, G, c;
    __host__ __device__ void init(int M, int N, int G_, int c_) { nM = M / BM; nN = N / BM; nwg = nM * nN; G = G_; c = c_; }
    __host__ __device__ bool next(int i, Unit& u) const {
        const long L = (long)i * G + c; if (L >= nwg) return false;
        int wgid = (int)L; { const int q = nwg / NXCD, r = nwg % NXCD, xcd = wgid % NXCD, off = wgid / NXCD; wgid = (xcd < r ? xcd * (q + 1) : r * (q + 1) + (xcd - r) * q) + off; }
        const int nig = WGM * nN, gid = wgid / nig, fm = gid * WGM, gsz = (nM - fm) < WGM ? (nM - fm) : WGM;
        u.pm = fm + ((wgid % nig) % gsz); u.pn = (wgid % nig) / gsz; return true;
    }
    __device__ __forceinline__ void a_ready(const Unit&) const {}
    __device__ __forceinline__ void done(const Unit&) const {}
};

template <class Epi, class Sched, bool ALIGN_EPI = false, bool SP2 = false>
__device__ __forceinline__ void gemm_phase(PG8_LAS unsigned char* lds, const Gemm g, const Sched& S, const Epi& E) {
    int tid_ = threadIdx.x; asm volatile("" : "+v"(tid_));
    const int tid = tid_, wid = __builtin_amdgcn_readfirstlane(tid >> 6), lane = tid & 63, wr = wid >> 2, wc = wid & 3, fr = lane & 15, fq = lane >> 4;
    const int K = g.K, nt = K / BK;
    unsigned voffA[2], voffB[2];
#pragma unroll
    for (int i = 0; i < 2; ++i) { int R, C; stage_rc(tid * 16 + i * 8192, R, C); const int Rb = Epi::PERM ? ((R & ~31) + perm32(R & 31)) : R;
        const int Ra = Epi::PERMA ? ((R & 64) + 4 * (R & 15) + ((R >> 4) & 3)) : R;
        voffA[i] = (unsigned)(Ra * K + C) * 2u; voffB[i] = (unsigned)(Rb * K + C) * 2u; }
    const size_t kstep = (size_t)(BK * 2);
    const size_t hstep = (size_t)HALF * K * 2;
    const size_t tstep = 2 * hstep;
    const unsigned ldsw = (unsigned)wid * 1024u;
    const int aoff = lds_byte(wr * 64 + fr, fq * 8), boff = lds_byte(wc * 32 + fr, fq * 8);
#define PG8_SA(b, h) (((b) * 2 + (h)) * HTB)
#define PG8_SB(b, h) ((4 + (b) * 2 + (h)) * HTB)
#define PG8_STAGE(bufoff, gbase, voff) do { _Pragma("unroll") for (int _i = 0; _i < 2; ++_i) \
        __builtin_amdgcn_global_load_lds((const unsigned*)((const char*)(gbase) + (voff)[_i]), (PG8_LAS unsigned*)(lds + (bufoff) + ldsw + _i * 8192), 16, 0, 0); } while (0)
#define PG8_LDA(dst, b, h) do { _Pragma("unroll") for (int m = 0; m < 4; ++m) _Pragma("unroll") for (int k = 0; k < 2; ++k) dst[m][k] = *(const PG8_LAS bf16x8*)(lds + PG8_SA(b, h) + aoff + m * 2048 + k * 1024); } while (0)
#define PG8_LDB(dst, b, h) do { _Pragma("unroll") for (int n = 0; n < 2; ++n) _Pragma("unroll") for (int k = 0; k < 2; ++k) dst[n][k] = *(const PG8_LAS bf16x8*)(lds + PG8_SB(b, h) + boff + n * 2048 + k * 1024); } while (0)
#define PG8_MMA(ai, bj, At, Bt) do { __builtin_amdgcn_s_setprio(1); _Pragma("unroll") for (int m = 0; m < 4; ++m) _Pragma("unroll") for (int n = 0; n < 2; ++n) _Pragma("unroll") for (int k = 0; k < 2; ++k) \
        acc[ai][bj][m][n] = __builtin_amdgcn_mfma_f32_16x16x32_bf16(Bt[n][k], At[m][k], acc[ai][bj][m][n], 0, 0, 0); __builtin_amdgcn_s_setprio(0); } while (0)
#define PG8_WAIT_V(n) asm volatile("s_waitcnt vmcnt(" #n ")" ::: "memory")
#define PG8_WAIT_L(n) asm volatile("s_waitcnt lgkmcnt(" #n ")" ::: "memory")
#define PG8_BAR __builtin_amdgcn_s_barrier()
#define PG8_SCHED __builtin_amdgcn_sched_barrier(0)
    Unit cur, nxt; int ui = 0;
    if (!S.next(0, cur)) return;
    f32x4 acc[2][2][4][2];
#pragma unroll
    for (int a = 0; a < 2; ++a)
#pragma unroll
        for (int b = 0; b < 2; ++b)
#pragma unroll
            for (int m = 0; m < 4; ++m)
#pragma unroll
                for (int n = 0; n < 2; ++n) acc[a][b][m][n] = (f32x4){0.f, 0.f, 0.f, 0.f};
    bf16x8 At[4][2], B0[2][2], B1[2][2];
    const char* cA = (const char*)g.A + (size_t)cur.pm * tstep; const char* cB = (const char*)g.Bt + (size_t)cur.pn * tstep;
    S.a_ready(cur);
    if constexpr (SP2) {
        PG8_STAGE(PG8_SB(0, 0), cB, voffB); PG8_STAGE(PG8_SB(0, 1), cB + hstep, voffB); PG8_STAGE(PG8_SA(0, 0), cA, voffA); PG8_STAGE(PG8_SA(0, 1), cA + hstep, voffA);
        if (wr == 1) PG8_BAR;
        PG8_WAIT_V(2); PG8_BAR;
        PG8_STAGE(PG8_SB(1, 0), cB + kstep, voffB); PG8_STAGE(PG8_SA(1, 0), cA + kstep, voffA); PG8_STAGE(PG8_SB(1, 1), cB + hstep + kstep, voffB);
        PG8_WAIT_V(6); PG8_BAR;
    } else {
        PG8_STAGE(PG8_SB(0, 0), cB, voffB); PG8_STAGE(PG8_SA(0, 0), cA, voffA); PG8_STAGE(PG8_SB(0, 1), cB + hstep, voffB); PG8_STAGE(PG8_SA(0, 1), cA + hstep, voffA);
        if (wr == 1) PG8_BAR;
        PG8_WAIT_V(4); PG8_BAR;
        PG8_STAGE(PG8_SB(1, 0), cB + kstep, voffB); PG8_STAGE(PG8_SA(1, 0), cA + kstep, voffA); PG8_STAGE(PG8_SB(1, 1), cB + hstep + kstep, voffB);
        PG8_WAIT_V(6); PG8_BAR;
    }
    for (;;) {
        const bool has_next = S.next(ui + 1, nxt);
        const char* nA = has_next ? (const char*)g.A + (size_t)nxt.pm * tstep : cA; const char* nB = has_next ? (const char*)g.Bt + (size_t)nxt.pn * tstep : cB;
        for (int t = 0; t < nt; t += 2) {
            const bool last = (t == nt - 2);
            const char* a1 = cA + (size_t)(t + 1) * kstep;
            const char* a2 = last ? nA : cA + (size_t)(t + 2) * kstep; const char* b2 = last ? nB : cB + (size_t)(t + 2) * kstep;
            const char* a3 = a2 + kstep; const char* b3 = b2 + kstep;
            if (last && has_next) S.a_ready(nxt);
            if constexpr (SP2) {
            PG8_LDB(B0, 0, 0); PG8_LDB(B1, 0, 1); PG8_SCHED; PG8_LDA(At, 0, 0); PG8_STAGE(PG8_SA(1, 1), a1 + hstep, voffA);
            PG8_WAIT_V(8); PG8_WAIT_L(0); PG8_BAR; PG8_MMA(0, 0, At, B0); PG8_MMA(0, 1, At, B1); PG8_BAR; PG8_SCHED;
            PG8_LDA(At, 0, 1); PG8_STAGE(PG8_SB(0, 0), b2, voffB); PG8_STAGE(PG8_SB(0, 1), b2 + hstep, voffB); PG8_STAGE(PG8_SA(0, 0), a2, voffA);
            PG8_WAIT_V(8); PG8_WAIT_L(0); PG8_BAR; PG8_MMA(1, 0, At, B0); PG8_MMA(1, 1, At, B1); PG8_BAR; PG8_SCHED;
            PG8_LDB(B0, 1, 0); PG8_LDB(B1, 1, 1); PG8_SCHED; PG8_LDA(At, 1, 0); PG8_STAGE(PG8_SA(0, 1), a2 + hstep, voffA);
            PG8_WAIT_V(8); PG8_WAIT_L(0); PG8_BAR; PG8_MMA(0, 0, At, B0); PG8_MMA(0, 1, At, B1); PG8_BAR; PG8_SCHED;
            PG8_LDA(At, 1, 1); PG8_STAGE(PG8_SB(1, 0), b3, voffB); PG8_STAGE(PG8_SB(1, 1), b3 + hstep, voffB); PG8_STAGE(PG8_SA(1, 0), a3, voffA);
            PG8_WAIT_V(8); PG8_WAIT_L(0); PG8_BAR; PG8_MMA(1, 0, At, B0); PG8_MMA(1, 1, At, B1); PG8_BAR; PG8_SCHED;
            } else {
            PG8_LDB(B0, 0, 0); PG8_SCHED; PG8_LDA(At, 0, 0); PG8_STAGE(PG8_SA(1, 1), a1 + hstep, voffA);
            PG8_WAIT_L(8); PG8_BAR; PG8_WAIT_L(0); PG8_MMA(0, 0, At, B0); PG8_BAR; PG8_SCHED;
            PG8_LDB(B1, 0, 1); PG8_STAGE(PG8_SB(0, 0), b2, voffB);
            PG8_BAR; PG8_WAIT_L(0); PG8_MMA(0, 1, At, B1); PG8_BAR;
            PG8_LDA(At, 0, 1); PG8_STAGE(PG8_SA(0, 0), a2, voffA);
            PG8_BAR; PG8_WAIT_L(0); PG8_MMA(1, 0, At, B0); PG8_BAR; PG8_SCHED;
            PG8_STAGE(PG8_SB(0, 1), b2 + hstep, voffB);
            PG8_WAIT_V(6); PG8_BAR; PG8_MMA(1, 1, At, B1); PG8_BAR;
            PG8_LDB(B0, 1, 0); PG8_SCHED; PG8_LDA(At, 1, 0); PG8_STAGE(PG8_SA(0, 1), a2 + hstep, voffA);
            PG8_WAIT_L(8); PG8_BAR; PG8_WAIT_L(0); PG8_MMA(0, 0, At, B0); PG8_BAR; PG8_SCHED;
            PG8_LDB(B1, 1, 1); PG8_STAGE(PG8_SB(1, 0), b3, voffB);
            PG8_BAR; PG8_WAIT_L(0); PG8_MMA(0, 1, At, B1); PG8_BAR;
            PG8_LDA(At, 1, 1); PG8_STAGE(PG8_SA(1, 0), a3, voffA);
            PG8_BAR; PG8_WAIT_L(0); PG8_MMA(1, 0, At, B0); PG8_BAR; PG8_SCHED;
            PG8_STAGE(PG8_SB(1, 1), b3 + hstep, voffB);
            PG8_WAIT_V(6); PG8_BAR; PG8_MMA(1, 1, At, B1); PG8_BAR;
            }
        }
        if constexpr (ALIGN_EPI) { if (wr == 0) PG8_BAR; }
        if constexpr (!Epi::AFTER_DRAIN) { E(acc, cur, wr, wc, fr, fq); S.done(cur); }
        if (!has_next) break;
#pragma unroll
        for (int a = 0; a < 2; ++a)
#pragma unroll
            for (int b = 0; b < 2; ++b)
#pragma unroll
                for (int m = 0; m < 4; ++m)
#pragma unroll
                    for (int n = 0; n < 2; ++n) acc[a][b][m][n] = (f32x4){0.f, 0.f, 0.f, 0.f};
        cur = nxt; cA = nA; cB = nB; ++ui;
        if constexpr (ALIGN_EPI) { if (wr == 1) PG8_BAR; }
    }
    PG8_WAIT_V(0);
    if constexpr (!ALIGN_EPI) { if (wr == 0) PG8_BAR; }
    PG8_BAR;
    if constexpr (Epi::AFTER_DRAIN) { E.fused(acc, cur, wr, wc, fr, fq, lds, wid, lane); S.done(cur); }
#undef PG8_SA
#undef PG8_SB
#undef PG8_STAGE
#undef PG8_LDA
#undef PG8_LDB
#undef PG8_MMA
#undef PG8_WAIT_V
#undef PG8_WAIT_L
#undef PG8_BAR
#undef PG8_SCHED
}
}
#ifndef PG8_SP2
#define PG8_SP2 true
#endif
#ifndef PG8_ALIGN
#define PG8_ALIGN true
#endif
constexpr size_t MiB = 1u << 20;
constexpr size_t WS_CTL = 0, CTL_ZERO_BYTES = 3 * MiB;
constexpr size_t OFF_MOD = 65536, OFF_C2 = 327680, OFF_RSS2 = 589824, OFF_HSS = 1 * MiB;
constexpr size_t WS_WUP = 3 * MiB, WS_WDN = 3 * MiB, WS_SMALL = 14 * MiB, WS_H1 = 16 * MiB, WS_MIXB = 16 * MiB, WS_ACT = 80 * MiB, WS_CAT = 80 * MiB, WS_WIN = 144 * MiB, WS_WOUT = 148 * MiB;
constexpr size_t DO_PROJ = 0, DO_XG2 = 0, DO_EDGE = 64 * MiB;
constexpr size_t WS_END = 256 * MiB;
constexpr int CW_BAR = 4096;
constexpr int RING_OFF = 0, RING_BYTES = 131072;
constexpr int XCH_OFF = 131072;
constexpr int KRING_OFF = 0, VRING_OFF = 73728;
constexpr int BIAS_OFF = 147456, RK_OFF = 149504;
constexpr int LDSCTL_OFF = 155648, MISC_OFF = LDSCTL_OFF + 320, LDS_BYTES = 163840;
constexpr int NWAVES = 8;

#define GAS __attribute__((address_space(1)))
#define LAS __attribute__((address_space(3)))
typedef unsigned short bf16;
typedef unsigned v4u __attribute__((ext_vector_type(4)));
typedef unsigned v2u __attribute__((ext_vector_type(2)));
using pg8::f32x4;
#define LDS_WAIT() asm volatile("s_waitcnt lgkmcnt(0)" ::: "memory")
#define VM_WAIT() asm volatile("s_waitcnt vmcnt(0)" ::: "memory")
__device__ __forceinline__ unsigned f2bf(float f) { unsigned u = __builtin_bit_cast(unsigned, f); return (u + 0x7fffu + ((u >> 16) & 1u)) >> 16; }
__device__ __forceinline__ unsigned pk2(float lo, float hi) { return f2bf(lo) | (f2bf(hi) << 16); }
__device__ __forceinline__ float bflo(unsigned w) { return __builtin_bit_cast(float, w << 16); }
__device__ __forceinline__ float bfhi(unsigned w) { return __builtin_bit_cast(float, w & 0xffff0000u); }
__device__ __forceinline__ unsigned cvt_pk(float lo, float hi) { unsigned r; asm volatile("v_cvt_pk_bf16_f32 %0, %1, %2" : "=v"(r) : "v"(lo), "v"(hi)); return r; }
__device__ __forceinline__ int batch_of_row(int row) { return row < NPR ? (row >> 11) : 8 + ((row - NPR) >> 13); }
__device__ __forceinline__ int batch_of_tile(int pm) { return pm < 64 ? (pm >> 3) : 8 + ((pm - 64) >> 5); }
__device__ __forceinline__ int permcol(int n) { const int f = n < FF ? n : n - FF; return (f >> 7) * 256 + (f & 127) + (n < FF ? 0 : 128); }
__device__ __forceinline__ float wave_sum(float v) {
#pragma unroll
    for (int o = 1; o < 64; o <<= 1) v += __shfl_xor(v, o);
    return v;
}
__device__ __forceinline__ float silu_f(float x) { return x / (1.0f + __expf(-x)); }

#define XB_TMO      128
#define XB_XCNT(j)  (256  + 64 * (j))
#define XB_XSUB(j)  (1280 + 64 * (j))
#define XB_XGEN(j)  (2304 + 64 * (j))
#define XB_TOP      3328
#define XB_TOPGEN   3392
#define XCD_BAR_WORDS 3456
#define XB_SPIN_CAP (1u << 18)

__device__ __forceinline__ unsigned xb_ld(unsigned* p)              { return __hip_atomic_load(p, __ATOMIC_RELAXED, __HIP_MEMORY_SCOPE_AGENT); }
__device__ __forceinline__ unsigned xb_add(unsigned* p, unsigned v) { return __hip_atomic_fetch_add(p, v, __ATOMIC_RELAXED, __HIP_MEMORY_SCOPE_AGENT); }
__device__ __forceinline__ unsigned xb_xcc_id() { return (unsigned)__builtin_amdgcn_s_getreg((3 << 11) | 20) & 0xFu; }
#define XB_SPIN(cond, bar) do { unsigned _sp = 0; while (cond) { __builtin_amdgcn_s_sleep(1); \
    if ((++_sp & 255u) == 0u) { if (xb_ld(&(bar)[XB_TMO])) break; if (_sp > XB_SPIN_CAP) { atomicAdd(&(bar)[XB_TMO], 1u); break; } } } } while (0)

struct XcdBarrier {
    unsigned* bar; unsigned x;
    volatile LAS unsigned* st;
};

__device__ __forceinline__ XcdBarrier xcd_barrier_post(unsigned* bar, volatile LAS unsigned* st) {
    XcdBarrier b; b.bar = bar; b.x = xb_xcc_id(); b.st = st;
    if (threadIdx.x == 0) (void)xb_add(&bar[XB_XCNT(b.x)], 1u);
    return b;
}
__device__ __forceinline__ void xcd_barrier_complete(unsigned* bar, unsigned x, unsigned& nloc, unsigned& nx) {
    const unsigned G = gridDim.x * gridDim.y * gridDim.z;
    unsigned sum, cnt, mine, sp = 0u;
    for (;;) {
        sum = 0u; cnt = 0u; mine = 0u;
#pragma unroll
        for (unsigned j = 0; j < 16; ++j) { const unsigned c = xb_ld(&bar[XB_XCNT(j)]); sum += c; cnt += (c > 0u) ? 1u : 0u; mine = (j == x) ? c : mine; }
        if (sum == G) break;
        __builtin_amdgcn_s_sleep(1);
        if ((++sp & 255u) == 0u) { if (xb_ld(&bar[XB_TMO])) break; if (sp > XB_SPIN_CAP) { atomicAdd(&bar[XB_TMO], 1u); break; } }
    }
    nloc = mine > 0u ? mine : 1u; nx = cnt > 0u ? cnt : 1u;
}

__device__ __forceinline__ void xcd_barrier(const XcdBarrier& b) {
    asm volatile("s_waitcnt vmcnt(0)" ::: "memory");
    __syncthreads();
    if (threadIdx.x == 0) {
        unsigned* bar = b.bar;
        __builtin_amdgcn_s_waitcnt(0);
        unsigned nloc = b.st[0], nx = b.st[1];
        if (nloc == 0u) { xcd_barrier_complete(bar, b.x, nloc, nx); b.st[0] = nloc; b.st[1] = nx; }
        const unsigned old = xb_add(&bar[XB_XSUB(b.x)], 1u);
        const unsigned gen = old / nloc;
        if (old + 1u == (gen + 1u) * nloc) {
            __builtin_amdgcn_fence(__ATOMIC_RELEASE, "agent");
            asm volatile("s_waitcnt vmcnt(0)" ::: "memory");
            const unsigned og = xb_add(&bar[XB_TOP], 1u);
            const unsigned tg = og / nx;
            if (og + 1u == (tg + 1u) * nx) xb_add(&bar[XB_TOPGEN], 1u);
            else XB_SPIN(xb_ld(&bar[XB_TOPGEN]) == tg, bar);
            __builtin_amdgcn_fence(__ATOMIC_ACQUIRE, "agent");
            xb_add(&bar[XB_XGEN(b.x)], 1u);
            asm volatile("s_waitcnt vmcnt(0)" ::: "memory");
        } else {
            XB_SPIN(xb_ld(&bar[XB_XGEN(b.x)]) == gen, bar);
            __builtin_amdgcn_fence(__ATOMIC_ACQUIRE, "agent");
            asm volatile("s_waitcnt vmcnt(0)" ::: "memory");
        }
    }
    __syncthreads();
}
typedef const f32x4 (&AccRef)[2][2][4][2];
__device__ __forceinline__ float modv(const float* macc, const float* b_ada, int b, int j) { return macc[b * MODW + j] + b_ada[j]; }
__device__ __forceinline__ f32x4 modv4(const float* macc, const float* b_ada, int b, int j) { return *(const f32x4*)(macc + b * MODW + j) + *(const f32x4*)(b_ada + j); }

struct EpiProj {
    static constexpr bool PERM = true, PERMA = false, AFTER_DRAIN = false;
    bf16* O; float* hss; float asc;
    __device__ __forceinline__ void operator()(AccRef acc, const pg8::Unit& u, int wr, int wc, int fr, int fq) const {
        const int row0 = u.pm * 256 + wr * 64 + fr, col0 = u.pn * 256 + wc * 32 + 8 * fq;
#pragma unroll
        for (int ai = 0; ai < 2; ++ai)
#pragma unroll
            for (int m = 0; m < 4; ++m) { bf16* rowp = O + (size_t)(row0 + ai * 128 + m * 16) * INW + col0;
#pragma unroll
                for (int bj = 0; bj < 2; ++bj) { const f32x4 v0 = acc[ai][bj][m][0], v1 = acc[ai][bj][m][1];
                    v4u w; w.x = cvt_pk(v0[0], v0[1]); w.y = cvt_pk(v0[2], v0[3]); w.z = cvt_pk(v1[0], v1[1]); w.w = cvt_pk(v1[2], v1[3]);
                    *(v4u*)(rowp + bj * 128) = w; } }
        if (u.pn < 4) {
#pragma unroll
            for (int ai = 0; ai < 2; ++ai)
#pragma unroll
                for (int m = 0; m < 4; ++m)
#pragma unroll
                    for (int bj = 0; bj < 2; ++bj) { const f32x4 v0 = acc[ai][bj][m][0], v1 = acc[ai][bj][m][1];
                        float s = ((v0[0] * v0[0] + v0[1] * v0[1]) + (v0[2] * v0[2] + v0[3] * v0[3])) + ((v1[0] * v1[0] + v1[1] * v1[1]) + (v1[2] * v1[2] + v1[3] * v1[3]));
                        s += __shfl_xor(s, 16); s += __shfl_xor(s, 32);
                        if (fq == 0) atomicAdd(hss + (size_t)(4 * u.pn + 2 * bj + (wc >> 1)) * MT + row0 + ai * 128 + m * 16, s * asc); }
        }
    }
};
struct EpiOut {
    static constexpr bool PERM = false, PERMA = false, AFTER_DRAIN = false;
    const float* xp; const float* xs; bf16* mixb; bf16* xg2; float* rss2; const float* macc; const float* b_ada; const float* n2g; float asc;
    __device__ __forceinline__ void operator()(AccRef acc, const pg8::Unit& u, int wr, int wc, int fr, int fq) const {
        const int b = batch_of_tile(u.pm), row0 = u.pm * 256 + wr * 64 + fr, col0 = u.pn * 256 + wc * 32 + 4 * fq;
        float ss[2][4];
#pragma unroll
        for (int ai = 0; ai < 2; ++ai)
#pragma unroll
            for (int m = 0; m < 4; ++m) ss[ai][m] = 0.f;
#pragma unroll
        for (int bj = 0; bj < 2; ++bj)
#pragma unroll
            for (int n = 0; n < 2; ++n) {
                const int c = col0 + bj * 128 + n * 16;
                const f32x4 g1 = modv4(macc, b_ada, b, 2 * D + c), G2 = *(const f32x4*)(n2g + c) * (modv4(macc, b_ada, b, 4 * D + c) + 1.0f);
#pragma unroll
                for (int ai = 0; ai < 2; ++ai)
#pragma unroll
                    for (int m = 0; m < 4; ++m) {
                        const int row = row0 + ai * 128 + m * 16;
                        const float* xrow = row < NPR ? xp + (size_t)row * D : xs + (size_t)(row - NPR) * D;
                        const f32x4 av = acc[ai][bj][m][n];
                        const f32x4 v = *(const f32x4*)(xrow + c) + g1 * av;
                        v2u mw; mw.x = cvt_pk(av[0], av[1]); mw.y = cvt_pk(av[2], av[3]);
                        *(v2u*)(mixb + (size_t)row * D + c) = mw;
                        ss[ai][m] += (v[0] * v[0] + v[1] * v[1]) + (v[2] * v[2] + v[3] * v[3]);
                        const f32x4 g = v * G2; v2u w; w.x = cvt_pk(g[0], g[1]); w.y = cvt_pk(g[2], g[3]);
                        *(v2u*)(xg2 + (size_t)row * D + c) = w;
                    }
            }
#pragma unroll
        for (int ai = 0; ai < 2; ++ai)
#pragma unroll
            for (int m = 0; m < 4; ++m) { float s = ss[ai][m]; s += __shfl_xor(s, 16); s += __shfl_xor(s, 32);
                if (fq == 0) atomicAdd(rss2 + row0 + ai * 128 + m * 16, s * asc); }
    }
};
__device__ __forceinline__ float dpp_shr1(float old, float src) { return __builtin_bit_cast(float, __builtin_amdgcn_update_dpp(__builtin_bit_cast(int, old), __builtin_bit_cast(int, src), 0x111, 0xf, 0xf, false)); }
__device__ __forceinline__ float dpp_shl1(float old, float src) { return __builtin_bit_cast(float, __builtin_amdgcn_update_dpp(__builtin_bit_cast(int, old), __builtin_bit_cast(int, src), 0x101, 0xf, 0xf, false)); }
struct EpiConvAct {
    static constexpr bool PERM = true, PERMA = true, AFTER_DRAIN = false;
    bf16* act; float* edge; const float* rss2; const float* c2; const float* convp; const float* cbp; LAS float* X;
    __device__ __forceinline__ void operator()(f32x4 (&acc)[2][2][4][2], const pg8::Unit& u, int wr, int wc, int fr_, int fq_) const {
        int fr = fr_, fq = fq_; asm volatile("" : "+v"(fr), "+v"(fq));
        const int b = batch_of_tile(u.pm), colL = wc * 32 + 8 * fq, colg = u.pn * 256 + colL;
        {   f32x4 rs[2];
#pragma unroll
            for (int ai = 0; ai < 2; ++ai) { const f32x4 q = *(const f32x4*)(rss2 + u.pm * 256 + 128 * ai + 64 * wr + 4 * fr);
                rs[ai][0] = rsqrtf(q[0] * (1.0f / D) + EPS); rs[ai][1] = rsqrtf(q[1] * (1.0f / D) + EPS); rs[ai][2] = rsqrtf(q[2] * (1.0f / D) + EPS); rs[ai][3] = rsqrtf(q[3] * (1.0f / D) + EPS); }
#pragma unroll
            for (int bj = 0; bj < 2; ++bj)
#pragma unroll
                for (int n = 0; n < 2; ++n) { const f32x4 c2v = *(const f32x4*)(c2 + b * FF2 + colg + 128 * bj + 4 * n);
#pragma unroll
                    for (int ai = 0; ai < 2; ++ai)
#pragma unroll
                        for (int m = 0; m < 4; ++m) acc[ai][bj][m][n] = acc[ai][bj][m][n] * rs[ai][m] + c2v; } }
#pragma unroll
        for (int bj = 0; bj < 2; ++bj)
#pragma unroll
            for (int n = 0; n < 2; ++n)
#pragma unroll
                for (int ai = 0; ai < 2; ++ai) { const int rb = 2 * ai + wr;
                    if (fr == 0)  *(LAS f32x4*)(X + (rb * 2 + 0) * 256 + 128 * bj + colL + 4 * n) = acc[ai][bj][0][n];
                    if (fr == 15) *(LAS f32x4*)(X + (rb * 2 + 1) * 256 + 128 * bj + colL + 4 * n) = acc[ai][bj][3][n]; }
        asm volatile("s_waitcnt lgkmcnt(0)" ::: "memory"); __builtin_amdgcn_s_barrier(); asm volatile("" ::: "memory");
#pragma unroll
        for (int n = 0; n < 2; ++n) {
#pragma unroll
            for (int ai = 0; ai < 2; ++ai) { const int rb = 2 * ai + wr;
                f32x4 sg[4];
#pragma unroll
                for (int bj = 0; bj < 2; ++bj) { const int col = colg + 128 * bj + 4 * n;
                    asm volatile("" ::: "memory");
                    const f32x4 w0 = *(const f32x4*)(convp + col), w1 = *(const f32x4*)(convp + FF2 + col), w2 = *(const f32x4*)(convp + 2 * FF2 + col), cb = *(const f32x4*)(cbp + col);
                    const f32x4 zero = {0.f, 0.f, 0.f, 0.f};
                    const f32x4 above = rb > 0 ? *(const LAS f32x4*)(X + ((rb - 1) * 2 + 1) * 256 + 128 * bj + colL + 4 * n) : zero;
                    const f32x4 below = rb < 3 ? *(const LAS f32x4*)(X + ((rb + 1) * 2 + 0) * 256 + 128 * bj + colL + 4 * n) : zero;
                    const f32x4 U0 = acc[ai][bj][0][n], U1 = acc[ai][bj][1][n], U2 = acc[ai][bj][2][n], U3 = acc[ai][bj][3][n];
                    f32x4 up0, dn3;
#pragma unroll
                    for (int e = 0; e < 4; ++e) { up0[e] = dpp_shr1(above[e], U3[e]); dn3[e] = dpp_shl1(below[e], U0[e]); }
                    if (rb == 0 && fr == 0) { float* ep = edge + ((size_t)u.pm * 4 + 0) * FF2 + col; *(f32x4*)ep = U0; *(f32x4*)(ep + FF2) = U1; }
                    if (rb == 3 && fr == 15) { float* ep = edge + ((size_t)u.pm * 4 + 2) * FF2 + col; *(f32x4*)ep = U2; *(f32x4*)(ep + FF2) = U3; }
                    f32x4 cv[4];
                    cv[0] = w0 * up0 + w1 * U0 + w2 * U1 + cb;
                    cv[1] = w0 * U0 + w1 * U1 + w2 * U2 + cb;
                    cv[2] = w0 * U1 + w1 * U2 + w2 * U3 + cb;
                    cv[3] = w0 * U2 + w1 * U3 + w2 * dn3 + cb;
                    if (bj == 0) {
#pragma unroll
                        for (int m = 0; m < 4; ++m)
#pragma unroll
                            for (int e = 0; e < 4; ++e) { const float g = cv[m][e]; sg[m][e] = g * __builtin_amdgcn_rcpf(1.0f + __builtin_amdgcn_exp2f(g * -1.4426950408889634f)); }
                    } else {
#pragma unroll
                        for (int m = 0; m < 4; ++m) { const int tr = 128 * ai + 64 * wr + 4 * fr + m; const f32x4 av = sg[m] * cv[m];
                            v2u w; w.x = cvt_pk(av[0], av[1]); w.y = cvt_pk(av[2], av[3]);
                            if (tr != 0 && tr != 255) *(v2u*)(act + (size_t)(u.pm * 256 + tr) * FF + u.pn * 128 + colL + 4 * n) = w; }
                    }
                }
            }
        }
    }
};
struct EpiDown {
    static constexpr bool PERM = false, PERMA = false, AFTER_DRAIN = false;
    const float* xp; const float* xs; const bf16* mixb; float* out; const float* macc; const float* b_ada;
    __device__ __forceinline__ void operator()(AccRef acc, const pg8::Unit& u, int wr, int wc, int fr, int fq) const {
        const int b = batch_of_tile(u.pm), row0 = u.pm * 256 + wr * 64 + fr, col0 = u.pn * 256 + wc * 32 + 4 * fq;
#pragma unroll
        for (int bj = 0; bj < 2; ++bj)
#pragma unroll
            for (int n = 0; n < 2; ++n) {
                const int c = col0 + bj * 128 + n * 16;
                const f32x4 g1 = modv4(macc, b_ada, b, 2 * D + c), g2 = modv4(macc, b_ada, b, 5 * D + c);
#pragma unroll
                for (int ai = 0; ai < 2; ++ai)
#pragma unroll
                    for (int m = 0; m < 4; ++m) { const int row = row0 + ai * 128 + m * 16;
                        const float* xrow = row < NPR ? xp + (size_t)row * D : xs + (size_t)(row - NPR) * D;
                        const v2u mw = *(const v2u*)(mixb + (size_t)row * D + c);
                        f32x4 mv; mv[0] = bflo(mw.x); mv[1] = bfhi(mw.x); mv[2] = bflo(mw.y); mv[3] = bfhi(mw.y);
                        *(f32x4*)(out + (size_t)row * D + c) = *(const f32x4*)(xrow + c) + g1 * mv + g2 * acc[ai][bj][m][n]; }
            }
    }
};

__device__ __forceinline__ void transpose_item(const float* W, int ldw, int k0, int n0, bf16* WT, int ldt, int drow0, int kd0, LAS float* scr, int lane) {
#pragma unroll 8
    for (int i = 0; i < 32; ++i) { const int kk = 2 * i + (lane >> 5); scr[kk * 33 + (lane & 31)] = W[(size_t)(k0 + kk) * ldw + n0 + (lane & 31)]; }
    LDS_WAIT(); asm volatile("" ::: "memory");
    const int c = lane & 7;
#pragma unroll
    for (int j = 0; j < 4; ++j) { const int n = (lane >> 3) + 8 * j; const LAS float* s = scr + (8 * c) * 33 + n;
        v4u o; o.x = pk2(s[0 * 33], s[1 * 33]); o.y = pk2(s[2 * 33], s[3 * 33]); o.z = pk2(s[4 * 33], s[5 * 33]); o.w = pk2(s[6 * 33], s[7 * 33]);
        *(v4u*)(WT + (size_t)(drow0 + n) * ldt + kd0 + 8 * c) = o; }
    LDS_WAIT(); asm volatile("" ::: "memory");
}
__device__ __forceinline__ void gemv10_item(const float* W, int ldw, int k0, int n, LAS float* sb, float* dst, int dstride, int dcol, float asc) {
    float acc[NBATCH];
#pragma unroll
    for (int b = 0; b < NBATCH; ++b) acc[b] = 0.f;
#pragma unroll 4
    for (int kk = 0; kk < 64; ++kk) {
        const float w = W[(size_t)(k0 + kk) * ldw + n];
        const f32x4 s0 = *(const LAS f32x4*)(sb + kk * 12), s1 = *(const LAS f32x4*)(sb + kk * 12 + 4), s2 = *(const LAS f32x4*)(sb + kk * 12 + 8);
        acc[0] += w * s0[0]; acc[1] += w * s0[1]; acc[2] += w * s0[2]; acc[3] += w * s0[3];
        acc[4] += w * s1[0]; acc[5] += w * s1[1]; acc[6] += w * s1[2]; acc[7] += w * s1[3];
        acc[8] += w * s2[0]; acc[9] += w * s2[1];
    }
#pragma unroll
    for (int b = 0; b < NBATCH; ++b) atomicAdd(dst + (size_t)b * dstride + dcol, acc[b] * asc);
    LDS_WAIT(); asm volatile("" ::: "memory");
}


template <int HW> __device__ __forceinline__ void pool_group(const bf16* PROJ, bf16* CAT, int pbase, int T, int t0, int ch) {
    constexpr int NL = 2 * HW + 3;
    v4u x[NL];
#pragma unroll
    for (int i = 0; i < NL; ++i) { const int s = t0 - HW + i; const v4u z = {0u, 0u, 0u, 0u}; x[i] = (s >= 0 && s < T) ? *(const v4u*)(PROJ + (size_t)(pbase + s) * INW + 3 * ATTW + 8 * ch) : z; }
    float S[8];
#pragma unroll
    for (int c = 0; c < 8; ++c) S[c] = 0.f;
#define POOL_ADD(sgn, VV) do { S[0] += sgn bflo((VV).x); S[1] += sgn bfhi((VV).x); S[2] += sgn bflo((VV).y); S[3] += sgn bfhi((VV).y); S[4] += sgn bflo((VV).z); S[5] += sgn bfhi((VV).z); S[6] += sgn bflo((VV).w); S[7] += sgn bfhi((VV).w); } while (0)
#pragma unroll
    for (int i = 0; i < 2 * HW; ++i) POOL_ADD(+, x[i]);
#pragma unroll
    for (int k = 0; k < 4; ++k) {
        if (k > 0) { POOL_ADD(-, x[k - 1]); POOL_ADD(+, x[k - 1 + 2 * HW]); }
        const int t = t0 + k; const float ic = 1.0f / (float)(min(t + HW, T) - max(t - HW, 0)); const v4u w = x[HW + k];
        v4u ow; ow.x = pk2(S[0] * ic - bflo(w.x), S[1] * ic - bfhi(w.x)); ow.y = pk2(S[2] * ic - bflo(w.y), S[3] * ic - bfhi(w.y));
        ow.z = pk2(S[4] * ic - bflo(w.z), S[5] * ic - bfhi(w.z)); ow.w = pk2(S[6] * ic - bflo(w.w), S[7] * ic - bfhi(w.w));
        *(v4u*)(CAT + (size_t)(pbase + t) * D + ATTW + 8 * ch) = ow;
    }
#undef POOL_ADD
}

struct Args { const float* in[19]; float* out; unsigned char* ws; int ph_lo, ph_hi, row0, nrows; };
enum { I_XP = 0, I_XS, I_CP, I_CS, I_WADA, I_BADA, I_N1G, I_N2G, I_WIN, I_QNG, I_KNG, I_RPB, I_WPOOL, I_PSCALE, I_WOUT, I_WUP, I_CONVW, I_CONVB, I_WDOWN };
constexpr int N_PHASES = 8;
#ifndef PROBE_MASK
#define PROBE_MASK 0
#endif
#ifndef PROBE_N
#define PROBE_N 0
#endif
#define PROBE_REPS(k) ((((PROBE_MASK) >> (k)) & 1) ? (PROBE_N) : 0)
#ifndef MK_ONE_LAUNCH
#define MK_ONE_LAUNCH 1
#endif

__global__ void __launch_bounds__(NWAVES * 64, 2) fwd(Args a) {
    extern __shared__ __attribute__((aligned(16))) unsigned char lds_raw[];
    LAS unsigned char* lds = (LAS unsigned char*)lds_raw;
    volatile LAS unsigned* MISC = (volatile LAS unsigned*)(lds + MISC_OFF);
    const int wave = __builtin_amdgcn_readfirstlane((int)threadIdx.x >> 6);
#define LANE_SETUP() int tid_ = threadIdx.x; asm volatile("" : "+v"(tid_)); const int tid = tid_, lane = tid & 63; (void)lane
    const int G = gridDim.x; const int bx = blockIdx.x; const int vcu = (G % 8 == 0) ? (bx % 8) * (G / 8) + bx / 8 : bx;
    const int gw = vcu * NWAVES + wave, NGW = G * NWAVES;
    unsigned char* ws = a.ws;
    unsigned* ctl = (unsigned*)(ws + WS_CTL);
    float* macc = (float*)(ws + OFF_MOD); float* c2acc = (float*)(ws + OFF_C2); float* rss2 = (float*)(ws + OFF_RSS2); float* hss = (float*)(ws + OFF_HSS);
    bf16* WinT = (bf16*)(ws + WS_WIN); bf16* WoT = (bf16*)(ws + WS_WOUT); bf16* WupT = (bf16*)(ws + WS_WUP); bf16* WdT = (bf16*)(ws + WS_WDN);
    float* convp = (float*)(ws + WS_SMALL); float* cbp = convp + 3 * FF2;
    bf16* H1 = (bf16*)(ws + WS_H1); bf16* MIXB = (bf16*)(ws + WS_MIXB); bf16* CAT = (bf16*)(ws + WS_CAT); bf16* ACT = (bf16*)(ws + WS_ACT);
    unsigned char* dob = (unsigned char*)a.out;
    bf16* PROJ = (bf16*)(dob + DO_PROJ); bf16* XG2 = (bf16*)(dob + DO_XG2); float* EDGE = (float*)(dob + DO_EDGE);
    const float* b_ada = a.in[I_BADA];

    for (int u = threadIdx.x; u < (LDS_BYTES - LDSCTL_OFF) / 4; u += NWAVES * 64) ((LAS unsigned*)(lds + LDSCTL_OFF))[u] = 0u;
    __syncthreads();
    const bool one_launch = (a.ph_lo == 0 && a.ph_hi == N_PHASES);
    XcdBarrier bar; bar.bar = ctl + CW_BAR; bar.x = 0; bar.st = nullptr;
    if (one_launch) bar = xcd_barrier_post(ctl + CW_BAR, MISC + 8);
#define IN(k) (a.ph_lo <= (k) && (k) < a.ph_hi)
#define SEAM(k) do { if (IN(k) && IN((k) + 1)) xcd_barrier(bar); } while (0)

    for (int rep = 0; rep <= PROBE_REPS(0); ++rep) { const float asc = rep ? 0.f : 1.f; (void)asc;
    if (IN(0)) {
        LANE_SETUP();
        LAS float* scr = (LAS float*)(lds + RING_OFF + wave * 16384);
        constexpr int I0 = 16 * 64, I1 = I0 + 8 * 32, I2 = I1 + 16 * 176, I3 = I2, I4 = I3 + 16 * 96, I5 = I4 + 4 * 16 * 16, I6 = I5 + 88;
        for (int it = gw; it < I6; it += NGW) {
            if (it < I0) { const int kb = it / 64, nb = it % 64; transpose_item(a.in[I_WIN], INW, 64 * kb, 32 * nb, WinT, D, 32 * nb, 64 * kb, scr, lane); }
            else if (it < I1) { const int r = it - I0, kb = r / 32, nb = r % 32; transpose_item(a.in[I_WOUT], D, 64 * kb, 32 * nb, WoT, D, 32 * nb, 64 * kb, scr, lane); }
            else if (it < I2) { const int r = it - I1, kb = r / 176, nb = r % 176; transpose_item(a.in[I_WUP], FF2, 64 * kb, 32 * nb, WupT, D, permcol(32 * nb), 64 * kb, scr, lane); }
            else if (it < I4) {
                const int r = it - I3, kc = r / 96, nc = r % 96, k = 64 * kc + lane;
#pragma unroll
                for (int b = 0; b < NBATCH; ++b) { const float c = b < 8 ? a.in[I_CP][b * D + k] : a.in[I_CS][(b - 8) * D + k]; scr[lane * 12 + b] = silu_f(c); }
                LDS_WAIT(); asm volatile("" ::: "memory");
                gemv10_item(a.in[I_WADA], MODW, 64 * kc, 64 * nc + lane, scr, macc, MODW, 64 * nc + lane, asc);
            }
            else if (it < I5) {
                const int r = it - I4, g = r / 256, cb = (r / 16) % 16, nb = r % 16, n = 64 * nb + lane;
                float acc[8];
#pragma unroll
                for (int i = 0; i < 8; ++i) acc[i] = 0.f;
                const float* wp = a.in[I_WPOOL] + (size_t)(g * 128 + 8 * cb) * 128;
                for (int d = 0; d < 128; ++d) {
                    const float wo = a.in[I_WOUT][(size_t)(ATTW + g * 128 + d) * D + n] * a.in[I_PSCALE][g * 128 + d];
#pragma unroll
                    for (int i = 0; i < 8; ++i) acc[i] += wp[i * 128 + d] * wo;
                }
                v4u o; o.x = pk2(acc[0], acc[1]); o.y = pk2(acc[2], acc[3]); o.z = pk2(acc[4], acc[5]); o.w = pk2(acc[6], acc[7]);
                *(v4u*)(WoT + (size_t)n * D + ATTW + g * 128 + 8 * cb) = o;
            }
            else { const int n = 64 * (it - I5) + lane, pc = permcol(n);
                convp[pc] = a.in[I_CONVW][n]; convp[FF2 + pc] = a.in[I_CONVW][FF2 + n]; convp[2 * FF2 + pc] = a.in[I_CONVW][2 * FF2 + n]; cbp[pc] = a.in[I_CONVB][n]; }
        }
    }
    if (rep < PROBE_REPS(0)) xcd_barrier(bar); }
    SEAM(0);

    for (int rep = 0; rep <= PROBE_REPS(1); ++rep) { const float asc = rep ? 0.f : 1.f; (void)asc;
    if (IN(1)) {
        LANE_SETUP();
        LAS float* scr = (LAS float*)(lds + RING_OFF + wave * 16384);
        for (int it = gw; it < 16 * 88; it += NGW) {
            const int kc = it / 88, nc = it % 88, k = 64 * kc + lane;
#pragma unroll
            for (int b = 0; b < NBATCH; ++b) scr[lane * 12 + b] = modv(macc, b_ada, b, 3 * D + k);
            LDS_WAIT(); asm volatile("" ::: "memory");
            gemv10_item(a.in[I_WUP], FF2, 64 * kc, 64 * nc + lane, scr, c2acc, FF2, permcol(64 * nc) + lane, asc);
        }
        for (int r0 = gw * 16; r0 < MT; r0 += NGW * 16) {
            const int b = batch_of_row(r0);
            f32x4 Gv[4], Sv[4];
#pragma unroll
            for (int j = 0; j < 4; ++j) { const int c = 4 * lane + 256 * j; Gv[j] = *(const f32x4*)(a.in[I_N1G] + c) * (modv4(macc, b_ada, b, D + c) + 1.0f); Sv[j] = modv4(macc, b_ada, b, c); }
            for (int rr = 0; rr < 16; ++rr) {
                const int row = r0 + rr; const float* xrow = row < NPR ? a.in[I_XP] + (size_t)row * D : a.in[I_XS] + (size_t)(row - NPR) * D;
                f32x4 v[4]; float s = 0.f;
#pragma unroll
                for (int j = 0; j < 4; ++j) { v[j] = *(const f32x4*)(xrow + 4 * lane + 256 * j); s += (v[j][0] * v[j][0] + v[j][1] * v[j][1]) + (v[j][2] * v[j][2] + v[j][3] * v[j][3]); }
                const float rstd = rsqrtf(wave_sum(s) * (1.0f / D) + EPS);
#pragma unroll
                for (int j = 0; j < 4; ++j) { const f32x4 h = v[j] * rstd * Gv[j] + Sv[j]; v2u w; w.x = pk2(h[0], h[1]); w.y = pk2(h[2], h[3]);
                    *(v2u*)(H1 + (size_t)row * D + 4 * lane + 256 * j) = w; }
            }
        }
    }
    if (rep < PROBE_REPS(1)) xcd_barrier(bar); }
    SEAM(1);

    for (int rep = 0; rep <= PROBE_REPS(2); ++rep) { const float asc = rep ? 0.f : 1.f; (void)asc;
    if (IN(2)) {
        pg8::Gemm g{H1, WinT, MT, INW, D}; pg8::StaticOrder S; S.init(MT, INW, G, bx);
        EpiProj E{PROJ, hss, asc};
        pg8::gemm_phase<EpiProj, pg8::StaticOrder, PG8_ALIGN, PG8_SP2>(lds + RING_OFF, g, S, E);
    }
    if (rep < PROBE_REPS(2)) xcd_barrier(bar); }
    SEAM(2);

    for (int rep = 0; rep <= PROBE_REPS(3); ++rep) { const float asc = rep ? 0.f : 1.f; (void)asc;
    if (IN(3)) {
        LANE_SETUP();
        typedef short bf16x8 __attribute__((ext_vector_type(8)));
        typedef short s16x4 __attribute__((ext_vector_type(4)));
        LAS float* tbl = (LAS float*)(lds + BIAS_OFF);
        LAS float* rkr = (LAS float*)(lds + RK_OFF);
        const int fq = lane >> 4, l15 = lane & 15, tq = l15 >> 2, tp = lane & 3;
        const int j = wave & 3, cb0 = j < 2 ? 0 : 1;
        for (int task = vcu; task < 256; task += G) {
            int b, h, r0, rows;
            if (task < 128) { b = task >> 4; h = (task >> 1) & 7; r0 = (task & 1) * 16; rows = 32; }
            else { const int t2 = task - 128; b = 8 + (t2 >> 6); h = (t2 >> 3) & 7; r0 = (t2 & 7) * 16; rows = 128; }
            const int base = b < 8 ? b * 2048 : NPR + (b - 8) * 8192;
            __syncthreads();
            { const int dr = tid >> 5, dc = tid & 31; tbl[tid] = (dr < 15 && dc < 31) ? a.in[I_RPB][h * 465 + dr * 31 + dc] * 1.4426950408889634f : -1e30f; }
            int dco[3][4];
            { const int qc = 16 * j + l15, cs = min(max(qc - 8, 0), 48);
#pragma unroll
              for (int cbk = 0; cbk < 3; ++cbk)
#pragma unroll
                  for (int e = 0; e < 4; ++e) { const int kc = 16 * (cb0 + cbk) + 4 * fq + e; dco[cbk][e] = (kc >= cs && kc < cs + 16) ? (kc - qc + 15) : 31; } }
            const int koff0 = l15 * 128 + 16 * (fq ^ (l15 & 7)), koff1 = l15 * 128 + 16 * ((fq ^ (l15 & 7)) ^ 4);
            int voff[4];
#pragma unroll
            for (int db = 0; db < 4; ++db) voff[db] = (4 * fq + tq) * 128 + 16 * ((2 * db + (tp >> 1)) ^ (4 * (fq & 1) + tq)) + 8 * (tp & 1);
#define STAGE_ROW(kr) do { const int kr_ = (kr); const int slot_ = kr_ % 9; const int tc_ = 8 * wave + (lane >> 3), c16_ = (lane & 7) ^ (tc_ & 7); \
                const bf16* src_ = PROJ + (size_t)(base + kr_ * 64 + tc_) * INW + ATTW + h * 64 + 8 * c16_; \
                __builtin_amdgcn_global_load_lds((const unsigned*)src_, (LAS unsigned*)(lds + KRING_OFF + slot_ * 8192 + wave * 1024), 16, 0, 0); \
                __builtin_amdgcn_global_load_lds((const unsigned*)(src_ + ATTW), (LAS unsigned*)(lds + VRING_OFF + slot_ * 8192 + wave * 1024), 16, 0, 0); \
                if (wave == 4) rkr[slot_ * 64 + lane] = rsqrtf(hss[(size_t)(8 + h) * MT + base + kr_ * 64 + lane] * (1.0f / 64.0f) + EPS) * 1.4426950408889634f; } while (0)
            { const int lo0 = min(max(r0 - 4, 0), rows - 8);
              for (int kr = lo0; kr < lo0 + 8; ++kr) STAGE_ROW(kr); }
            const int pu0 = 2 * task;
#pragma unroll 1
            for (int st = 0; st < 16; ++st) {
                VM_WAIT(); LDS_WAIT(); __syncthreads();
                const int r = r0 + st, rs = min(max(r - 4, 0), rows - 8);
                if (st < 15) { const int rsn = min(max(r + 1 - 4, 0), rows - 8); if (rsn != rs) STAGE_ROW(rsn + 7); }
                if (wave < 4) {
                    const int dr0 = rs - r + 7;
                    const int qrow = base + r * 64 + 16 * j + l15;
                    bf16x8 qf[2];
                    { const float rqs = rsqrtf(hss[(size_t)h * MT + qrow] * (1.0f / 64.0f) + EPS) * 0.125f;
#pragma unroll
                      for (int ks = 0; ks < 2; ++ks) { const int d0 = 32 * ks + 8 * fq;
                          const v4u w = *(const v4u*)(PROJ + (size_t)qrow * INW + h * 64 + d0);
                          const f32x4 g0 = *(const f32x4*)(a.in[I_QNG] + d0) * *(const f32x4*)(a.in[I_KNG] + d0) * rqs, g1 = *(const f32x4*)(a.in[I_QNG] + d0 + 4) * *(const f32x4*)(a.in[I_KNG] + d0 + 4) * rqs;
                          v4u o; o.x = pk2(bflo(w.x) * g0[0], bfhi(w.x) * g0[1]); o.y = pk2(bflo(w.y) * g0[2], bfhi(w.y) * g0[3]); o.z = pk2(bflo(w.z) * g1[0], bfhi(w.z) * g1[1]); o.w = pk2(bflo(w.w) * g1[2], bfhi(w.w) * g1[3]);
                          qf[ks] = __builtin_bit_cast(bf16x8, o); } }
                    f32x4 sc[24]; float mx = -3e38f;
#pragma unroll
                    for (int i = 0; i < 8; ++i) {
                        const int slot = (rs + i) % 9;
                        const LAS unsigned char* kb_ = lds + KRING_OFF + slot * 8192 + cb0 * 2048;
                        const LAS float* rkb = rkr + slot * 64 + 16 * cb0 + 4 * fq;
                        const LAS float* tb = tbl + (dr0 + i) * 32;
#pragma unroll
                        for (int cbk = 0; cbk < 3; ++cbk) {
                            const bf16x8 k0 = *(const LAS bf16x8*)(kb_ + cbk * 2048 + koff0), k1 = *(const LAS bf16x8*)(kb_ + cbk * 2048 + koff1);
                            f32x4 c = {0.f, 0.f, 0.f, 0.f};
                            c = __builtin_amdgcn_mfma_f32_16x16x32_bf16(k0, qf[0], c, 0, 0, 0);
                            c = __builtin_amdgcn_mfma_f32_16x16x32_bf16(k1, qf[1], c, 0, 0, 0);
                            const f32x4 rk = *(const LAS f32x4*)(rkb + 16 * cbk);
                            f32x4 s; s[0] = c[0] * rk[0] + tb[dco[cbk][0]]; s[1] = c[1] * rk[1] + tb[dco[cbk][1]]; s[2] = c[2] * rk[2] + tb[dco[cbk][2]]; s[3] = c[3] * rk[3] + tb[dco[cbk][3]];
                            sc[3 * i + cbk] = s; mx = fmaxf(fmaxf(mx, fmaxf(s[0], s[1])), fmaxf(s[2], s[3]));
                        }
                    }
                    mx = fmaxf(mx, __shfl_xor(mx, 16)); mx = fmaxf(mx, __shfl_xor(mx, 32));
                    float lsum = 0.f;
#pragma unroll
                    for (int kb = 0; kb < 24; ++kb) { f32x4 e; e[0] = __builtin_amdgcn_exp2f(sc[kb][0] - mx); e[1] = __builtin_amdgcn_exp2f(sc[kb][1] - mx); e[2] = __builtin_amdgcn_exp2f(sc[kb][2] - mx); e[3] = __builtin_amdgcn_exp2f(sc[kb][3] - mx);
                        sc[kb] = e; lsum += (e[0] + e[1]) + (e[2] + e[3]); }
                    lsum += __shfl_xor(lsum, 16); lsum += __shfl_xor(lsum, 32);
                    f32x4 oacc[4];
#pragma unroll
                    for (int db = 0; db < 4; ++db) oacc[db] = (f32x4){0.f, 0.f, 0.f, 0.f};
#pragma unroll
                    for (int t = 0; t < 12; ++t) {
                        const int kbA = 2 * t, kbB = 2 * t + 1, iA = kbA / 3, cA = kbA % 3, iB = kbB / 3, cB = kbB % 3;
                        v4u pw; pw.x = cvt_pk(sc[kbA][0], sc[kbA][1]); pw.y = cvt_pk(sc[kbA][2], sc[kbA][3]); pw.z = cvt_pk(sc[kbB][0], sc[kbB][1]); pw.w = cvt_pk(sc[kbB][2], sc[kbB][3]);
                        const bf16x8 pf = __builtin_bit_cast(bf16x8, pw);
                        const LAS unsigned char* vA = lds + VRING_OFF + ((rs + iA) % 9) * 8192 + (cb0 + cA) * 2048, * vB = lds + VRING_OFF + ((rs + iB) % 9) * 8192 + (cb0 + cB) * 2048;
#pragma unroll
                        for (int db = 0; db < 4; ++db) {
                            const s16x4 va = __builtin_bit_cast(s16x4, __builtin_amdgcn_ds_read_tr16_b64_v4i16((LAS s16x4*)(vA + voff[db])));
                            const s16x4 vb = __builtin_bit_cast(s16x4, __builtin_amdgcn_ds_read_tr16_b64_v4i16((LAS s16x4*)(vB + voff[db])));
                            bf16x8 vf; vf[0] = va[0]; vf[1] = va[1]; vf[2] = va[2]; vf[3] = va[3]; vf[4] = vb[0]; vf[5] = vb[1]; vf[6] = vb[2]; vf[7] = vb[3];
                            oacc[db] = __builtin_amdgcn_mfma_f32_16x16x32_bf16(vf, pf, oacc[db], 0, 0, 0);
                        }
                    }
                    const float il = 1.0f / lsum;
#pragma unroll
                    for (int db = 0; db < 4; ++db) { v2u w; w.x = cvt_pk(oacc[db][0] * il, oacc[db][1] * il); w.y = cvt_pk(oacc[db][2] * il, oacc[db][3] * il);
                        *(v2u*)(CAT + (size_t)qrow * D + h * 64 + 16 * db + 4 * fq) = w; }
                } else if ((st & 1) == 0) {
                    const int it = st >> 1, g = wave - 4, pu = pu0 + (it >> 2), tg = 4 * (it & 3) + (lane >> 4), ch = 16 * g + (lane & 15);
                    int pb, prr, prows;
                    if (pu < 256) { pb = pu >> 5; prr = pu & 31; prows = 32; } else { pb = 8 + ((pu - 256) >> 7); prr = (pu - 256) & 127; prows = 128; }
                    const int pbase = pb < 8 ? pb * 2048 : NPR + (pb - 8) * 8192, T = prows * 64, t0 = prr * 64 + 4 * tg;
                    if (g == 0) pool_group<1>(PROJ, CAT, pbase, T, t0, ch); else if (g == 1) pool_group<2>(PROJ, CAT, pbase, T, t0, ch);
                    else if (g == 2) pool_group<4>(PROJ, CAT, pbase, T, t0, ch); else pool_group<8>(PROJ, CAT, pbase, T, t0, ch);
                }
            }
#undef STAGE_ROW
        }
    }
    if (rep < PROBE_REPS(3)) xcd_barrier(bar); }
    SEAM(3);

    for (int rep = 0; rep <= PROBE_REPS(4); ++rep) { const float asc = rep ? 0.f : 1.f; (void)asc;
    if (IN(4)) {
        pg8::Gemm g{CAT, WoT, MT, D, D}; pg8::StaticOrder S; S.init(MT, D, G, bx);
        EpiOut E{a.in[I_XP], a.in[I_XS], MIXB, XG2, rss2, macc, b_ada, a.in[I_N2G], asc};
        pg8::gemm_phase<EpiOut, pg8::StaticOrder, PG8_ALIGN, PG8_SP2>(lds + RING_OFF, g, S, E);
    }
    if (rep < PROBE_REPS(4)) xcd_barrier(bar); }
    SEAM(4);

    for (int rep = 0; rep <= PROBE_REPS(5); ++rep) { const float asc = rep ? 0.f : 1.f; (void)asc;
    if (IN(5)) {
        pg8::Gemm g{XG2, WupT, MT, FF2, D}; pg8::StaticOrder S; S.init(MT, FF2, G, bx);
        EpiConvAct E{ACT, EDGE, rss2, c2acc, convp, cbp, (LAS float*)(lds + XCH_OFF)};
        pg8::gemm_phase<EpiConvAct, pg8::StaticOrder, PG8_ALIGN, PG8_SP2>(lds + RING_OFF, g, S, E);
    }
    if (rep < PROBE_REPS(5)) xcd_barrier(bar); }
    SEAM(5);

    for (int rep = 0; rep <= PROBE_REPS(6); ++rep) { const float asc = rep ? 0.f : 1.f; (void)asc;
    if (IN(6)) {
        LANE_SETUP();
        LAS float* scr = (LAS float*)(lds + RING_OFF + wave * 16384);
        for (int it = gw; it < 44 * 32; it += NGW) { const int kb = it / 32, nb = it % 32; transpose_item(a.in[I_WDOWN], D, 64 * kb, 32 * nb, WdT, FF, 32 * nb, 64 * kb, scr, lane); }
        for (int idx = vcu * 512 + tid; idx < 256 * (FF / 8); idx += G * 512) {
            const int br = idx / (FF / 8), f = 8 * (idx % (FF / 8)), gcol = (f >> 7) * 256 + (f & 127);
            const int pm = br >> 1, last = br & 1, row = pm * 256 + (last ? 255 : 0);
            const int b = batch_of_row(row), t = row < NPR ? (row & 2047) : ((row - NPR) & 8191), T = b < 8 ? 2048 : 8192;
            const float* em; const float* e0; const float* ep;
            if (!last) { em = EDGE + ((size_t)(pm - 1) * 4 + 3) * FF2; e0 = EDGE + ((size_t)pm * 4 + 0) * FF2; ep = EDGE + ((size_t)pm * 4 + 1) * FF2; }
            else       { em = EDGE + ((size_t)pm * 4 + 2) * FF2; e0 = EDGE + ((size_t)pm * 4 + 3) * FF2; ep = EDGE + ((size_t)(pm + 1) * 4 + 0) * FF2; }
            const bool hm = t > 0, hp = t < T - 1;
            float res[2][8];
#pragma unroll
            for (int part = 0; part < 2; ++part) {
                const int col = gcol + 128 * part;
#pragma unroll
                for (int hh = 0; hh < 2; ++hh) {
                    const int c = col + 4 * hh; const f32x4 zero = {0.f, 0.f, 0.f, 0.f};
                    const f32x4 um = hm ? *(const f32x4*)(em + c) : zero, u0 = *(const f32x4*)(e0 + c), up = hp ? *(const f32x4*)(ep + c) : zero;
                    const f32x4 w0 = *(const f32x4*)(convp + c), w1 = *(const f32x4*)(convp + FF2 + c), w2 = *(const f32x4*)(convp + 2 * FF2 + c), cb = *(const f32x4*)(cbp + c);
                    const f32x4 r = w0 * um + w1 * u0 + w2 * up + cb;
                    res[part][4 * hh + 0] = r[0]; res[part][4 * hh + 1] = r[1]; res[part][4 * hh + 2] = r[2]; res[part][4 * hh + 3] = r[3];
                }
            }
            v4u ow; ow.x = pk2(silu_f(res[0][0]) * res[1][0], silu_f(res[0][1]) * res[1][1]); ow.y = pk2(silu_f(res[0][2]) * res[1][2], silu_f(res[0][3]) * res[1][3]);
            ow.z = pk2(silu_f(res[0][4]) * res[1][4], silu_f(res[0][5]) * res[1][5]); ow.w = pk2(silu_f(res[0][6]) * res[1][6], silu_f(res[0][7]) * res[1][7]);
            *(v4u*)(ACT + (size_t)row * FF + f) = ow;
        }
    }
    if (rep < PROBE_REPS(6)) xcd_barrier(bar); }
    SEAM(6);

    for (int rep = 0; rep <= PROBE_REPS(7); ++rep) { const float asc = rep ? 0.f : 1.f; (void)asc;
    if (IN(7)) {
        pg8::Gemm g{ACT, WdT, MT, D, FF}; pg8::StaticOrder S; S.init(MT, D, G, bx);
        EpiDown E{a.in[I_XP], a.in[I_XS], MIXB, a.out, macc, b_ada};
        pg8::gemm_phase<EpiDown, pg8::StaticOrder, PG8_ALIGN, PG8_SP2>(lds + RING_OFF, g, S, E);
    }
    if (rep < PROBE_REPS(7)) xcd_barrier(bar); }
#undef IN
#undef SEAM
}

extern "C" void kernel_launch(void* const* d_in, const int* in_sizes, int n_in, void* d_out, int out_size, void* d_ws, size_t ws_size, hipStream_t stream) {
    static int grid = 0;
    if (grid == 0) {
        if (n_in != 19 || out_size != MT * D || ws_size < WS_END) { fprintf(stderr, "kernel_launch: unexpected shapes (n_in %d, out %d, ws %zu)\n", n_in, out_size, ws_size); grid = -1; return; }
        int dev = 0, cus = 0;
        if (hipGetDevice(&dev) != hipSuccess || hipDeviceGetAttribute(&cus, hipDeviceAttributeMultiprocessorCount, dev) != hipSuccess) { grid = -1; return; }
        if (hipFuncSetAttribute((const void*)fwd, hipFuncAttributeMaxDynamicSharedMemorySize, LDS_BYTES) != hipSuccess) { fprintf(stderr, "kernel_launch: hipFuncSetAttribute failed\n"); grid = -1; return; }
        (void)hipGetLastError();
        grid = cus;
    }
    if (grid < 0) return;
    if (hipMemsetAsync((char*)d_ws + WS_CTL, 0, CTL_ZERO_BYTES, stream) != hipSuccess) return;
    Args a{};
    for (int i = 0; i < 19; ++i) a.in[i] = (const float*)d_in[i];
    a.out = (float*)d_out; a.ws = (unsigned char*)d_ws;
#if MK_ONE_LAUNCH
    a.ph_lo = 0; a.ph_hi = N_PHASES; a.row0 = 0; a.nrows = 0; hipLaunchKernelGGL(fwd, dim3(grid), dim3(NWAVES * 64), LDS_BYTES, stream, a);
#else
    for (int ph = 0; ph < N_PHASES; ++ph) { a.ph_lo = ph; a.ph_hi = ph + 1; hipLaunchKernelGGL(fwd, dim3(grid), dim3(NWAVES * 64), LDS_BYTES, stream, a); }
#endif
}
```

```cpp
#include <hip/hip_runtime.h>
#include <cstdio>
#include <cstdint>

constexpr int D = 1024, MT = 32768, NPR = 16384, INW = 2048, ATTW = 512, HD = 64, NH = 8, FF = 2816, FF2 = 5632, NBATCH = 10, MODW = 6144;
constexpr float EPS = 1e-6f;

namespace pg8 {
#define PG8_LAS __attribute__((address_space(3)))
typedef unsigned short bf16_t;
typedef short bf16x8 __attribute__((ext_vector_type(8)));
typedef float f32x4 __attribute__((ext_vector_type(4)));
typedef unsigned u32x4 __attribute__((ext_vector_type(4)));
constexpr int BM = 256, BK = 64, HALF = 128, HTB = HALF * BK * 2  , STAGE_BYTES = 8 * HTB, NXCD = 8, WGM = 8;

__host__ __device__ __forceinline__ int lds_byte(int r, int c) { const int st = (r >> 4) * 2 + (c >> 5), rr = r & 15, cc = c & 31, ob = rr * 64 + cc * 2; return st * 1024 + (ob ^ (((ob >> 9) & 1) << 5)); }
__host__ __device__ __forceinline__ void stage_rc(int b, int& R, int& C) { const int st = b / 1024, sb = b % 1024, swz = sb ^ (((sb >> 9) & 1) << 5); R = (st >> 1) * 16 + swz / 64; C = (st & 1) * 32 + (swz % 64) / 2; }
__host__ __device__ __forceinline__ int perm32(int rho) { const int n = rho >> 4, i = rho & 15; return 8 * (i >> 2) + 4 * n + (i & 3); }

struct Unit { int pm, pn; };
struct Gemm { const bf16_t* A; const bf16_t* Bt; int M, N, K; };

struct StaticOrder {
    int nM, nN, nwg, G, c;
    __host__ __device__ void init(int M, int N, int G_, int c_) { nM = M / BM; nN = N / BM; nwg = nM * nN; G = G_; c = c_; }
    __host__ __device__ bool next(int i, Unit& u) const {
        const long L = (long)i * G + c; if (L >= nwg) return false;
        int wgid = (int)L; { const int q = nwg / NXCD, r = nwg % NXCD, xcd = wgid % NXCD, off = wgid / NXCD; wgid = (xcd < r ? xcd * (q + 1) : r * (q + 1) + (xcd - r) * q) + off; }
        const int nig = WGM * nN, gid = wgid / nig, fm = gid * WGM, gsz = (nM - fm) < WGM ? (nM - fm) : WGM;
        u.pm = fm + ((wgid % nig) % gsz); u.pn = (wgid % nig) / gsz; return true;
    }
    __device__ __forceinline__ void a_ready(const Unit&) const {}
    __device__ __forceinline__ void done(const Unit&) const {}
};

template <class Epi, class Sched, bool ALIGN_EPI = false, bool SP2 = false>
__device__ __forceinline__ void gemm_phase(PG8_LAS unsigned char* lds, const Gemm g, const Sched& S, const Epi& E, volatile PG8_LAS unsigned* sw = nullptr) {
    unsigned long long sw_t = 0;
    int tid_ = threadIdx.x; asm volatile("" : "+v"(tid_));
    const int tid = tid_, wid = __builtin_amdgcn_readfirstlane(tid >> 6), lane = tid & 63, wr = wid >> 2, wc = wid & 3, fr = lane & 15, fq = lane >> 4;
    const int K = g.K, nt = K / BK;
    unsigned voffA[2], voffB[2];
#pragma unroll
    for (int i = 0; i < 2; ++i) { int R, C; stage_rc(tid * 16 + i * 8192, R, C); const int Rb = Epi::PERM ? ((R & ~31) + perm32(R & 31)) : R;
        const int Ra = Epi::PERMA ? ((R & 64) + 4 * (R & 15) + ((R >> 4) & 3)) : R;
        voffA[i] = (unsigned)(Ra * BK + C) * 2u; voffB[i] = (unsigned)(Rb * BK + C) * 2u; }
    const size_t kstep = (size_t)(BM * BK * 2);
    const size_t hstep = (size_t)HALF * BK * 2;
    const size_t tstep = (size_t)K * BM * 2;
    const unsigned ldsw = (unsigned)wid * 1024u;
    const int aoff = lds_byte(wr * 64 + fr, fq * 8), boff = lds_byte(wc * 32 + fr, fq * 8);
#define PG8_SA(b, h) (((b) * 2 + (h)) * HTB)
#define PG8_SB(b, h) ((4 + (b) * 2 + (h)) * HTB)
#define PG8_STAGE(bufoff, gbase, voff) do { _Pragma("unroll") for (int _i = 0; _i < 2; ++_i) \
        __builtin_amdgcn_global_load_lds((const unsigned*)((const char*)(gbase) + (voff)[_i]), (PG8_LAS unsigned*)(lds + (bufoff) + ldsw + _i * 8192), 16, 0, 0); } while (0)
#define PG8_LDA(dst, b, h) do { _Pragma("unroll") for (int m = 0; m < 4; ++m) _Pragma("unroll") for (int k = 0; k < 2; ++k) dst[m][k] = *(const PG8_LAS bf16x8*)(lds + PG8_SA(b, h) + aoff + m * 2048 + k * 1024); } while (0)
#define PG8_LDB(dst, b, h) do { _Pragma("unroll") for (int n = 0; n < 2; ++n) _Pragma("unroll") for (int k = 0; k < 2; ++k) dst[n][k] = *(const PG8_LAS bf16x8*)(lds + PG8_SB(b, h) + boff + n * 2048 + k * 1024); } while (0)
#define PG8_MMA(ai, bj, At, Bt) do { __builtin_amdgcn_s_setprio(1); _Pragma("unroll") for (int m = 0; m < 4; ++m) _Pragma("unroll") for (int n = 0; n < 2; ++n) _Pragma("unroll") for (int k = 0; k < 2; ++k) \
        acc[ai][bj][m][n] = __builtin_amdgcn_mfma_f32_16x16x32_bf16(Bt[n][k], At[m][k], acc[ai][bj][m][n], 0, 0, 0); __builtin_amdgcn_s_setprio(0); } while (0)
#define PG8_WAIT_V(n) asm volatile("s_waitcnt vmcnt(" #n ")" ::: "memory")
#define PG8_WAIT_L(n) asm volatile("s_waitcnt lgkmcnt(" #n ")" ::: "memory")
#define PG8_BAR __builtin_amdgcn_s_barrier()
#define PG8_SCHED __builtin_amdgcn_sched_barrier(0)
    Unit cur, nxt; int ui = 0;
    if (!S.next(0, cur)) return;
    if constexpr (Epi::PREFETCH) E.prefetch(cur, 0, wid, lane);
    f32x4 acc[2][2][4][2];
#pragma unroll
    for (int a = 0; a < 2; ++a)
#pragma unroll
        for (int b = 0; b < 2; ++b)
#pragma unroll
            for (int m = 0; m < 4; ++m)
#pragma unroll
                for (int n = 0; n < 2; ++n) acc[a][b][m][n] = (f32x4){0.f, 0.f, 0.f, 0.f};
    bf16x8 At[4][2], B0[2][2], B1[2][2];
    const char* cA = (const char*)g.A + (size_t)cur.pm * tstep; const char* cB = (const char*)g.Bt + (size_t)cur.pn * tstep;
    S.a_ready(cur);
    if constexpr (SP2) {
        PG8_STAGE(PG8_SB(0, 0), cB, voffB); PG8_STAGE(PG8_SB(0, 1), cB + hstep, voffB); PG8_STAGE(PG8_SA(0, 0), cA, voffA); PG8_STAGE(PG8_SA(0, 1), cA + hstep, voffA);
        if (wr == 1) PG8_BAR;
        PG8_WAIT_V(2); PG8_BAR;
        PG8_STAGE(PG8_SB(1, 0), cB + kstep, voffB); PG8_STAGE(PG8_SA(1, 0), cA + kstep, voffA); PG8_STAGE(PG8_SB(1, 1), cB + hstep + kstep, voffB);
        PG8_WAIT_V(6); PG8_BAR;
    } else {
        PG8_STAGE(PG8_SB(0, 0), cB, voffB); PG8_STAGE(PG8_SA(0, 0), cA, voffA); PG8_STAGE(PG8_SB(0, 1), cB + hstep, voffB); PG8_STAGE(PG8_SA(0, 1), cA + hstep, voffA);
        if (wr == 1) PG8_BAR;
        PG8_WAIT_V(4); PG8_BAR;
        PG8_STAGE(PG8_SB(1, 0), cB + kstep, voffB); PG8_STAGE(PG8_SA(1, 0), cA + kstep, voffA); PG8_STAGE(PG8_SB(1, 1), cB + hstep + kstep, voffB);
        PG8_WAIT_V(6); PG8_BAR;
    }
    for (;;) {
        if (sw) { __builtin_amdgcn_sched_barrier(0); sw_t = __builtin_amdgcn_s_memrealtime(); __builtin_amdgcn_sched_barrier(0); }
        const bool has_next = S.next(ui + 1, nxt);
        const char* nA = has_next ? (const char*)g.A + (size_t)nxt.pm * tstep : cA; const char* nB = has_next ? (const char*)g.Bt + (size_t)nxt.pn * tstep : cB;
        for (int t = 0; t < nt; t += 2) {
            const bool last = (t == nt - 2);
            const char* a1 = cA + (size_t)(t + 1) * kstep;
            const char* a2 = last ? nA : cA + (size_t)(t + 2) * kstep; const char* b2 = last ? nB : cB + (size_t)(t + 2) * kstep;
            const char* a3 = a2 + kstep; const char* b3 = b2 + kstep;
            if (last && has_next) S.a_ready(nxt);
            if constexpr (SP2) {
            PG8_LDB(B0, 0, 0); PG8_LDB(B1, 0, 1); PG8_SCHED; PG8_LDA(At, 0, 0); PG8_STAGE(PG8_SA(1, 1), a1 + hstep, voffA);
            PG8_WAIT_V(8); PG8_WAIT_L(0); PG8_BAR; PG8_MMA(0, 0, At, B0); PG8_MMA(0, 1, At, B1); PG8_BAR; PG8_SCHED;
            PG8_LDA(At, 0, 1); PG8_STAGE(PG8_SB(0, 0), b2, voffB); PG8_STAGE(PG8_SB(0, 1), b2 + hstep, voffB); PG8_STAGE(PG8_SA(0, 0), a2, voffA);
            PG8_WAIT_V(8); PG8_WAIT_L(0); PG8_BAR; PG8_MMA(1, 0, At, B0); PG8_MMA(1, 1, At, B1); PG8_BAR; PG8_SCHED;
            PG8_LDB(B0, 1, 0); PG8_LDB(B1, 1, 1); PG8_SCHED; PG8_LDA(At, 1, 0); PG8_STAGE(PG8_SA(0, 1), a2 + hstep, voffA);
            PG8_WAIT_V(8); PG8_WAIT_L(0); PG8_BAR; PG8_MMA(0, 0, At, B0); PG8_MMA(0, 1, At, B1); PG8_BAR; PG8_SCHED;
            PG8_LDA(At, 1, 1); PG8_STAGE(PG8_SB(1, 0), b3, voffB); PG8_STAGE(PG8_SB(1, 1), b3 + hstep, voffB); PG8_STAGE(PG8_SA(1, 0), a3, voffA);
            PG8_WAIT_V(8); PG8_WAIT_L(0); PG8_BAR; PG8_MMA(1, 0, At, B0); PG8_MMA(1, 1, At, B1); PG8_BAR; PG8_SCHED;
            } else {
            PG8_LDB(B0, 0, 0); PG8_SCHED; PG8_LDA(At, 0, 0); PG8_STAGE(PG8_SA(1, 1), a1 + hstep, voffA);
            PG8_WAIT_L(8); PG8_BAR; PG8_WAIT_L(0); PG8_MMA(0, 0, At, B0); PG8_BAR; PG8_SCHED;
            PG8_LDB(B1, 0, 1); PG8_STAGE(PG8_SB(0, 0), b2, voffB);
            PG8_BAR; PG8_WAIT_L(0); PG8_MMA(0, 1, At, B1); PG8_BAR;
            PG8_LDA(At, 0, 1); PG8_STAGE(PG8_SA(0, 0), a2, voffA);
            PG8_BAR; PG8_WAIT_L(0); PG8_MMA(1, 0, At, B0); PG8_BAR; PG8_SCHED;
            PG8_STAGE(PG8_SB(0, 1), b2 + hstep, voffB);
            PG8_WAIT_V(6); PG8_BAR; PG8_MMA(1, 1, At, B1); PG8_BAR;
            PG8_LDB(B0, 1, 0); PG8_SCHED; PG8_LDA(At, 1, 0); PG8_STAGE(PG8_SA(0, 1), a2 + hstep, voffA);
            PG8_WAIT_L(8); PG8_BAR; PG8_WAIT_L(0); PG8_MMA(0, 0, At, B0); PG8_BAR; PG8_SCHED;
            PG8_LDB(B1, 1, 1); PG8_STAGE(PG8_SB(1, 0), b3, voffB);
            PG8_BAR; PG8_WAIT_L(0); PG8_MMA(0, 1, At, B1); PG8_BAR;
            PG8_LDA(At, 1, 1); PG8_STAGE(PG8_SA(1, 0), a3, voffA);
            PG8_BAR; PG8_WAIT_L(0); PG8_MMA(1, 0, At, B0); PG8_BAR; PG8_SCHED;
            PG8_STAGE(PG8_SB(1, 1), b3 + hstep, voffB);
            PG8_WAIT_V(6); PG8_BAR; PG8_MMA(1, 1, At, B1); PG8_BAR;
            }
        }
        if constexpr (ALIGN_EPI) { if (wr == 0) PG8_BAR; }
        if (sw) { __builtin_amdgcn_sched_barrier(0); const unsigned long long t1 = __builtin_amdgcn_s_memrealtime(); if (threadIdx.x == 0) sw[0] += (unsigned)(t1 - sw_t); sw_t = t1; __builtin_amdgcn_sched_barrier(0); }
        if constexpr (Epi::PREFETCH) { E.run(acc, cur, wr, wc, fr, fq, ui & 1); if (has_next) E.prefetch(nxt, (ui + 1) & 1, wid, lane); S.done(cur); }
        else if constexpr (!Epi::AFTER_DRAIN) { E(acc, cur, wr, wc, fr, fq); S.done(cur); }
        if (sw) { __builtin_amdgcn_sched_barrier(0); const unsigned long long t1 = __builtin_amdgcn_s_memrealtime(); if (threadIdx.x == 0) sw[1] += (unsigned)(t1 - sw_t); __builtin_amdgcn_sched_barrier(0); }
        if (!has_next) break;
#pragma unroll
        for (int a = 0; a < 2; ++a)
#pragma unroll
            for (int b = 0; b < 2; ++b)
#pragma unroll
                for (int m = 0; m < 4; ++m)
#pragma unroll
                    for (int n = 0; n < 2; ++n) acc[a][b][m][n] = (f32x4){0.f, 0.f, 0.f, 0.f};
        cur = nxt; cA = nA; cB = nB; ++ui;
        if constexpr (ALIGN_EPI) { if (wr == 1) PG8_BAR; }
    }
    PG8_WAIT_V(0);
    if constexpr (!ALIGN_EPI) { if (wr == 0) PG8_BAR; }
    PG8_BAR;
    if constexpr (Epi::AFTER_DRAIN) { E.fused(acc, cur, wr, wc, fr, fq, lds, wid, lane); S.done(cur); }
#undef PG8_SA
#undef PG8_SB
#undef PG8_STAGE
#undef PG8_LDA
#undef PG8_LDB
#undef PG8_MMA
#undef PG8_WAIT_V
#undef PG8_WAIT_L
#undef PG8_BAR
#undef PG8_SCHED
}
}
#ifndef PG8_SP2
#define PG8_SP2 true
#endif
#ifndef PG8_ALIGN
#define PG8_ALIGN true
#endif
constexpr size_t MiB = 1u << 20;
constexpr size_t WS_CTL = 0, CTL_ZERO_BYTES = 3 * MiB;
constexpr size_t OFF_MOD = 131072, OFF_C2 = 393216, OFF_RSS2 = 622592, OFF_HSS = 1 * MiB;
constexpr size_t WS_WIN = 3 * MiB, WS_WOUT = 7 * MiB, WS_WUP = 9 * MiB, WS_WDN = 20 * MiB, WS_SMALL = 26 * MiB, WS_EDGE = 27 * MiB, WS_SLICE0 = 40 * MiB, WS_SLICE = 112 * MiB;
constexpr size_t SL_H1 = 0, SL_PROJ = 16 * MiB, SL_CAT = 48 * MiB, SL_XG2 = 64 * MiB, SL_X1 = 80 * MiB, SL_ACT = 0;
constexpr size_t WS_END = 512 * MiB;
constexpr int NGROUPS = 4, GROWS = MT / NGROUPS, GPANELS = GROWS / 256;
constexpr int CW_BAR = 4096, CW_GBAR = 8192;
constexpr int RING_OFF = 0, RING_BYTES = 131072;
constexpr int XCH_OFF = 131072;
constexpr int KRING_OFF = 0, VRING_OFF = 73728;
constexpr int BIAS_OFF = 147456, RK_OFF = 149504;
constexpr int LDSCTL_OFF = 155648, MISC_OFF = LDSCTL_OFF + 320, LDS_BYTES = 163840;
constexpr int NWAVES = 8;

#define GAS __attribute__((address_space(1)))
#define LAS __attribute__((address_space(3)))
typedef unsigned short bf16;
typedef unsigned v4u __attribute__((ext_vector_type(4)));
typedef unsigned v2u __attribute__((ext_vector_type(2)));
using pg8::f32x4;
#define LDS_WAIT() asm volatile("s_waitcnt lgkmcnt(0)" ::: "memory")
#define VM_WAIT() asm volatile("s_waitcnt vmcnt(0)" ::: "memory")
__device__ __forceinline__ unsigned f2bf(float f) { unsigned u = __builtin_bit_cast(unsigned, f); return (u + 0x7fffu + ((u >> 16) & 1u)) >> 16; }
__device__ __forceinline__ unsigned pk2(float lo, float hi) { return f2bf(lo) | (f2bf(hi) << 16); }
__device__ __forceinline__ float bflo(unsigned w) { return __builtin_bit_cast(float, w << 16); }
__device__ __forceinline__ float bfhi(unsigned w) { return __builtin_bit_cast(float, w & 0xffff0000u); }
typedef float f32x2_t __attribute__((ext_vector_type(2))); typedef __bf16 bf16x2_t __attribute__((ext_vector_type(2))); typedef _Float16 f16x2_t __attribute__((ext_vector_type(2)));
__device__ __forceinline__ unsigned cvt_pk_h(float lo, float hi) { f32x2_t v = {lo, hi}; f16x2_t h = __builtin_convertvector(v, f16x2_t); return __builtin_bit_cast(unsigned, h); }
__device__ __forceinline__ f32x2_t h2f(unsigned w) { return __builtin_convertvector(__builtin_bit_cast(f16x2_t, w), f32x2_t); }
__device__ __forceinline__ unsigned cvt_pk(float lo, float hi) { f32x2_t v = {lo, hi}; bf16x2_t b = __builtin_convertvector(v, bf16x2_t); return __builtin_bit_cast(unsigned, b); }
__device__ __forceinline__ size_t blk_off(int row, int col, int K) { return ((size_t)((row >> 8) * (K >> 6) + (col >> 6)) << 14) + (size_t)(((row & 255) << 6) + (col & 63)); }
__device__ __forceinline__ int batch_of_row(int row) { return row < NPR ? (row >> 11) : 8 + ((row - NPR) >> 13); }
__device__ __forceinline__ int batch_of_tile(int pm) { return pm < 64 ? (pm >> 3) : 8 + ((pm - 64) >> 5); }
__device__ __forceinline__ int permcol(int n) { const int f = n < FF ? n : n - FF; return (f >> 7) * 256 + (f & 127) + (n < FF ? 0 : 128); }
__device__ __forceinline__ float wave_sum(float v) {
#pragma unroll
    for (int o = 1; o < 64; o <<= 1) v += __shfl_xor(v, o);
    return v;
}
__device__ __forceinline__ float silu_f(float x) { return x / (1.0f + __expf(-x)); }

#define XB_TMO      128
#define XB_XCNT(j)  (256  + 64 * (j))
#define XB_XSUB(j)  (1280 + 64 * (j))
#define XB_XGEN(j)  (2304 + 64 * (j))
#define XB_TOP      3328
#define XB_TOPGEN   3392
#define XCD_BAR_WORDS 3456
#define XB_SPIN_CAP (1u << 18)

__device__ __forceinline__ unsigned xb_ld(unsigned* p)              { return __hip_atomic_load(p, __ATOMIC_RELAXED, __HIP_MEMORY_SCOPE_AGENT); }
__device__ __forceinline__ unsigned xb_add(unsigned* p, unsigned v) { return __hip_atomic_fetch_add(p, v, __ATOMIC_RELAXED, __HIP_MEMORY_SCOPE_AGENT); }
__device__ __forceinline__ unsigned xb_xcc_id() { return (unsigned)__builtin_amdgcn_s_getreg((3 << 11) | 20) & 0xFu; }
#define XB_SPIN(cond, bar) do { unsigned _sp = 0; while (cond) { __builtin_amdgcn_s_sleep(1); \
    if ((++_sp & 255u) == 0u) { if (xb_ld(&(bar)[XB_TMO])) break; if (_sp > XB_SPIN_CAP) { atomicAdd(&(bar)[XB_TMO], 1u); break; } } } } while (0)

struct XcdBarrier {
    unsigned* bar; unsigned x; unsigned gsize;
    volatile LAS unsigned* st;
};

__device__ __forceinline__ XcdBarrier xcd_barrier_post(unsigned* bar, volatile LAS unsigned* st, unsigned gsize) {
    XcdBarrier b; b.bar = bar; b.x = xb_xcc_id(); b.st = st; b.gsize = gsize;
    if (threadIdx.x == 0) (void)xb_add(&bar[XB_XCNT(b.x)], 1u);
    return b;
}
__device__ __forceinline__ void xcd_barrier_complete(unsigned* bar, unsigned x, unsigned G, unsigned& nloc, unsigned& nx) {
    unsigned sum, cnt, mine, sp = 0u;
    for (;;) {
        sum = 0u; cnt = 0u; mine = 0u;
#pragma unroll
        for (unsigned j = 0; j < 16; ++j) { const unsigned c = xb_ld(&bar[XB_XCNT(j)]); sum += c; cnt += (c > 0u) ? 1u : 0u; mine = (j == x) ? c : mine; }
        if (sum == G) break;
        __builtin_amdgcn_s_sleep(1);
        if ((++sp & 255u) == 0u) { if (xb_ld(&bar[XB_TMO])) break; if (sp > XB_SPIN_CAP) { atomicAdd(&bar[XB_TMO], 1u); break; } }
    }
    nloc = mine > 0u ? mine : 1u; nx = cnt > 0u ? cnt : 1u;
}

__device__ __forceinline__ void xcd_barrier(const XcdBarrier& b) {
    asm volatile("s_waitcnt vmcnt(0)" ::: "memory");
    __syncthreads();
    if (threadIdx.x == 0) {
        unsigned* bar = b.bar;
        __builtin_amdgcn_s_waitcnt(0);
        unsigned nloc = b.st[0], nx = b.st[1];
        if (nloc == 0u) { xcd_barrier_complete(bar, b.x, b.gsize, nloc, nx); b.st[0] = nloc; b.st[1] = nx; }
        const unsigned old = xb_add(&bar[XB_XSUB(b.x)], 1u);
        const unsigned gen = old / nloc;
        if (old + 1u == (gen + 1u) * nloc) {
            __builtin_amdgcn_fence(__ATOMIC_RELEASE, "agent");
            asm volatile("s_waitcnt vmcnt(0)" ::: "memory");
            const unsigned og = xb_add(&bar[XB_TOP], 1u);
            const unsigned tg = og / nx;
            if (og + 1u == (tg + 1u) * nx) xb_add(&bar[XB_TOPGEN], 1u);
            else XB_SPIN(xb_ld(&bar[XB_TOPGEN]) == tg, bar);
            __builtin_amdgcn_fence(__ATOMIC_ACQUIRE, "agent");
            xb_add(&bar[XB_XGEN(b.x)], 1u);
            asm volatile("s_waitcnt vmcnt(0)" ::: "memory");
        } else {
            XB_SPIN(xb_ld(&bar[XB_XGEN(b.x)]) == gen, bar);
            __builtin_amdgcn_fence(__ATOMIC_ACQUIRE, "agent");
            asm volatile("s_waitcnt vmcnt(0)" ::: "memory");
        }
    }
    __syncthreads();
}

struct GroupOrder {
    int nN, k, xh, cph, nunits;
    __device__ void init(int N, int k_, int xh_, int cph_) { nN = N / 256; k = k_; xh = xh_; cph = cph_; nunits = 16 * nN; }
    __device__ bool next(int i, pg8::Unit& u) const { const int L = i * cph + k; if (L >= nunits) return false; const int nig = 8 * nN, gid = L / nig, w = L % nig; u.pm = 16 * xh + 8 * gid + (w & 7); u.pn = w >> 3; return true; }
    __device__ __forceinline__ void a_ready(const pg8::Unit&) const {}
    __device__ __forceinline__ void done(const pg8::Unit&) const {}
};

typedef const f32x4 (&AccRef)[2][2][4][2];
__device__ __forceinline__ float modv(const float* macc, const float* b_ada, int b, int j) { return macc[b * MODW + j] + b_ada[j]; }
__device__ __forceinline__ f32x4 modv4(const float* macc, const float* b_ada, int b, int j) { return *(const f32x4*)(macc + b * MODW + j) + *(const f32x4*)(b_ada + j); }

struct EpiProj {
    static constexpr bool PERM = true, PERMA = false, AFTER_DRAIN = false, PREFETCH = false;
    bf16* O; float* hss; float asc; int pm0;
    __device__ __forceinline__ void operator()(AccRef acc, const pg8::Unit& u, int wr, int wc, int fr, int fq) const {
        const int row0 = u.pm * 256 + wr * 64 + fr, col0 = u.pn * 256 + wc * 32 + 8 * fq;
#pragma unroll
        for (int ai = 0; ai < 2; ++ai)
#pragma unroll
            for (int m = 0; m < 4; ++m) { bf16* rowp = O + (size_t)(row0 + ai * 128 + m * 16) * INW + col0;
#pragma unroll
                for (int bj = 0; bj < 2; ++bj) { const f32x4 v0 = acc[ai][bj][m][0], v1 = acc[ai][bj][m][1];
                    v4u w; w.x = cvt_pk(v0[0], v0[1]); w.y = cvt_pk(v0[2], v0[3]); w.z = cvt_pk(v1[0], v1[1]); w.w = cvt_pk(v1[2], v1[3]);
                    *(v4u*)(rowp + bj * 128) = w; } }
        if (u.pn < 4) {
#pragma unroll
            for (int ai = 0; ai < 2; ++ai)
#pragma unroll
                for (int m = 0; m < 4; ++m)
#pragma unroll
                    for (int bj = 0; bj < 2; ++bj) { const f32x4 v0 = acc[ai][bj][m][0], v1 = acc[ai][bj][m][1];
                        float s = ((v0[0] * v0[0] + v0[1] * v0[1]) + (v0[2] * v0[2] + v0[3] * v0[3])) + ((v1[0] * v1[0] + v1[1] * v1[1]) + (v1[2] * v1[2] + v1[3] * v1[3]));
                        s += __shfl_xor(s, 16); s += __shfl_xor(s, 32);
                        if (fq == 0) atomicAdd(hss + (size_t)(4 * u.pn + 2 * bj + (wc >> 1)) * MT + pm0 * 256 + row0 + ai * 128 + m * 16, s * asc); }
        }
    }
};
struct EpiOut {
    static constexpr bool PERM = true, PERMA = false, AFTER_DRAIN = false, PREFETCH = false;
    const float* xp; const float* xs; unsigned short* x1; bf16* xg2; float* rss2; const float* g1t; const float* G2t; float asc; int pm0;
    __device__ __forceinline__ void operator()(AccRef acc, const pg8::Unit& u, int wr, int wc, int fr_, int fq_) const {
        int fr = fr_, fq = fq_; asm volatile("" : "+v"(fr), "+v"(fq));
        const int gpm = pm0 + u.pm, b = batch_of_tile(gpm), grow0 = gpm * 256 + wr * 64 + fr, cl = wc * 32 + 8 * fq;
        const char* xb = (const char*)(gpm * 256 < NPR ? xp + (size_t)gpm * 256 * D : xs + ((size_t)gpm * 256 - NPR) * D) + (size_t)u.pn * 1024;
        char* x1b = (char*)(x1 + (size_t)u.pm * 256 * D) + (size_t)u.pn * 512;
        char* xgb = (char*)(xg2 + ((size_t)(u.pm * 16 + u.pn * 4 + (wc >> 1)) << 14));
        const unsigned loff = (unsigned)(((wr * 64 + fr) * D + cl) * 4), xgl = (unsigned)(((wr * 64 + fr) * 64 + (wc & 1) * 32 + 8 * fq) * 2);
        float ss[2][4];
#pragma unroll
        for (int ai = 0; ai < 2; ++ai)
#pragma unroll
            for (int m = 0; m < 4; ++m) ss[ai][m] = 0.f;
        f32x4 xv[2][2][2], g1a[2][2], G2a[2][2];
#define EO_LOADG(bj) do { _Pragma("unroll") for (int n = 0; n < 2; ++n) { const int c_ = u.pn * 256 + (bj) * 128 + cl + 4 * n; g1a[bj][n] = *(const f32x4*)(g1t + b * D + c_); G2a[bj][n] = *(const f32x4*)(G2t + b * D + c_); } } while (0)
#define EO_LOADB(k) do { _Pragma("unroll") for (int mm = 0; mm < 2; ++mm) { const char* xr = xb + (size_t)(((((k) >> 1) & 1) * 128 + (2 * ((k) & 1) + mm) * 16) * D + ((k) >> 2) * 128) * 4; \
            xv[(k) & 1][mm][0] = *(const f32x4*)(xr + loff); xv[(k) & 1][mm][1] = *(const f32x4*)(xr + 16 + loff); } } while (0)
        EO_LOADG(0); EO_LOADB(0);
#pragma unroll
        for (int k = 0; k < 8; ++k) {
            const int bj = k >> 2, ai = (k >> 1) & 1;
            if (k + 1 < 8) EO_LOADB(k + 1);
            if (k == 3) EO_LOADG(1);
            asm volatile("" ::: "memory");
#pragma unroll
            for (int mm = 0; mm < 2; ++mm) { const int m = 2 * (k & 1) + mm;
                const f32x4 v0 = xv[k & 1][mm][0] + g1a[bj][0] * acc[ai][bj][m][0], v1 = xv[k & 1][mm][1] + g1a[bj][1] * acc[ai][bj][m][1];
                { v4u xw; xw.x = cvt_pk_h(v0[0], v0[1]); xw.y = cvt_pk_h(v0[2], v0[3]); xw.z = cvt_pk_h(v1[0], v1[1]); xw.w = cvt_pk_h(v1[2], v1[3]);
                  *(v4u*)(x1b + (size_t)((ai * 128 + m * 16) * D + bj * 128) * 2 + (loff >> 1)) = xw; }
                ss[ai][m] += ((v0[0] * v0[0] + v0[1] * v0[1]) + (v0[2] * v0[2] + v0[3] * v0[3])) + ((v1[0] * v1[0] + v1[1] * v1[1]) + (v1[2] * v1[2] + v1[3] * v1[3]));
                const f32x4 h0 = v0 * G2a[bj][0], h1 = v1 * G2a[bj][1]; v4u w; w.x = cvt_pk(h0[0], h0[1]); w.y = cvt_pk(h0[2], h0[3]); w.z = cvt_pk(h1[0], h1[1]); w.w = cvt_pk(h1[2], h1[3]);
                *(v4u*)(xgb + (size_t)((2 * bj) << 15) + (size_t)((ai * 128 + m * 16) * 128) + xgl) = w;
            }
            asm volatile("" ::: "memory");
        }
#undef EO_LOADG
#undef EO_LOADB
#pragma unroll
        for (int ai = 0; ai < 2; ++ai)
#pragma unroll
            for (int m = 0; m < 4; ++m) { float s = ss[ai][m]; s += __shfl_xor(s, 16); s += __shfl_xor(s, 32);
                if (fq == 0) atomicAdd(rss2 + grow0 + ai * 128 + m * 16, s * asc); }
    }
};
__device__ __forceinline__ float dpp_shr1(float old, float src) { return __builtin_bit_cast(float, __builtin_amdgcn_update_dpp(__builtin_bit_cast(int, old), __builtin_bit_cast(int, src), 0x111, 0xf, 0xf, false)); }
__device__ __forceinline__ float dpp_shl1(float old, float src) { return __builtin_bit_cast(float, __builtin_amdgcn_update_dpp(__builtin_bit_cast(int, old), __builtin_bit_cast(int, src), 0x101, 0xf, 0xf, false)); }
struct EpiConvAct {
    static constexpr bool PERM = true, PERMA = true, AFTER_DRAIN = false, PREFETCH = true;
    bf16* act; float* edge; const float* rss2; const float* c2; const float* convp; const float* cbp; LAS float* X; int pm0;
    __device__ __forceinline__ void prefetch(const pg8::Unit& u, int buf, int wid, int lane) const {
        if (wid < 6) {
            const int gpm = pm0 + u.pm, b = batch_of_tile(gpm);
            const float* src = wid == 0 ? rss2 + gpm * 256 : wid == 1 ? c2 + b * FF2 + u.pn * 256 : wid < 5 ? convp + (wid - 2) * FF2 + u.pn * 256 : cbp + u.pn * 256;
            __builtin_amdgcn_global_load_lds((const unsigned*)(src + 4 * lane), (LAS unsigned*)(X + 2048 + buf * 1536 + wid * 256), 16, 0, 0);
        }
    }
    __device__ __forceinline__ void run(f32x4 (&acc)[2][2][4][2], const pg8::Unit& u, int wr, int wc, int fr_, int fq_, int buf) const {
        int fr = fr_, fq = fq_; asm volatile("" : "+v"(fr), "+v"(fq));
        const int gpm = pm0 + u.pm, colL = wc * 32 + 8 * fq, colg = u.pn * 256 + colL;
        const LAS float* T = X + 2048 + buf * 1536; const LAS float* TB = T + 512;
        {   f32x4 rs[2];
#pragma unroll
            for (int ai = 0; ai < 2; ++ai) { const f32x4 q = *(const LAS f32x4*)(T + 128 * ai + 64 * wr + 4 * fr);
                rs[ai][0] = rsqrtf(q[0] * (1.0f / D) + EPS); rs[ai][1] = rsqrtf(q[1] * (1.0f / D) + EPS); rs[ai][2] = rsqrtf(q[2] * (1.0f / D) + EPS); rs[ai][3] = rsqrtf(q[3] * (1.0f / D) + EPS); }
#pragma unroll
            for (int bj = 0; bj < 2; ++bj)
#pragma unroll
                for (int n = 0; n < 2; ++n) { const f32x4 c2v = *(const LAS f32x4*)(T + 256 + 128 * bj + colL + 4 * n);
#pragma unroll
                    for (int ai = 0; ai < 2; ++ai)
#pragma unroll
                        for (int m = 0; m < 4; ++m) acc[ai][bj][m][n] = acc[ai][bj][m][n] * rs[ai][m] + c2v; } }
#pragma unroll
        for (int bj = 0; bj < 2; ++bj)
#pragma unroll
            for (int n = 0; n < 2; ++n)
#pragma unroll
                for (int ai = 0; ai < 2; ++ai) { const int rb = 2 * ai + wr;
                    if (fr == 0)  *(LAS f32x4*)(X + (rb * 2 + 0) * 256 + 128 * bj + colL + 4 * n) = acc[ai][bj][0][n];
                    if (fr == 15) *(LAS f32x4*)(X + (rb * 2 + 1) * 256 + 128 * bj + colL + 4 * n) = acc[ai][bj][3][n]; }
        asm volatile("s_waitcnt lgkmcnt(0)" ::: "memory"); __builtin_amdgcn_s_barrier(); asm volatile("" ::: "memory");
        if (wr == 0 && fr == 0) {
#pragma unroll
            for (int bj = 0; bj < 2; ++bj)
#pragma unroll
                for (int n = 0; n < 2; ++n) { float* ep = edge + ((size_t)gpm * 4 + 0) * FF2 + colg + 128 * bj + 4 * n; *(f32x4*)ep = acc[0][bj][0][n]; *(f32x4*)(ep + FF2) = acc[0][bj][1][n]; }
        }
        if (wr == 1 && fr == 15) {
#pragma unroll
            for (int bj = 0; bj < 2; ++bj)
#pragma unroll
                for (int n = 0; n < 2; ++n) { float* ep = edge + ((size_t)gpm * 4 + 2) * FF2 + colg + 128 * bj + 4 * n; *(f32x4*)ep = acc[1][bj][2][n]; *(f32x4*)(ep + FF2) = acc[1][bj][3][n]; }
        }
        typedef float f32x2 __attribute__((ext_vector_type(2)));
#pragma unroll
        for (int ai = 0; ai < 2; ++ai) { const int rb = 2 * ai + wr;
            unsigned pk[4][2][2];
#pragma unroll
            for (int n = 0; n < 2; ++n) {
#pragma unroll
                for (int eh = 0; eh < 2; ++eh) {
                    f32x2 sg[4];
#pragma unroll
                    for (int bj = 0; bj < 2; ++bj) { const int col = colg + 128 * bj + 4 * n + 2 * eh;
                        const int tcol = 128 * bj + colL + 4 * n + 2 * eh;
                        const f32x2 w0 = *(const LAS f32x2*)(TB + tcol), w1 = *(const LAS f32x2*)(TB + 256 + tcol), w2 = *(const LAS f32x2*)(TB + 512 + tcol), cb = *(const LAS f32x2*)(TB + 768 + tcol);
                        const int ia = rb > 0 ? (rb - 1) * 2 + 1 : 0, ib = rb < 3 ? (rb + 1) * 2 : 7;
                        const f32x2 above = *(const LAS f32x2*)(X + ia * 256 + 128 * bj + colL + 4 * n + 2 * eh);
                        const f32x2 below = *(const LAS f32x2*)(X + ib * 256 + 128 * bj + colL + 4 * n + 2 * eh);
                        f32x2 U0, U1, U2, U3;
                        U0[0] = acc[ai][bj][0][n][2 * eh]; U0[1] = acc[ai][bj][0][n][2 * eh + 1]; U1[0] = acc[ai][bj][1][n][2 * eh]; U1[1] = acc[ai][bj][1][n][2 * eh + 1];
                        U2[0] = acc[ai][bj][2][n][2 * eh]; U2[1] = acc[ai][bj][2][n][2 * eh + 1]; U3[0] = acc[ai][bj][3][n][2 * eh]; U3[1] = acc[ai][bj][3][n][2 * eh + 1];
                        f32x2 up0, dn3;
                        up0[0] = dpp_shr1(above[0], U3[0]); up0[1] = dpp_shr1(above[1], U3[1]); dn3[0] = dpp_shl1(below[0], U0[0]); dn3[1] = dpp_shl1(below[1], U0[1]);
                        f32x2 cv[4];
                        cv[0] = w0 * up0 + w1 * U0 + w2 * U1 + cb;
                        cv[1] = w0 * U0 + w1 * U1 + w2 * U2 + cb;
                        cv[2] = w0 * U1 + w1 * U2 + w2 * U3 + cb;
                        cv[3] = w0 * U2 + w1 * U3 + w2 * dn3 + cb;
                        if (bj == 0) {
#pragma unroll
                            for (int m = 0; m < 4; ++m)
#pragma unroll
                                for (int e = 0; e < 2; ++e) { const float g = cv[m][e]; sg[m][e] = g * __builtin_amdgcn_rcpf(1.0f + __builtin_amdgcn_exp2f(g * -1.4426950408889634f)); }
                        } else {
#pragma unroll
                            for (int m = 0; m < 4; ++m) { const f32x2 av = sg[m] * cv[m]; pk[m][n][eh] = cvt_pk(av[0], av[1]); }
                        }
                    }
                }
            }
#pragma unroll
            for (int m = 0; m < 4; ++m) { const int tr = 128 * ai + 64 * wr + 4 * fr + m; v4u w; w.x = pk[m][0][0]; w.y = pk[m][0][1]; w.z = pk[m][1][0]; w.w = pk[m][1][1];
                *(v4u*)(act + blk_off(u.pm * 256 + tr, u.pn * 128 + colL, FF)) = w; }
        }
    }
};
struct EpiDown {
    static constexpr bool PERM = true, PERMA = false, AFTER_DRAIN = false, PREFETCH = false;
    const unsigned short* x1; float* out; const float* g2t; int pm0;
    __device__ __forceinline__ void operator()(AccRef acc, const pg8::Unit& u, int wr, int wc, int fr_, int fq_) const {
        int fr = fr_, fq = fq_; asm volatile("" : "+v"(fr), "+v"(fq));
        const int gpm = pm0 + u.pm, b = batch_of_tile(gpm), cl = wc * 32 + 8 * fq;
        const char* xb = (const char*)(x1 + (size_t)u.pm * 256 * D) + (size_t)u.pn * 512;
        char* ob = (char*)(out + (size_t)gpm * 256 * D) + (size_t)u.pn * 1024;
        const unsigned loff = (unsigned)(((wr * 64 + fr) * D + cl) * 4);
        v4u xv[2][2][4];
#pragma unroll
        for (int bj = 0; bj < 2; ++bj)
#pragma unroll
            for (int ai = 0; ai < 2; ++ai)
#pragma unroll
                for (int m = 0; m < 4; ++m) xv[bj][ai][m] = *(const v4u*)(xb + (size_t)((ai * 128 + m * 16) * D + bj * 128) * 2 + (loff >> 1));
        f32x4 g2a[2][2];
#pragma unroll
        for (int bj = 0; bj < 2; ++bj)
#pragma unroll
            for (int n = 0; n < 2; ++n) g2a[bj][n] = *(const f32x4*)(g2t + b * D + u.pn * 256 + bj * 128 + cl + 4 * n);
        asm volatile("" ::: "memory");
#pragma unroll
        for (int bj = 0; bj < 2; ++bj) {
            const f32x4 g2[2] = {g2a[bj][0], g2a[bj][1]};
#pragma unroll
            for (int ai = 0; ai < 2; ++ai)
#pragma unroll
                for (int m = 0; m < 4; ++m) { char* orow = ob + (size_t)((ai * 128 + m * 16) * D + bj * 128) * 4; const v4u w = xv[bj][ai][m];
                    const f32x2_t a0 = h2f(w.x), a1 = h2f(w.y), a2 = h2f(w.z), a3 = h2f(w.w);
                    const f32x4 x0 = {a0[0], a0[1], a1[0], a1[1]}, x1v = {a2[0], a2[1], a3[0], a3[1]};
                    *(f32x4*)(orow + loff) = x0 + g2[0] * acc[ai][bj][m][0]; *(f32x4*)(orow + 16 + loff) = x1v + g2[1] * acc[ai][bj][m][1]; }
        }
    }
};

__device__ __forceinline__ void transpose_item(const float* W, int ldw, int k0, int n0, bf16* WT, int ldt, int drow0, int kd0, LAS float* scr, int lane) {
#pragma unroll 8
    for (int i = 0; i < 32; ++i) { const int kk = 2 * i + (lane >> 5); scr[kk * 33 + (lane & 31)] = W[(size_t)(k0 + kk) * ldw + n0 + (lane & 31)]; }
    LDS_WAIT(); asm volatile("" ::: "memory");
    const int c = lane & 7;
#pragma unroll
    for (int j = 0; j < 4; ++j) { const int n = (lane >> 3) + 8 * j; const LAS float* s = scr + (8 * c) * 33 + n;
        v4u o; o.x = pk2(s[0 * 33], s[1 * 33]); o.y = pk2(s[2 * 33], s[3 * 33]); o.z = pk2(s[4 * 33], s[5 * 33]); o.w = pk2(s[6 * 33], s[7 * 33]);
        *(v4u*)(WT + blk_off(drow0 + n, kd0 + 8 * c, ldt)) = o; }
    LDS_WAIT(); asm volatile("" ::: "memory");
}
template <class Fill> __device__ __forceinline__ void gemv10_item(const float* W, int ldw, int k0, int n, LAS float* sb, float* dst, int dstride, int dcol, float asc, const Fill& fill) {
    float w[64];
#pragma unroll
    for (int kk = 0; kk < 64; ++kk) w[kk] = W[(size_t)(k0 + kk) * ldw + n];
    fill(sb);
    LDS_WAIT(); asm volatile("" ::: "memory");
    float acc[NBATCH];
#pragma unroll
    for (int b = 0; b < NBATCH; ++b) acc[b] = 0.f;
#pragma unroll
    for (int kk = 0; kk < 64; ++kk) {
        const f32x4 s0 = *(const LAS f32x4*)(sb + kk * 12), s1 = *(const LAS f32x4*)(sb + kk * 12 + 4), s2 = *(const LAS f32x4*)(sb + kk * 12 + 8);
        acc[0] += w[kk] * s0[0]; acc[1] += w[kk] * s0[1]; acc[2] += w[kk] * s0[2]; acc[3] += w[kk] * s0[3];
        acc[4] += w[kk] * s1[0]; acc[5] += w[kk] * s1[1]; acc[6] += w[kk] * s1[2]; acc[7] += w[kk] * s1[3];
        acc[8] += w[kk] * s2[0]; acc[9] += w[kk] * s2[1];
    }
#pragma unroll
    for (int b = 0; b < NBATCH; ++b) atomicAdd(dst + (size_t)b * dstride + dcol, acc[b] * asc);
    LDS_WAIT(); asm volatile("" ::: "memory");
}

template <int HW> __device__ __forceinline__ void pool_group(const bf16* PROJ, bf16* CAT, int pbase, int T, int t0, int ch) {
    constexpr int NL = 2 * HW + 3;
    v4u x[NL];
#pragma unroll
    for (int i = 0; i < NL; ++i) { const int s = t0 - HW + i; const v4u z = {0u, 0u, 0u, 0u}; x[i] = (s >= 0 && s < T) ? *(const v4u*)(PROJ + (size_t)(pbase + s) * INW + 3 * ATTW + 8 * ch) : z; }
    float S[8];
#pragma unroll
    for (int c = 0; c < 8; ++c) S[c] = 0.f;
#define POOL_ADD(sgn, VV) do { S[0] += sgn bflo((VV).x); S[1] += sgn bfhi((VV).x); S[2] += sgn bflo((VV).y); S[3] += sgn bfhi((VV).y); S[4] += sgn bflo((VV).z); S[5] += sgn bfhi((VV).z); S[6] += sgn bflo((VV).w); S[7] += sgn bfhi((VV).w); } while (0)
#pragma unroll
    for (int i = 0; i < 2 * HW; ++i) POOL_ADD(+, x[i]);
#pragma unroll
    for (int k = 0; k < 4; ++k) {
        if (k > 0) { POOL_ADD(-, x[k - 1]); POOL_ADD(+, x[k - 1 + 2 * HW]); }
        const int t = t0 + k; const float ic = 1.0f / (float)(min(t + HW, T) - max(t - HW, 0)); const v4u w = x[HW + k];
        v4u ow; ow.x = pk2(S[0] * ic - bflo(w.x), S[1] * ic - bfhi(w.x)); ow.y = pk2(S[2] * ic - bflo(w.y), S[3] * ic - bfhi(w.y));
        ow.z = pk2(S[4] * ic - bflo(w.z), S[5] * ic - bfhi(w.z)); ow.w = pk2(S[6] * ic - bflo(w.w), S[7] * ic - bfhi(w.w));
        *(v4u*)(CAT + blk_off(pbase + t, ATTW + 8 * ch, D)) = ow;
    }
#undef POOL_ADD
}

struct Args { const float* in[19]; float* out; unsigned char* ws; int ph_lo, ph_hi, row0, nrows; };
enum { I_XP = 0, I_XS, I_CP, I_CS, I_WADA, I_BADA, I_N1G, I_N2G, I_WIN, I_QNG, I_KNG, I_RPB, I_WPOOL, I_PSCALE, I_WOUT, I_WUP, I_CONVW, I_CONVB, I_WDOWN };
constexpr int N_PHASES = 8;
#ifndef SW_PHASE
#define SW_PHASE -1
#endif
#ifndef SW_SEL
#define SW_SEL 0
#endif
#ifndef SW_SCALE
#define SW_SCALE 8
#endif
#define SW_PTR(k) ((SW_PHASE == (k) && blockIdx.x == 0) ? (volatile LAS unsigned*)(lds + LDSCTL_OFF + 64) : (volatile LAS unsigned*)nullptr)
#ifndef PROBE_MASK
#define PROBE_MASK 0
#endif
#ifndef PROBE_N
#define PROBE_N 0
#endif
#define PROBE_REPS(k) ((((PROBE_MASK) >> (k)) & 1) ? (PROBE_N) : 0)
#ifndef MK_ONE_LAUNCH
#define MK_ONE_LAUNCH 1
#endif

__global__ void __launch_bounds__(NWAVES * 64, 2) fwd(Args a) {
    extern __shared__ __attribute__((aligned(16))) unsigned char lds_raw[];
    LAS unsigned char* lds = (LAS unsigned char*)lds_raw;
    volatile LAS unsigned* MISC = (volatile LAS unsigned*)(lds + MISC_OFF);
    const int wave = __builtin_amdgcn_readfirstlane((int)threadIdx.x >> 6);
#define LANE_SETUP() int tid_ = threadIdx.x; asm volatile("" : "+v"(tid_)); const int tid = tid_, lane = tid & 63; (void)lane
    const int G = gridDim.x; const int bx = blockIdx.x; const int vcu = (bx % 8) * (G / 8) + bx / 8;
    const int gw = vcu * NWAVES + wave, NGW = G * NWAVES;
    const int grp = (bx & 7) >> 1, xh = bx & 1, gk = bx >> 3, cph = G >> 3, gsz = G >> 2, pm0 = GPANELS * grp;
    unsigned char* ws = a.ws;
    unsigned* ctl = (unsigned*)(ws + WS_CTL);
    float* macc = (float*)(ws + OFF_MOD); float* c2acc = (float*)(ws + OFF_C2); float* rss2 = (float*)(ws + OFF_RSS2); float* hss = (float*)(ws + OFF_HSS);
    bf16* WinT = (bf16*)(ws + WS_WIN); bf16* WoT = (bf16*)(ws + WS_WOUT); bf16* WupT = (bf16*)(ws + WS_WUP); bf16* WdT = (bf16*)(ws + WS_WDN);
    float* convp = (float*)(ws + WS_SMALL); float* cbp = convp + 3 * FF2;
    float* g1t = (float*)(ws + WS_SMALL + 131072); float* G2t = g1t + NBATCH * D; float* g2t = G2t + NBATCH * D;
    float* EDGE = (float*)(ws + WS_EDGE);
    unsigned char* slice = ws + WS_SLICE0 + (size_t)grp * WS_SLICE;
    bf16* H1g = (bf16*)(slice + SL_H1); bf16* PROJg = (bf16*)(slice + SL_PROJ); bf16* CATg = (bf16*)(slice + SL_CAT); unsigned short* X1g = (unsigned short*)(slice + SL_X1); bf16* XG2g = (bf16*)(slice + SL_XG2); bf16* ACTg = (bf16*)(slice + SL_ACT);
    const float* b_ada = a.in[I_BADA];

    for (int u = threadIdx.x; u < (LDS_BYTES - LDSCTL_OFF) / 4; u += NWAVES * 64) ((LAS unsigned*)(lds + LDSCTL_OFF))[u] = 0u;
    __syncthreads();
    XcdBarrier bar = xcd_barrier_post(ctl + CW_BAR, MISC + 8, (unsigned)G);
    XcdBarrier barg = xcd_barrier_post(ctl + CW_GBAR + grp * XCD_BAR_WORDS, MISC + 12, (unsigned)gsz);
#define IN(k) true
#define SEAM(k) do { if ((k) < 2) xcd_barrier(bar); else xcd_barrier(barg); } while (0)

    for (int rep = 0; rep <= PROBE_REPS(0); ++rep) { const float asc = rep ? 0.f : 1.f; (void)asc;
    if (IN(0)) {
        LANE_SETUP();
        LAS float* scr = (LAS float*)(lds + RING_OFF + wave * 16384);
        for (int it = gw; it < 16 * 96; it += NGW) {
            const int kc = it / 96, nc = it % 96, k = 64 * kc + lane;
            const float* cp = a.in[I_CP]; const float* cs = a.in[I_CS];
            gemv10_item(a.in[I_WADA], MODW, 64 * kc, 64 * nc + lane, scr, macc, MODW, 64 * nc + lane, asc, [=](LAS float* sb) {
#pragma unroll
                for (int b = 0; b < NBATCH; ++b) { const float c = b < 8 ? cp[b * D + k] : cs[(b - 8) * D + k]; sb[lane * 12 + b] = silu_f(c); } });
        }
    }
    if (rep < PROBE_REPS(0)) xcd_barrier(bar); }
    SEAM(0);

    for (int rep = 0; rep <= PROBE_REPS(1); ++rep) { const float asc = rep ? 0.f : 1.f; (void)asc;
    if (IN(1)) {
        LANE_SETUP();
        LAS float* scr = (LAS float*)(lds + RING_OFF + wave * 16384);
        constexpr int I0 = 16 * 64, I1 = I0 + 8 * 32, I2 = I1 + 16 * 176, I4 = I2 + 44 * 32, I5 = I4 + 4 * 16 * 16, I6 = I5 + 88, I7 = I6 + NBATCH * 16;
        for (int it = gw; it < I7; it += NGW) {
            if (it < I0) { const int kb = it / 64, nb = it % 64; transpose_item(a.in[I_WIN], INW, 64 * kb, 32 * nb, WinT, D, 32 * nb, 64 * kb, scr, lane); }
            else if (it < I1) { const int r = it - I0, kb = r / 32, nb = r % 32; transpose_item(a.in[I_WOUT], D, 64 * kb, 32 * nb, WoT, D, 32 * nb, 64 * kb, scr, lane); }
            else if (it < I2) { const int r = it - I1, kb = r / 176, nb = r % 176; transpose_item(a.in[I_WUP], FF2, 64 * kb, 32 * nb, WupT, D, permcol(32 * nb), 64 * kb, scr, lane);
                LAS float* sb2 = scr + 64 * 33 + 16;
#pragma unroll
                for (int b = 0; b < NBATCH; ++b) sb2[lane * 12 + b] = modv(macc, b_ada, b, 3 * D + 64 * kb + lane);
                LDS_WAIT(); asm volatile("" ::: "memory");
                const int cn = lane & 31, bh = 5 * (lane >> 5);
                float ac[5] = {0.f, 0.f, 0.f, 0.f, 0.f};
#pragma unroll 8
                for (int kk = 0; kk < 64; ++kk) { const float w = scr[kk * 33 + cn];
#pragma unroll
                    for (int i = 0; i < 5; ++i) ac[i] += w * sb2[kk * 12 + bh + i]; }
#pragma unroll
                for (int i = 0; i < 5; ++i) atomicAdd(c2acc + (size_t)(bh + i) * FF2 + permcol(32 * nb) + cn, ac[i] * asc);
                LDS_WAIT(); asm volatile("" ::: "memory"); }
            else if (it < I4) { const int r = it - I2, kb = r / 32, nb = r % 32; transpose_item(a.in[I_WDOWN], D, 64 * kb, 32 * nb, WdT, FF, 32 * nb, 64 * kb, scr, lane); }
            else if (it < I5) {
                const int r = it - I4, g = r / 256, cb = (r / 16) % 16, nb = r % 16, n = 64 * nb + lane;
                float acc[8];
#pragma unroll
                for (int i = 0; i < 8; ++i) acc[i] = 0.f;
                const float* wp = a.in[I_WPOOL] + (size_t)(g * 128 + 8 * cb) * 128;
#pragma unroll 8
                for (int d = 0; d < 128; ++d) {
                    const float wo = a.in[I_WOUT][(size_t)(ATTW + g * 128 + d) * D + n] * a.in[I_PSCALE][g * 128 + d];
#pragma unroll
                    for (int i = 0; i < 8; ++i) acc[i] += wp[i * 128 + d] * wo;
                }
                v4u o; o.x = pk2(acc[0], acc[1]); o.y = pk2(acc[2], acc[3]); o.z = pk2(acc[4], acc[5]); o.w = pk2(acc[6], acc[7]);
                *(v4u*)(WoT + blk_off(n, ATTW + g * 128 + 8 * cb, D)) = o;
            }
            else if (it < I6) { const int n = 64 * (it - I5) + lane, pc = permcol(n);
                convp[pc] = a.in[I_CONVW][n]; convp[FF2 + pc] = a.in[I_CONVW][FF2 + n]; convp[2 * FF2 + pc] = a.in[I_CONVW][2 * FF2 + n]; cbp[pc] = a.in[I_CONVB][n]; }
            else { const int r = it - I6, b = r / 16, j = 64 * (r % 16) + lane;
                g1t[b * D + j] = modv(macc, b_ada, b, 2 * D + j); G2t[b * D + j] = a.in[I_N2G][j] * (modv(macc, b_ada, b, 4 * D + j) + 1.0f); g2t[b * D + j] = modv(macc, b_ada, b, 5 * D + j); }
        }
        for (int r0 = gw * 16; r0 < MT; r0 += NGW * 16) {
            const int b = batch_of_row(r0);
            bf16* h1b = (bf16*)(ws + WS_SLICE0 + (size_t)(r0 / GROWS) * WS_SLICE + SL_H1);
            f32x4 Gv[4], Sv[4];
#pragma unroll
            for (int j = 0; j < 4; ++j) { const int c = 4 * lane + 256 * j; Gv[j] = *(const f32x4*)(a.in[I_N1G] + c) * (modv4(macc, b_ada, b, D + c) + 1.0f); Sv[j] = modv4(macc, b_ada, b, c); }
#pragma unroll 1
            for (int rr = 0; rr < 16; rr += 4) {
                f32x4 v[4][4]; float s[4];
#pragma unroll
                for (int q = 0; q < 4; ++q) { const int row = r0 + rr + q; const float* xrow = row < NPR ? a.in[I_XP] + (size_t)row * D : a.in[I_XS] + (size_t)(row - NPR) * D;
#pragma unroll
                    for (int j = 0; j < 4; ++j) v[q][j] = *(const f32x4*)(xrow + 4 * lane + 256 * j); }
#pragma unroll
                for (int q = 0; q < 4; ++q) { float t = 0.f;
#pragma unroll
                    for (int j = 0; j < 4; ++j) t += (v[q][j][0] * v[q][j][0] + v[q][j][1] * v[q][j][1]) + (v[q][j][2] * v[q][j][2] + v[q][j][3] * v[q][j][3]);
                    s[q] = t; }
#pragma unroll
                for (int o = 1; o < 64; o <<= 1) { s[0] += __shfl_xor(s[0], o); s[1] += __shfl_xor(s[1], o); s[2] += __shfl_xor(s[2], o); s[3] += __shfl_xor(s[3], o); }
#pragma unroll
                for (int q = 0; q < 4; ++q) { const int row = r0 + rr + q; const float rstd = rsqrtf(s[q] * (1.0f / D) + EPS);
#pragma unroll
                    for (int j = 0; j < 4; ++j) { const f32x4 h = v[q][j] * rstd * Gv[j] + Sv[j]; v2u w; w.x = pk2(h[0], h[1]); w.y = pk2(h[2], h[3]);
                        *(v2u*)(h1b + blk_off(row & (GROWS - 1), 4 * lane + 256 * j, D)) = w; } }
            }
        }
    }
    if (rep < PROBE_REPS(1)) xcd_barrier(bar); }
    SEAM(1);

#ifndef GROUP_SKEW_US
#define GROUP_SKEW_US 0
#endif
    if (GROUP_SKEW_US > 0 && grp > 0) {
        if (threadIdx.x == 0) { const unsigned long long t0 = __builtin_amdgcn_s_memrealtime(), tgt = (unsigned long long)(100 * GROUP_SKEW_US) * (unsigned)grp;
            while (__builtin_amdgcn_s_memrealtime() - t0 < tgt) __builtin_amdgcn_s_sleep(10); }
        __syncthreads();
    }
    for (int rep = 0; rep <= PROBE_REPS(2); ++rep) { const float asc = rep ? 0.f : 1.f; (void)asc;
    if (IN(2)) {
        pg8::Gemm g{H1g, WinT, GROWS, INW, D}; GroupOrder S; S.init(INW, gk, xh, cph);
        EpiProj E{PROJg, hss, asc, pm0};
        pg8::gemm_phase<EpiProj, GroupOrder, PG8_ALIGN, PG8_SP2>(lds + RING_OFF, g, S, E, SW_PTR(2));
    }
    if (rep < PROBE_REPS(2)) xcd_barrier(barg); }
    SEAM(2);

    for (int rep = 0; rep <= PROBE_REPS(3); ++rep) { const float asc = rep ? 0.f : 1.f; (void)asc;
    if (IN(3)) {
        LANE_SETUP();
        typedef short bf16x8 __attribute__((ext_vector_type(8)));
        typedef short s16x4 __attribute__((ext_vector_type(4)));
        LAS float* tbl = (LAS float*)(lds + BIAS_OFF);
        LAS float* rkr = (LAS float*)(lds + RK_OFF);
        const int fq = lane >> 4, l15 = lane & 15, tq = l15 >> 2, tp = lane & 3;
        const int j = wave & 3, kc0 = min(max(16 * j - 8, 0), 32);
        for (int task = xh * cph + gk; task < 64; task += 2 * cph) {
            int b, h, r0, rows;
            if (grp < 2) { b = 4 * grp + (task >> 4); h = (task >> 1) & 7; r0 = (task & 1) * 16; rows = 32; }
            else { b = 8 + (grp - 2); h = task >> 3; r0 = (task & 7) * 16; rows = 128; }
            const int base = b < 8 ? b * 2048 : NPR + (b - 8) * 8192;
            const int gbase = base - GROWS * grp;
            __syncthreads();
            { const int dr = tid >> 5, dc = tid & 31; tbl[tid] = (dr < 15 && dc < 31) ? a.in[I_RPB][h * 465 + dr * 31 + dc] * 1.4426950408889634f : -1e30f; }
            int dco[2][4];
            { const int qc = 16 * j + l15, cs = min(max(qc - 8, 0), 48);
#pragma unroll
              for (int cbk = 0; cbk < 2; ++cbk)
#pragma unroll
                  for (int e = 0; e < 4; ++e) { const int kc = kc0 + 16 * cbk + 4 * fq + e; dco[cbk][e] = 4 * ((kc >= cs && kc < cs + 16) ? (kc - qc + 15) : 31); } }
            const int koff0 = l15 * 128 + 16 * (fq ^ (l15 & 7)), koff1 = l15 * 128 + 16 * ((fq ^ (l15 & 7)) ^ 4);
            int voff[4];
#pragma unroll
            for (int db = 0; db < 4; ++db) voff[db] = (4 * fq + tq) * 128 + 16 * ((2 * db + (tp >> 1)) ^ (4 * (fq & 1) + tq)) + 8 * (tp & 1);
#define STAGE_ROW(kr) do { const int kr_ = (kr); const int slot_ = kr_ % 9; const int tc_ = 8 * wave + (lane >> 3), c16_ = (lane & 7) ^ (tc_ & 7); \
                const bf16* src_ = PROJg + (size_t)(gbase + kr_ * 64 + tc_) * INW + ATTW + h * 64 + 8 * c16_; \
                __builtin_amdgcn_global_load_lds((const unsigned*)src_, (LAS unsigned*)(lds + KRING_OFF + slot_ * 8192 + wave * 1024), 16, 0, 0); \
                __builtin_amdgcn_global_load_lds((const unsigned*)(src_ + ATTW), (LAS unsigned*)(lds + VRING_OFF + slot_ * 8192 + wave * 1024), 16, 0, 0); \
                if (wave == 4) rkr[slot_ * 64 + lane] = rsqrtf(hss[(size_t)(8 + h) * MT + base + kr_ * 64 + lane] * (1.0f / 64.0f) + EPS) * 1.4426950408889634f; } while (0)
            { const int lo0 = min(max(r0 - 4, 0), rows - 8);
              for (int kr = lo0; kr < lo0 + 8; ++kr) STAGE_ROW(kr); }
            const int pu0 = 128 * grp + 2 * task;
            v4u qraw[2] = {{0u, 0u, 0u, 0u}, {0u, 0u, 0u, 0u}}; float qss = 0.f;
            if (wave < 4) { const int qrow0 = base + r0 * 64 + 16 * j + l15; qss = hss[(size_t)h * MT + qrow0];
                qraw[0] = *(const v4u*)(PROJg + (size_t)(qrow0 - GROWS * grp) * INW + h * 64 + 8 * fq); qraw[1] = *(const v4u*)(PROJg + (size_t)(qrow0 - GROWS * grp) * INW + h * 64 + 32 + 8 * fq); }
#pragma unroll 1
            for (int st = 0; st < 16; ++st) {
                if (wave < 4 && st > 0) asm volatile("s_waitcnt vmcnt(4)" ::: "memory"); else VM_WAIT();
                LDS_WAIT(); __builtin_amdgcn_s_barrier(); asm volatile("" ::: "memory");
                const int r = r0 + st, rs = min(max(r - 4, 0), rows - 8);
                if (st < 15) { const int rsn = min(max(r + 1 - 4, 0), rows - 8); if (rsn != rs) STAGE_ROW(rsn + 7); }
                if (wave < 4) {
                    const int dr0 = rs - r + 7;
                    const int qrow = base + r * 64 + 16 * j + l15;
                    bf16x8 qf[2];
                    { const float rqs = rsqrtf(qss * (1.0f / 64.0f) + EPS) * 0.125f;
#pragma unroll
                      for (int ks = 0; ks < 2; ++ks) { const int d0 = 32 * ks + 8 * fq; const v4u w = qraw[ks];
                          const f32x4 g0 = *(const f32x4*)(a.in[I_QNG] + d0) * *(const f32x4*)(a.in[I_KNG] + d0) * rqs, g1 = *(const f32x4*)(a.in[I_QNG] + d0 + 4) * *(const f32x4*)(a.in[I_KNG] + d0 + 4) * rqs;
                          v4u o; o.x = pk2(bflo(w.x) * g0[0], bfhi(w.x) * g0[1]); o.y = pk2(bflo(w.y) * g0[2], bfhi(w.y) * g0[3]); o.z = pk2(bflo(w.z) * g1[0], bfhi(w.z) * g1[1]); o.w = pk2(bflo(w.w) * g1[2], bfhi(w.w) * g1[3]);
                          qf[ks] = __builtin_bit_cast(bf16x8, o); } }
                    if (st < 15) { qss = hss[(size_t)h * MT + qrow + 64]; qraw[0] = *(const v4u*)(PROJg + (size_t)(qrow + 64 - GROWS * grp) * INW + h * 64 + 8 * fq); qraw[1] = *(const v4u*)(PROJg + (size_t)(qrow + 64 - GROWS * grp) * INW + h * 64 + 32 + 8 * fq); }
                    f32x4 sc[16]; float mx = -3e38f;
                    bf16x8 kA[2][2], kB[2][2]; f32x4 rkv[2]; float bsv[2][4];
                    const LAS unsigned char* tba[2][4];
#pragma unroll
                    for (int cbk = 0; cbk < 2; ++cbk)
#pragma unroll
                        for (int e = 0; e < 4; ++e) tba[cbk][e] = (const LAS unsigned char*)(tbl + dr0 * 32) + dco[cbk][e];
#define ATT_LOAD_K(KF, i) do { const LAS unsigned char* kb_ = lds + KRING_OFF + ((rs + (i)) % 9) * 8192 + kc0 * 128; \
                        _Pragma("unroll") for (int cbk = 0; cbk < 2; ++cbk) { KF[cbk][0] = *(const LAS bf16x8*)(kb_ + cbk * 2048 + koff0); KF[cbk][1] = *(const LAS bf16x8*)(kb_ + cbk * 2048 + koff1); } } while (0)
#define ATT_LOAD_RB(i) do { const LAS float* rkb_ = rkr + ((rs + (i)) % 9) * 64 + kc0 + 4 * fq; \
                        _Pragma("unroll") for (int cbk = 0; cbk < 2; ++cbk) { rkv[cbk] = *(const LAS f32x4*)(rkb_ + 16 * cbk); \
                            bsv[cbk][0] = *(const LAS float*)(tba[cbk][0] + (i) * 128); bsv[cbk][1] = *(const LAS float*)(tba[cbk][1] + (i) * 128); bsv[cbk][2] = *(const LAS float*)(tba[cbk][2] + (i) * 128); bsv[cbk][3] = *(const LAS float*)(tba[cbk][3] + (i) * 128); } } while (0)
#define ATT_COMP_ROW(KF, i) do { f32x4 c_[2]; _Pragma("unroll") for (int cbk = 0; cbk < 2; ++cbk) { c_[cbk] = (f32x4){0.f, 0.f, 0.f, 0.f}; \
                            c_[cbk] = __builtin_amdgcn_mfma_f32_16x16x32_bf16(KF[cbk][0], qf[0], c_[cbk], 0, 0, 0); c_[cbk] = __builtin_amdgcn_mfma_f32_16x16x32_bf16(KF[cbk][1], qf[1], c_[cbk], 0, 0, 0); } \
                        _Pragma("unroll") for (int cbk = 0; cbk < 2; ++cbk) { \
                            f32x4 s; s[0] = c_[cbk][0] * rkv[cbk][0] + bsv[cbk][0]; s[1] = c_[cbk][1] * rkv[cbk][1] + bsv[cbk][1]; s[2] = c_[cbk][2] * rkv[cbk][2] + bsv[cbk][2]; s[3] = c_[cbk][3] * rkv[cbk][3] + bsv[cbk][3]; \
                            sc[2 * (i) + cbk] = s; mx = fmaxf(fmaxf(mx, fmaxf(s[0], s[1])), fmaxf(s[2], s[3])); } } while (0)
                    ATT_LOAD_K(kA, 0);
#pragma unroll
                    for (int i2 = 0; i2 < 4; ++i2) {
                        ATT_LOAD_K(kB, 2 * i2 + 1); ATT_LOAD_RB(2 * i2); __builtin_amdgcn_sched_barrier(0);
                        ATT_COMP_ROW(kA, 2 * i2);     __builtin_amdgcn_sched_barrier(0);
                        if (i2 < 3) { ATT_LOAD_K(kA, 2 * i2 + 2); } ATT_LOAD_RB(2 * i2 + 1); __builtin_amdgcn_sched_barrier(0);
                        ATT_COMP_ROW(kB, 2 * i2 + 1); __builtin_amdgcn_sched_barrier(0);
                    }
#undef ATT_LOAD_K
#undef ATT_LOAD_RB
#undef ATT_COMP_ROW
                    mx = fmaxf(mx, __shfl_xor(mx, 16)); mx = fmaxf(mx, __shfl_xor(mx, 32));
                    float lsum = 0.f;
#pragma unroll
                    for (int kb = 0; kb < 16; ++kb) { f32x4 e; e[0] = __builtin_amdgcn_exp2f(sc[kb][0] - mx); e[1] = __builtin_amdgcn_exp2f(sc[kb][1] - mx); e[2] = __builtin_amdgcn_exp2f(sc[kb][2] - mx); e[3] = __builtin_amdgcn_exp2f(sc[kb][3] - mx);
                        sc[kb] = e; lsum += (e[0] + e[1]) + (e[2] + e[3]); }
                    lsum += __shfl_xor(lsum, 16); lsum += __shfl_xor(lsum, 32);
                    f32x4 oacc[4];
#pragma unroll
                    for (int db = 0; db < 4; ++db) oacc[db] = (f32x4){0.f, 0.f, 0.f, 0.f};
                    s16x4 vaA[4], vbA[4], vaB[4], vbB[4];
#define ATT_LOAD_V(VA, VB, t) do { const LAS unsigned char* pA_ = lds + VRING_OFF + ((rs + (t)) % 9) * 8192 + kc0 * 128, * pB_ = pA_ + 2048; \
                        _Pragma("unroll") for (int db = 0; db < 4; ++db) { VA[db] = __builtin_bit_cast(s16x4, __builtin_amdgcn_ds_read_tr16_b64_v4i16((LAS s16x4*)(pA_ + voff[db]))); \
                            VB[db] = __builtin_bit_cast(s16x4, __builtin_amdgcn_ds_read_tr16_b64_v4i16((LAS s16x4*)(pB_ + voff[db]))); } } while (0)
#define ATT_COMP_V(VA, VB, t) do { const int kbA_ = 2 * (t), kbB_ = 2 * (t) + 1; \
                        v4u pw_; pw_.x = cvt_pk(sc[kbA_][0], sc[kbA_][1]); pw_.y = cvt_pk(sc[kbA_][2], sc[kbA_][3]); pw_.z = cvt_pk(sc[kbB_][0], sc[kbB_][1]); pw_.w = cvt_pk(sc[kbB_][2], sc[kbB_][3]); \
                        const bf16x8 pf_ = __builtin_bit_cast(bf16x8, pw_); \
                        _Pragma("unroll") for (int db = 0; db < 4; ++db) { bf16x8 vf_; vf_[0] = VA[db][0]; vf_[1] = VA[db][1]; vf_[2] = VA[db][2]; vf_[3] = VA[db][3]; vf_[4] = VB[db][0]; vf_[5] = VB[db][1]; vf_[6] = VB[db][2]; vf_[7] = VB[db][3]; \
                            oacc[db] = __builtin_amdgcn_mfma_f32_16x16x32_bf16(vf_, pf_, oacc[db], 0, 0, 0); } } while (0)
                    ATT_LOAD_V(vaA, vbA, 0);
#pragma unroll
                    for (int t2 = 0; t2 < 4; ++t2) {
                        ATT_LOAD_V(vaB, vbB, 2 * t2 + 1); __builtin_amdgcn_sched_barrier(0);
                        ATT_COMP_V(vaA, vbA, 2 * t2);     __builtin_amdgcn_sched_barrier(0);
                        if (t2 < 3) { ATT_LOAD_V(vaA, vbA, 2 * t2 + 2); } __builtin_amdgcn_sched_barrier(0);
                        ATT_COMP_V(vaB, vbB, 2 * t2 + 1); __builtin_amdgcn_sched_barrier(0);
                    }
#undef ATT_LOAD_V
#undef ATT_COMP_V
                    const float il = 1.0f / lsum;
#pragma unroll
                    for (int db = 0; db < 4; ++db) { v2u w; w.x = cvt_pk(oacc[db][0] * il, oacc[db][1] * il); w.y = cvt_pk(oacc[db][2] * il, oacc[db][3] * il);
                        *(v2u*)(CATg + blk_off(qrow - GROWS * grp, h * 64 + 16 * db + 4 * fq, D)) = w; }
                } else if ((st & 1) == 0) {
                    const int it = st >> 1, g = wave - 4, pu = pu0 + (it >> 2), tg = 4 * (it & 3) + (lane >> 4), ch = 16 * g + (lane & 15);
                    int pb, prr, prows;
                    if (pu < 256) { pb = pu >> 5; prr = pu & 31; prows = 32; } else { pb = 8 + ((pu - 256) >> 7); prr = (pu - 256) & 127; prows = 128; }
                    const int pbase = (pb < 8 ? pb * 2048 : NPR + (pb - 8) * 8192) - GROWS * grp, T = prows * 64, t0 = prr * 64 + 4 * tg;
                    if (g == 0) pool_group<1>(PROJg, CATg, pbase, T, t0, ch); else if (g == 1) pool_group<2>(PROJg, CATg, pbase, T, t0, ch);
                    else if (g == 2) pool_group<4>(PROJg, CATg, pbase, T, t0, ch); else pool_group<8>(PROJg, CATg, pbase, T, t0, ch);
                }
            }
#undef STAGE_ROW
        }
    }
    if (rep < PROBE_REPS(3)) xcd_barrier(barg); }
    SEAM(3);

    for (int rep = 0; rep <= PROBE_REPS(4); ++rep) { const float asc = rep ? 0.f : 1.f; (void)asc;
    if (IN(4)) {
        pg8::Gemm g{CATg, WoT, GROWS, D, D}; GroupOrder S; S.init(D, gk, xh, cph);
        EpiOut E{a.in[I_XP], a.in[I_XS], X1g, XG2g, rss2, g1t, G2t, asc, pm0};
        pg8::gemm_phase<EpiOut, GroupOrder, PG8_ALIGN, PG8_SP2>(lds + RING_OFF, g, S, E, SW_PTR(4));
    }
    if (rep < PROBE_REPS(4)) xcd_barrier(barg); }
    SEAM(4);

    for (int rep = 0; rep <= PROBE_REPS(5); ++rep) { const float asc = rep ? 0.f : 1.f; (void)asc;
    if (IN(5)) {
        pg8::Gemm g{XG2g, WupT, GROWS, FF2, D}; GroupOrder S; S.init(FF2, gk, xh, cph);
        EpiConvAct E{ACTg, EDGE, rss2, c2acc, convp, cbp, (LAS float*)(lds + XCH_OFF), pm0};
        pg8::gemm_phase<EpiConvAct, GroupOrder, PG8_ALIGN, PG8_SP2>(lds + RING_OFF, g, S, E, SW_PTR(5));
    }
    if (rep < PROBE_REPS(5)) xcd_barrier(barg); }
    SEAM(5);

    for (int rep = 0; rep <= PROBE_REPS(6); ++rep) { const float asc = rep ? 0.f : 1.f; (void)asc;
    if (IN(6)) {
        LANE_SETUP();
        for (int idx = (xh * cph + gk) * 512 + tid; idx < 2 * GPANELS * (FF / 8); idx += gsz * 512) {
            const int br = idx / (FF / 8), f = 8 * (idx % (FF / 8)), gcol = (f >> 7) * 256 + (f & 127);
            const int pm = pm0 + (br >> 1), last = br & 1, row = pm * 256 + (last ? 255 : 0);
            const int b = batch_of_row(row), t = row < NPR ? (row & 2047) : ((row - NPR) & 8191), T = b < 8 ? 2048 : 8192;
            const float* em; const float* e0; const float* ep;
            if (!last) { em = EDGE + ((size_t)(pm - 1) * 4 + 3) * FF2; e0 = EDGE + ((size_t)pm * 4 + 0) * FF2; ep = EDGE + ((size_t)pm * 4 + 1) * FF2; }
            else       { em = EDGE + ((size_t)pm * 4 + 2) * FF2; e0 = EDGE + ((size_t)pm * 4 + 3) * FF2; ep = EDGE + ((size_t)(pm + 1) * 4 + 0) * FF2; }
            const bool hm = t > 0, hp = t < T - 1;
            float res[2][8];
#pragma unroll
            for (int part = 0; part < 2; ++part) {
                const int col = gcol + 128 * part;
#pragma unroll
                for (int hh = 0; hh < 2; ++hh) {
                    const int c = col + 4 * hh; const f32x4 zero = {0.f, 0.f, 0.f, 0.f};
                    const f32x4 um = hm ? *(const f32x4*)(em + c) : zero, u0 = *(const f32x4*)(e0 + c), up = hp ? *(const f32x4*)(ep + c) : zero;
                    const f32x4 w0 = *(const f32x4*)(convp + c), w1 = *(const f32x4*)(convp + FF2 + c), w2 = *(const f32x4*)(convp + 2 * FF2 + c), cb = *(const f32x4*)(cbp + c);
                    const f32x4 r = w0 * um + w1 * u0 + w2 * up + cb;
                    res[part][4 * hh + 0] = r[0]; res[part][4 * hh + 1] = r[1]; res[part][4 * hh + 2] = r[2]; res[part][4 * hh + 3] = r[3];
                }
            }
            v4u ow; ow.x = pk2(silu_f(res[0][0]) * res[1][0], silu_f(res[0][1]) * res[1][1]); ow.y = pk2(silu_f(res[0][2]) * res[1][2], silu_f(res[0][3]) * res[1][3]);
            ow.z = pk2(silu_f(res[0][4]) * res[1][4], silu_f(res[0][5]) * res[1][5]); ow.w = pk2(silu_f(res[0][6]) * res[1][6], silu_f(res[0][7]) * res[1][7]);
            *(v4u*)(ACTg + blk_off(row - GROWS * grp, f, FF)) = ow;
        }
    }
    if (rep < PROBE_REPS(6)) xcd_barrier(barg); }
    SEAM(6);

    for (int rep = 0; rep <= PROBE_REPS(7); ++rep) { const float asc = rep ? 0.f : 1.f; (void)asc;
    if (IN(7)) {
        pg8::Gemm g{ACTg, WdT, GROWS, D, FF}; GroupOrder S; S.init(D, gk, xh, cph);
        EpiDown E{X1g, a.out, g2t, pm0};
        pg8::gemm_phase<EpiDown, GroupOrder, PG8_ALIGN, PG8_SP2>(lds + RING_OFF, g, S, E, SW_PTR(7));
    }
    if (rep < PROBE_REPS(7)) xcd_barrier(barg); }
    if (SW_PHASE >= 0 && blockIdx.x == 0 && threadIdx.x == 0) {
        const unsigned long long tgt = (unsigned long long)SW_SCALE * ((volatile LAS unsigned*)(lds + LDSCTL_OFF + 64))[SW_SEL], t0 = __builtin_amdgcn_s_memrealtime();
        while (__builtin_amdgcn_s_memrealtime() - t0 < tgt) __builtin_amdgcn_s_sleep(20);
    }
#undef IN
#undef SEAM
}

extern "C" void kernel_launch(void* const* d_in, const int* in_sizes, int n_in, void* d_out, int out_size, void* d_ws, size_t ws_size, hipStream_t stream) {
    static int grid = 0;
    if (grid == 0) {
        if (n_in != 19 || out_size != MT * D || ws_size < WS_END) { fprintf(stderr, "kernel_launch: unexpected shapes (n_in %d, out %d, ws %zu)\n", n_in, out_size, ws_size); grid = -1; return; }
        int dev = 0, cus = 0;
        if (hipGetDevice(&dev) != hipSuccess || hipDeviceGetAttribute(&cus, hipDeviceAttributeMultiprocessorCount, dev) != hipSuccess) { grid = -1; return; }
        if (hipFuncSetAttribute((const void*)fwd, hipFuncAttributeMaxDynamicSharedMemorySize, LDS_BYTES) != hipSuccess) { fprintf(stderr, "kernel_launch: hipFuncSetAttribute failed\n"); grid = -1; return; }
        int per_cu = 0;
        if (hipOccupancyMaxActiveBlocksPerMultiprocessor(&per_cu, (const void*)fwd, NWAVES * 64, LDS_BYTES) != hipSuccess || per_cu < 1) { fprintf(stderr, "kernel_launch: the occupancy query admits %d workgroups per CU; nothing launched\n", per_cu); grid = -1; return; }
        (void)hipGetLastError();
        grid = cus;
        if (grid % 8 != 0 || grid < 8) { fprintf(stderr, "kernel_launch: needs a multiple of 8 CUs (got %d)\n", grid); grid = -1; return; }
    }
    if (grid < 0) return;
    if (hipMemsetAsync((char*)d_ws + WS_CTL, 0, CTL_ZERO_BYTES, stream) != hipSuccess) return;
    Args a{};
    for (int i = 0; i < 19; ++i) a.in[i] = (const float*)d_in[i];
    a.out = (float*)d_out; a.ws = (unsigned char*)d_ws;
    a.ph_lo = 0; a.ph_hi = N_PHASES; a.row0 = 0; a.nrows = 0;
    hipLaunchKernelGGL(fwd, dim3(grid), dim3(NWAVES * 64), LDS_BYTES, stream, a);
}
```

```cpp
#include <hip/hip_runtime.h>
#include <cstdio>
#include <cstdint>

constexpr int D = 1024, MT = 32768, NPR = 16384, INW = 2048, ATTW = 512, HD = 64, NH = 8, FF = 2816, FF2 = 5632, NBATCH = 10, MODW = 6144;
constexpr float EPS = 1e-6f;

namespace pg8 {
#define PG8_LAS __attribute__((address_space(3)))
typedef unsigned short bf16_t;
typedef short bf16x8 __attribute__((ext_vector_type(8)));
typedef float f32x4 __attribute__((ext_vector_type(4)));
typedef unsigned u32x4 __attribute__((ext_vector_type(4)));
constexpr int BM = 256, BK = 64, HALF = 128, HTB = HALF * BK * 2  , STAGE_BYTES = 8 * HTB, NXCD = 8, WGM = 8;

__host__ __device__ __forceinline__ int lds_byte(int r, int c) { const int st = (r >> 4) * 2 + (c >> 5), rr = r & 15, cc = c & 31, ob = rr * 64 + cc * 2; return st * 1024 + (ob ^ (((ob >> 9) & 1) << 5)); }
__host__ __device__ __forceinline__ void stage_rc(int b, int& R, int& C) { const int st = b / 1024, sb = b % 1024, swz = sb ^ (((sb >> 9) & 1) << 5); R = (st >> 1) * 16 + swz / 64; C = (st & 1) * 32 + (swz % 64) / 2; }
__host__ __device__ __forceinline__ int perm32(int rho) { const int n = rho >> 4, i = rho & 15; return 8 * (i >> 2) + 4 * n + (i & 3); }

struct Unit { int pm, pn; };
struct Gemm { const bf16_t* A; const bf16_t* Bt; int M, N, K; };

struct StaticOrder {
    int nM, nN, nwg, G, c;
    __host__ __device__ void init(int M, int N, int G_, int c_) { nM = M / BM; nN = N / BM; nwg = nM * nN; G = G_; c = c_; }
    __host__ __device__ bool next(int i, Unit& u) const {
        const long L = (long)i * G + c; if (L >= nwg) return false;
        int wgid = (int)L; { const int q = nwg / NXCD, r = nwg % NXCD, xcd = wgid % NXCD, off = wgid / NXCD; wgid = (xcd < r ? xcd * (q + 1) : r * (q + 1) + (xcd - r) * q) + off; }
        const int nig = WGM * nN, gid = wgid / nig, fm = gid * WGM, gsz = (nM - fm) < WGM ? (nM - fm) : WGM;
        u.pm = fm + ((wgid % nig) % gsz); u.pn = (wgid % nig) / gsz; return true;
    }
    __device__ __forceinline__ void a_ready(const Unit&) const {}
    __device__ __forceinline__ void done(const Unit&) const {}
};

template <class Epi, class Sched, bool ALIGN_EPI = false, bool SP2 = false>
__device__ __forceinline__ void gemm_phase(PG8_LAS unsigned char* lds, const Gemm g, const Sched& S, const Epi& E, volatile PG8_LAS unsigned* sw = nullptr) {
    unsigned long long sw_t = 0;
    int tid_ = threadIdx.x; asm volatile("" : "+v"(tid_));
    const int tid = tid_, wid = __builtin_amdgcn_readfirstlane(tid >> 6), lane = tid & 63, wr = wid >> 2, wc = wid & 3, fr = lane & 15, fq = lane >> 4;
    const int K = g.K, nt = K / BK;
    unsigned voffA[2], voffB[2];
#pragma unroll
    for (int i = 0; i < 2; ++i) { int R, C; stage_rc(tid * 16 + i * 8192, R, C); const int Rb = Epi::PERM ? ((R & ~31) + perm32(R & 31)) : R;
        const int Ra = Epi::PERMA ? ((R & 64) + 4 * (R & 15) + ((R >> 4) & 3)) : R;
        voffA[i] = (unsigned)(Ra * BK + C) * 2u; voffB[i] = (unsigned)(Rb * BK + C) * 2u; }
    const size_t kstep = (size_t)(BM * BK * 2);
    const size_t hstep = (size_t)HALF * BK * 2;
    const size_t tstep = (size_t)K * BM * 2;
    const unsigned ldsw = (unsigned)wid * 1024u;
    const int aoff = lds_byte(wr * 64 + fr, fq * 8), boff = lds_byte(wc * 32 + fr, fq * 8);
#define PG8_SA(b, h) (((b) * 2 + (h)) * HTB)
#define PG8_SB(b, h) ((4 + (b) * 2 + (h)) * HTB)
#define PG8_STAGE(bufoff, gbase, voff) do { _Pragma("unroll") for (int _i = 0; _i < 2; ++_i) \
        __builtin_amdgcn_global_load_lds((const unsigned*)((const char*)(gbase) + (voff)[_i]), (PG8_LAS unsigned*)(lds + (bufoff) + ldsw + _i * 8192), 16, 0, 0); } while (0)
#define PG8_LDA(dst, b, h) do { _Pragma("unroll") for (int m = 0; m < 4; ++m) _Pragma("unroll") for (int k = 0; k < 2; ++k) dst[m][k] = *(const PG8_LAS bf16x8*)(lds + PG8_SA(b, h) + aoff + m * 2048 + k * 1024); } while (0)
#define PG8_LDB(dst, b, h) do { _Pragma("unroll") for (int n = 0; n < 2; ++n) _Pragma("unroll") for (int k = 0; k < 2; ++k) dst[n][k] = *(const PG8_LAS bf16x8*)(lds + PG8_SB(b, h) + boff + n * 2048 + k * 1024); } while (0)
#define PG8_MMA(ai, bj, At, Bt) do { __builtin_amdgcn_s_setprio(1); _Pragma("unroll") for (int m = 0; m < 4; ++m) _Pragma("unroll") for (int n = 0; n < 2; ++n) _Pragma("unroll") for (int k = 0; k < 2; ++k) \
        acc[ai][bj][m][n] = __builtin_amdgcn_mfma_f32_16x16x32_bf16(Bt[n][k], At[m][k], acc[ai][bj][m][n], 0, 0, 0); __builtin_amdgcn_s_setprio(0); } while (0)
#define PG8_WAIT_V(n) asm volatile("s_waitcnt vmcnt(" #n ")" ::: "memory")
#define PG8_WAIT_L(n) asm volatile("s_waitcnt lgkmcnt(" #n ")" ::: "memory")
#define PG8_BAR __builtin_amdgcn_s_barrier()
#define PG8_SCHED __builtin_amdgcn_sched_barrier(0)
    Unit cur, nxt; int ui = 0;
    if (!S.next(0, cur)) return;
    if constexpr (Epi::PREFETCH) E.prefetch(cur, 0, wid, lane);
    f32x4 acc[2][2][4][2];
#pragma unroll
    for (int a = 0; a < 2; ++a)
#pragma unroll
        for (int b = 0; b < 2; ++b)
#pragma unroll
            for (int m = 0; m < 4; ++m)
#pragma unroll
                for (int n = 0; n < 2; ++n) acc[a][b][m][n] = (f32x4){0.f, 0.f, 0.f, 0.f};
    bf16x8 At[4][2], B0[2][2], B1[2][2];
    const char* cA = (const char*)g.A + (size_t)cur.pm * tstep; const char* cB = (const char*)g.Bt + (size_t)cur.pn * tstep;
    S.a_ready(cur);
    if constexpr (SP2) {
        PG8_STAGE(PG8_SB(0, 0), cB, voffB); PG8_STAGE(PG8_SB(0, 1), cB + hstep, voffB); PG8_STAGE(PG8_SA(0, 0), cA, voffA); PG8_STAGE(PG8_SA(0, 1), cA + hstep, voffA);
        if (wr == 1) PG8_BAR;
        PG8_WAIT_V(2); PG8_BAR;
        PG8_STAGE(PG8_SB(1, 0), cB + kstep, voffB); PG8_STAGE(PG8_SA(1, 0), cA + kstep, voffA); PG8_STAGE(PG8_SB(1, 1), cB + hstep + kstep, voffB);
        PG8_WAIT_V(6); PG8_BAR;
    } else {
        PG8_STAGE(PG8_SB(0, 0), cB, voffB); PG8_STAGE(PG8_SA(0, 0), cA, voffA); PG8_STAGE(PG8_SB(0, 1), cB + hstep, voffB); PG8_STAGE(PG8_SA(0, 1), cA + hstep, voffA);
        if (wr == 1) PG8_BAR;
        PG8_WAIT_V(4); PG8_BAR;
        PG8_STAGE(PG8_SB(1, 0), cB + kstep, voffB); PG8_STAGE(PG8_SA(1, 0), cA + kstep, voffA); PG8_STAGE(PG8_SB(1, 1), cB + hstep + kstep, voffB);
        PG8_WAIT_V(6); PG8_BAR;
    }
    for (;;) {
        if (sw) { __builtin_amdgcn_sched_barrier(0); sw_t = __builtin_amdgcn_s_memrealtime(); __builtin_amdgcn_sched_barrier(0); }
        const bool has_next = S.next(ui + 1, nxt);
        const char* nA = has_next ? (const char*)g.A + (size_t)nxt.pm * tstep : cA; const char* nB = has_next ? (const char*)g.Bt + (size_t)nxt.pn * tstep : cB;
        for (int t = 0; t < nt; t += 2) {
            const bool last = (t == nt - 2);
            const char* a1 = cA + (size_t)(t + 1) * kstep;
            const char* a2 = last ? nA : cA + (size_t)(t + 2) * kstep; const char* b2 = last ? nB : cB + (size_t)(t + 2) * kstep;
            const char* a3 = a2 + kstep; const char* b3 = b2 + kstep;
            if (last && has_next) S.a_ready(nxt);
            if constexpr (SP2) {
            PG8_LDB(B0, 0, 0); PG8_LDB(B1, 0, 1); PG8_SCHED; PG8_LDA(At, 0, 0); PG8_STAGE(PG8_SA(1, 1), a1 + hstep, voffA);
            PG8_WAIT_V(8); PG8_WAIT_L(0); PG8_BAR; PG8_MMA(0, 0, At, B0); PG8_MMA(0, 1, At, B1); PG8_BAR; PG8_SCHED;
            PG8_LDA(At, 0, 1); PG8_STAGE(PG8_SB(0, 0), b2, voffB); PG8_STAGE(PG8_SB(0, 1), b2 + hstep, voffB); PG8_STAGE(PG8_SA(0, 0), a2, voffA);
            PG8_WAIT_V(8); PG8_WAIT_L(0); PG8_BAR; PG8_MMA(1, 0, At, B0); PG8_MMA(1, 1, At, B1); PG8_BAR; PG8_SCHED;
            PG8_LDB(B0, 1, 0); PG8_LDB(B1, 1, 1); PG8_SCHED; PG8_LDA(At, 1, 0); PG8_STAGE(PG8_SA(0, 1), a2 + hstep, voffA);
            PG8_WAIT_V(8); PG8_WAIT_L(0); PG8_BAR; PG8_MMA(0, 0, At, B0); PG8_MMA(0, 1, At, B1); PG8_BAR; PG8_SCHED;
            PG8_LDA(At, 1, 1); PG8_STAGE(PG8_SB(1, 0), b3, voffB); PG8_STAGE(PG8_SB(1, 1), b3 + hstep, voffB); PG8_STAGE(PG8_SA(1, 0), a3, voffA);
            PG8_WAIT_V(8); PG8_WAIT_L(0); PG8_BAR; PG8_MMA(1, 0, At, B0); PG8_MMA(1, 1, At, B1); PG8_BAR; PG8_SCHED;
            } else {
            PG8_LDB(B0, 0, 0); PG8_SCHED; PG8_LDA(At, 0, 0); PG8_STAGE(PG8_SA(1, 1), a1 + hstep, voffA);
            PG8_WAIT_L(8); PG8_BAR; PG8_WAIT_L(0); PG8_MMA(0, 0, At, B0); PG8_BAR; PG8_SCHED;
            PG8_LDB(B1, 0, 1); PG8_STAGE(PG8_SB(0, 0), b2, voffB);
            PG8_BAR; PG8_WAIT_L(0); PG8_MMA(0, 1, At, B1); PG8_BAR;
            PG8_LDA(At, 0, 1); PG8_STAGE(PG8_SA(0, 0), a2, voffA);
            PG8_BAR; PG8_WAIT_L(0); PG8_MMA(1, 0, At, B0); PG8_BAR; PG8_SCHED;
            PG8_STAGE(PG8_SB(0, 1), b2 + hstep, voffB);
            PG8_WAIT_V(6); PG8_BAR; PG8_MMA(1, 1, At, B1); PG8_BAR;
            PG8_LDB(B0, 1, 0); PG8_SCHED; PG8_LDA(At, 1, 0); PG8_STAGE(PG8_SA(0, 1), a2 + hstep, voffA);
            PG8_WAIT_L(8); PG8_BAR; PG8_WAIT_L(0); PG8_MMA(0, 0, At, B0); PG8_BAR; PG8_SCHED;
            PG8_LDB(B1, 1, 1); PG8_STAGE(PG8_SB(1, 0), b3, voffB);
            PG8_BAR; PG8_WAIT_L(0); PG8_MMA(0, 1, At, B1); PG8_BAR;
            PG8_LDA(At, 1, 1); PG8_STAGE(PG8_SA(1, 0), a3, voffA);
            PG8_BAR; PG8_WAIT_L(0); PG8_MMA(1, 0, At, B0); PG8_BAR; PG8_SCHED;
            PG8_STAGE(PG8_SB(1, 1), b3 + hstep, voffB);
            PG8_WAIT_V(6); PG8_BAR; PG8_MMA(1, 1, At, B1); PG8_BAR;
            }
        }
        if constexpr (ALIGN_EPI) { if (wr == 0) PG8_BAR; }
        if (sw) { __builtin_amdgcn_sched_barrier(0); const unsigned long long t1 = __builtin_amdgcn_s_memrealtime(); if (threadIdx.x == 0) sw[0] += (unsigned)(t1 - sw_t); sw_t = t1; __builtin_amdgcn_sched_barrier(0); }
        if constexpr (Epi::PREFETCH) { E.run(acc, cur, wr, wc, fr, fq, ui & 1); if (has_next) E.prefetch(nxt, (ui + 1) & 1, wid, lane); S.done(cur); }
        else if constexpr (!Epi::AFTER_DRAIN) { E(acc, cur, wr, wc, fr, fq); S.done(cur); }
        if (sw) { __builtin_amdgcn_sched_barrier(0); const unsigned long long t1 = __builtin_amdgcn_s_memrealtime(); if (threadIdx.x == 0) sw[1] += (unsigned)(t1 - sw_t); __builtin_amdgcn_sched_barrier(0); }
        if (!has_next) break;
#pragma unroll
        for (int a = 0; a < 2; ++a)
#pragma unroll
            for (int b = 0; b < 2; ++b)
#pragma unroll
                for (int m = 0; m < 4; ++m)
#pragma unroll
                    for (int n = 0; n < 2; ++n) acc[a][b][m][n] = (f32x4){0.f, 0.f, 0.f, 0.f};
        cur = nxt; cA = nA; cB = nB; ++ui;
        if constexpr (ALIGN_EPI) { if (wr == 1) PG8_BAR; }
    }
    PG8_WAIT_V(0);
    if constexpr (!ALIGN_EPI) { if (wr == 0) PG8_BAR; }
    PG8_BAR;
    if constexpr (Epi::AFTER_DRAIN) { E.fused(acc, cur, wr, wc, fr, fq, lds, wid, lane); S.done(cur); }
#undef PG8_SA
#undef PG8_SB
#undef PG8_STAGE
#undef PG8_LDA
#undef PG8_LDB
#undef PG8_MMA
#undef PG8_WAIT_V
#undef PG8_WAIT_L
#undef PG8_BAR
#undef PG8_SCHED
}
}
#ifndef PG8_SP2
#define PG8_SP2 true
#endif
#ifndef PG8_ALIGN
#define PG8_ALIGN true
#endif
constexpr size_t MiB = 1u << 20;
constexpr size_t WS_CTL = 0, CTL_ZERO_BYTES = 3 * MiB;
constexpr size_t OFF_MOD = 131072, OFF_C2 = 393216, OFF_RSS2 = 622592, OFF_HSS = 1 * MiB;
constexpr size_t WS_WIN = 3 * MiB, WS_WOUT = 7 * MiB, WS_WUP = 9 * MiB, WS_WDN = 20 * MiB, WS_SMALL = 26 * MiB, WS_EDGE = 27 * MiB, WS_SLICE0 = 40 * MiB, WS_SLICE = 112 * MiB;
constexpr size_t SL_H1 = 0, SL_PROJ = 16 * MiB, SL_CAT = 48 * MiB, SL_XG2 = 64 * MiB, SL_X1 = 80 * MiB, SL_ACT = 0;
constexpr size_t WS_END = 512 * MiB;
constexpr int NGROUPS = 4, GROWS = MT / NGROUPS, GPANELS = GROWS / 256;
constexpr int CW_BAR = 4096, CW_GBAR = 8192;
constexpr int RING_OFF = 0, RING_BYTES = 131072;
constexpr int XCH_OFF = 131072;
constexpr int KRING_OFF = 0, VRING_OFF = 73728;
constexpr int BIAS_OFF = 147456, RK_OFF = 149504;
constexpr int LDSCTL_OFF = 155648, MISC_OFF = LDSCTL_OFF + 320, LDS_BYTES = 163840;
constexpr int NWAVES = 8;

#define GAS __attribute__((address_space(1)))
#define LAS __attribute__((address_space(3)))
typedef unsigned short bf16;
typedef unsigned v4u __attribute__((ext_vector_type(4)));
typedef unsigned v2u __attribute__((ext_vector_type(2)));
using pg8::f32x4;
#define LDS_WAIT() asm volatile("s_waitcnt lgkmcnt(0)" ::: "memory")
#define VM_WAIT() asm volatile("s_waitcnt vmcnt(0)" ::: "memory")
__device__ __forceinline__ unsigned f2bf(float f) { unsigned u = __builtin_bit_cast(unsigned, f); return (u + 0x7fffu + ((u >> 16) & 1u)) >> 16; }
__device__ __forceinline__ unsigned pk2(float lo, float hi) { return f2bf(lo) | (f2bf(hi) << 16); }
__device__ __forceinline__ float bflo(unsigned w) { return __builtin_bit_cast(float, w << 16); }
__device__ __forceinline__ float bfhi(unsigned w) { return __builtin_bit_cast(float, w & 0xffff0000u); }
typedef float f32x2_t __attribute__((ext_vector_type(2))); typedef __bf16 bf16x2_t __attribute__((ext_vector_type(2))); typedef _Float16 f16x2_t __attribute__((ext_vector_type(2)));
__device__ __forceinline__ unsigned cvt_pk_h(float lo, float hi) { f32x2_t v = {lo, hi}; f16x2_t h = __builtin_convertvector(v, f16x2_t); return __builtin_bit_cast(unsigned, h); }
__device__ __forceinline__ f32x2_t h2f(unsigned w) { return __builtin_convertvector(__builtin_bit_cast(f16x2_t, w), f32x2_t); }
__device__ __forceinline__ unsigned cvt_pk(float lo, float hi) { f32x2_t v = {lo, hi}; bf16x2_t b = __builtin_convertvector(v, bf16x2_t); return __builtin_bit_cast(unsigned, b); }
__device__ __forceinline__ size_t blk_off(int row, int col, int K) { return ((size_t)((row >> 8) * (K >> 6) + (col >> 6)) << 14) + (size_t)(((row & 255) << 6) + (col & 63)); }
__device__ __forceinline__ int batch_of_row(int row) { return row < NPR ? (row >> 11) : 8 + ((row - NPR) >> 13); }
__device__ __forceinline__ int batch_of_tile(int pm) { return pm < 64 ? (pm >> 3) : 8 + ((pm - 64) >> 5); }
__device__ __forceinline__ int permcol(int n) { const int f = n < FF ? n : n - FF; return (f >> 7) * 256 + (f & 127) + (n < FF ? 0 : 128); }
__device__ __forceinline__ float wave_sum(float v) {
#pragma unroll
    for (int o = 1; o < 64; o <<= 1) v += __shfl_xor(v, o);
    return v;
}
__device__ __forceinline__ float silu_f(float x) { return x / (1.0f + __expf(-x)); }

#define XB_TMO      128
#define XB_XCNT(j)  (256  + 64 * (j))
#define XB_XSUB(j)  (1280 + 64 * (j))
#define XB_XGEN(j)  (2304 + 64 * (j))
#define XB_TOP      3328
#define XB_TOPGEN   3392
#define XCD_BAR_WORDS 3456
#define XB_SPIN_CAP (1u << 18)

__device__ __forceinline__ unsigned xb_ld(unsigned* p)              { return __hip_atomic_load(p, __ATOMIC_RELAXED, __HIP_MEMORY_SCOPE_AGENT); }
__device__ __forceinline__ unsigned xb_add(unsigned* p, unsigned v) { return __hip_atomic_fetch_add(p, v, __ATOMIC_RELAXED, __HIP_MEMORY_SCOPE_AGENT); }
__device__ __forceinline__ unsigned xb_xcc_id() { return (unsigned)__builtin_amdgcn_s_getreg((3 << 11) | 20) & 0xFu; }
#define XB_SPIN(cond, bar) do { unsigned _sp = 0; while (cond) { __builtin_amdgcn_s_sleep(1); \
    if ((++_sp & 255u) == 0u) { if (xb_ld(&(bar)[XB_TMO])) break; if (_sp > XB_SPIN_CAP) { atomicAdd(&(bar)[XB_TMO], 1u); break; } } } } while (0)

struct XcdBarrier {
    unsigned* bar; unsigned x; unsigned gsize;
    volatile LAS unsigned* st;
};

__device__ __forceinline__ XcdBarrier xcd_barrier_post(unsigned* bar, volatile LAS unsigned* st, unsigned gsize) {
    XcdBarrier b; b.bar = bar; b.x = xb_xcc_id(); b.st = st; b.gsize = gsize;
    if (threadIdx.x == 0) (void)xb_add(&bar[XB_XCNT(b.x)], 1u);
    return b;
}
__device__ __forceinline__ void xcd_barrier_complete(unsigned* bar, unsigned x, unsigned G, unsigned& nloc, unsigned& nx) {
    unsigned sum, cnt, mine, sp = 0u;
    for (;;) {
        sum = 0u; cnt = 0u; mine = 0u;
#pragma unroll
        for (unsigned j = 0; j < 16; ++j) { const unsigned c = xb_ld(&bar[XB_XCNT(j)]); sum += c; cnt += (c > 0u) ? 1u : 0u; mine = (j == x) ? c : mine; }
        if (sum == G) break;
        __builtin_amdgcn_s_sleep(1);
        if ((++sp & 255u) == 0u) { if (xb_ld(&bar[XB_TMO])) break; if (sp > XB_SPIN_CAP) { atomicAdd(&bar[XB_TMO], 1u); break; } }
    }
    nloc = mine > 0u ? mine : 1u; nx = cnt > 0u ? cnt : 1u;
}

__device__ __forceinline__ void xcd_barrier(const XcdBarrier& b) {
    asm volatile("s_waitcnt vmcnt(0)" ::: "memory");
    __syncthreads();
    if (threadIdx.x == 0) {
        unsigned* bar = b.bar;
        __builtin_amdgcn_s_waitcnt(0);
        unsigned nloc = b.st[0], nx = b.st[1];
        if (nloc == 0u) { xcd_barrier_complete(bar, b.x, b.gsize, nloc, nx); b.st[0] = nloc; b.st[1] = nx; }
        const unsigned old = xb_add(&bar[XB_XSUB(b.x)], 1u);
        const unsigned gen = old / nloc;
        if (old + 1u == (gen + 1u) * nloc) {
            __builtin_amdgcn_fence(__ATOMIC_RELEASE, "agent");
            asm volatile("s_waitcnt vmcnt(0)" ::: "memory");
            const unsigned og = xb_add(&bar[XB_TOP], 1u);
            const unsigned tg = og / nx;
            if (og + 1u == (tg + 1u) * nx) xb_add(&bar[XB_TOPGEN], 1u);
            else XB_SPIN(xb_ld(&bar[XB_TOPGEN]) == tg, bar);
            __builtin_amdgcn_fence(__ATOMIC_ACQUIRE, "agent");
            xb_add(&bar[XB_XGEN(b.x)], 1u);
            asm volatile("s_waitcnt vmcnt(0)" ::: "memory");
        } else {
            XB_SPIN(xb_ld(&bar[XB_XGEN(b.x)]) == gen, bar);
            __builtin_amdgcn_fence(__ATOMIC_ACQUIRE, "agent");
            asm volatile("s_waitcnt vmcnt(0)" ::: "memory");
        }
    }
    __syncthreads();
}

struct GroupOrder {
    int nN, k, xh, cph, nunits;
    __device__ void init(int N, int k_, int xh_, int cph_) { nN = N / 256; k = k_; xh = xh_; cph = cph_; nunits = 16 * nN; }
    __device__ bool next(int i, pg8::Unit& u) const { const int L = i * cph + k; if (L >= nunits) return false; const int nig = 8 * nN, gid = L / nig, w = L % nig; u.pm = 16 * xh + 8 * gid + (w & 7); u.pn = w >> 3; return true; }
    __device__ __forceinline__ void a_ready(const pg8::Unit&) const {}
    __device__ __forceinline__ void done(const pg8::Unit&) const {}
};

struct OneUnit {
    pg8::Unit u;
    __device__ bool next(int i, pg8::Unit& o) const { if (i != 0) return false; o = u; return true; }
    __device__ __forceinline__ void a_ready(const pg8::Unit&) const {}
    __device__ __forceinline__ void done(const pg8::Unit&) const {}
};
typedef const f32x4 (&AccRef)[2][2][4][2];
__device__ __forceinline__ float modv(const float* macc, const float* b_ada, int b, int j) { return macc[b * MODW + j] + b_ada[j]; }
__device__ __forceinline__ f32x4 modv4(const float* macc, const float* b_ada, int b, int j) { return *(const f32x4*)(macc + b * MODW + j) + *(const f32x4*)(b_ada + j); }

struct EpiProj {
    static constexpr bool PERM = true, PERMA = false, AFTER_DRAIN = false, PREFETCH = false;
    bf16* O; float* hss; float asc; int pm0;
    __device__ __forceinline__ void operator()(AccRef acc, const pg8::Unit& u, int wr, int wc, int fr, int fq) const {
        const int row0 = u.pm * 256 + wr * 64 + fr, col0 = u.pn * 256 + wc * 32 + 8 * fq;
#pragma unroll
        for (int ai = 0; ai < 2; ++ai)
#pragma unroll
            for (int m = 0; m < 4; ++m) { bf16* rowp = O + (size_t)(row0 + ai * 128 + m * 16) * INW + col0;
#pragma unroll
                for (int bj = 0; bj < 2; ++bj) { const f32x4 v0 = acc[ai][bj][m][0], v1 = acc[ai][bj][m][1];
                    v4u w; w.x = cvt_pk(v0[0], v0[1]); w.y = cvt_pk(v0[2], v0[3]); w.z = cvt_pk(v1[0], v1[1]); w.w = cvt_pk(v1[2], v1[3]);
                    *(v4u*)(rowp + bj * 128) = w; } }
        if (u.pn < 4) {
#pragma unroll
            for (int ai = 0; ai < 2; ++ai)
#pragma unroll
                for (int m = 0; m < 4; ++m)
#pragma unroll
                    for (int bj = 0; bj < 2; ++bj) { const f32x4 v0 = acc[ai][bj][m][0], v1 = acc[ai][bj][m][1];
                        float s = ((v0[0] * v0[0] + v0[1] * v0[1]) + (v0[2] * v0[2] + v0[3] * v0[3])) + ((v1[0] * v1[0] + v1[1] * v1[1]) + (v1[2] * v1[2] + v1[3] * v1[3]));
                        s += __shfl_xor(s, 16); s += __shfl_xor(s, 32);
                        if (fq == 0) atomicAdd(hss + (size_t)(4 * u.pn + 2 * bj + (wc >> 1)) * MT + pm0 * 256 + row0 + ai * 128 + m * 16, s * asc); }
        }
    }
};
struct EpiOut {
    static constexpr bool PERM = true, PERMA = false, AFTER_DRAIN = true, PREFETCH = false;
    const float* xp; const float* xs; unsigned short* x1; bf16* xg2; float* rss2; const float* g1t; const float* G2t; float asc; int pm0;
    __device__ __forceinline__ void fused(AccRef acc, const pg8::Unit& u, int wr, int wc, int fr_, int fq_, LAS unsigned char* lds, int wid, int lane_) const {
        int fr = fr_, fq = fq_, lane = lane_; asm volatile("" : "+v"(fr), "+v"(fq), "+v"(lane));
        const int gpm = pm0 + u.pm, b = batch_of_tile(gpm), grow0 = gpm * 256 + wr * 64 + fr, cl = wc * 32 + 8 * fq;
        const char* xb = (const char*)(gpm * 256 < NPR ? xp + (size_t)gpm * 256 * D : xs + ((size_t)gpm * 256 - NPR) * D) + (size_t)u.pn * 1024;
        char* x1b = (char*)(x1 + (size_t)u.pm * 256 * D) + (size_t)u.pn * 512;
        char* xgb = (char*)(xg2 + ((size_t)(u.pm * 16 + u.pn * 4 + (wc >> 1)) << 14));
        const unsigned loff = (unsigned)(((wr * 64 + fr) * D + cl) * 4), xgl = (unsigned)(((wr * 64 + fr) * 64 + (wc & 1) * 32 + 8 * fq) * 2);
        LAS unsigned char* slot = lds + wid * 16384;
        float ss[2][4];
#pragma unroll
        for (int ai = 0; ai < 2; ++ai)
#pragma unroll
            for (int m = 0; m < 4; ++m) ss[ai][m] = 0.f;
        f32x4 g1a[2][2], G2a[2][2];
#pragma unroll
        for (int bj = 0; bj < 2; ++bj)
#pragma unroll
            for (int n = 0; n < 2; ++n) { const int c_ = u.pn * 256 + bj * 128 + cl + 4 * n; g1a[bj][n] = *(const f32x4*)(g1t + b * D + c_); G2a[bj][n] = *(const f32x4*)(G2t + b * D + c_); }
        asm volatile("" ::: "memory");
#define EO_DMA(c) do { _Pragma("unroll") for (int m = 0; m < 4; ++m) _Pragma("unroll") for (int n = 0; n < 2; ++n) \
            __builtin_amdgcn_global_load_lds((const unsigned*)(xb + (size_t)((((c) & 1) * 128 + m * 16) * D + ((c) >> 1) * 128) * 4 + 16 * n + loff), (LAS unsigned*)(slot + ((c) & 1) * 8192 + (m * 2 + n) * 1024), 16, 0, 0); } while (0)
        EO_DMA(0); EO_DMA(1);
#pragma unroll
        for (int c = 0; c < 4; ++c) {
            const int bj = c >> 1, ai = c & 1;
            if (c == 0) asm volatile("s_waitcnt vmcnt(8)" ::: "memory"); else if (c == 1) asm volatile("s_waitcnt vmcnt(16)" ::: "memory"); else if (c == 2) asm volatile("s_waitcnt vmcnt(24)" ::: "memory"); else asm volatile("s_waitcnt vmcnt(16)" ::: "memory");
            f32x4 xv[4][2];
#pragma unroll
            for (int m = 0; m < 4; ++m)
#pragma unroll
                for (int n = 0; n < 2; ++n) xv[m][n] = *(const LAS f32x4*)(slot + (c & 1) * 8192 + (m * 2 + n) * 1024 + lane * 16);
            asm volatile("s_waitcnt lgkmcnt(0)" ::: "memory");
            if (c + 2 < 4) EO_DMA(c + 2);
            asm volatile("" ::: "memory");
#pragma unroll
            for (int m = 0; m < 4; ++m) {
                const f32x4 v0 = xv[m][0] + g1a[bj][0] * acc[ai][bj][m][0], v1 = xv[m][1] + g1a[bj][1] * acc[ai][bj][m][1];
                { v4u xw; xw.x = cvt_pk_h(v0[0], v0[1]); xw.y = cvt_pk_h(v0[2], v0[3]); xw.z = cvt_pk_h(v1[0], v1[1]); xw.w = cvt_pk_h(v1[2], v1[3]);
                  *(v4u*)(x1b + (size_t)((ai * 128 + m * 16) * D + bj * 128) * 2 + (loff >> 1)) = xw; }
                ss[ai][m] += ((v0[0] * v0[0] + v0[1] * v0[1]) + (v0[2] * v0[2] + v0[3] * v0[3])) + ((v1[0] * v1[0] + v1[1] * v1[1]) + (v1[2] * v1[2] + v1[3] * v1[3]));
                const f32x4 h0 = v0 * G2a[bj][0], h1 = v1 * G2a[bj][1]; v4u w; w.x = cvt_pk(h0[0], h0[1]); w.y = cvt_pk(h0[2], h0[3]); w.z = cvt_pk(h1[0], h1[1]); w.w = cvt_pk(h1[2], h1[3]);
                *(v4u*)(xgb + (size_t)((2 * bj) << 15) + (size_t)((ai * 128 + m * 16) * 128) + xgl) = w;
            }
            asm volatile("" ::: "memory");
        }
#undef EO_DMA
#pragma unroll
        for (int ai = 0; ai < 2; ++ai)
#pragma unroll
            for (int m = 0; m < 4; ++m) { float s = ss[ai][m]; s += __shfl_xor(s, 16); s += __shfl_xor(s, 32);
                if (fq == 0) atomicAdd(rss2 + grow0 + ai * 128 + m * 16, s * asc); }
    }
};
__device__ __forceinline__ float dpp_shr1(float old, float src) { return __builtin_bit_cast(float, __builtin_amdgcn_update_dpp(__builtin_bit_cast(int, old), __builtin_bit_cast(int, src), 0x111, 0xf, 0xf, false)); }
__device__ __forceinline__ float dpp_shl1(float old, float src) { return __builtin_bit_cast(float, __builtin_amdgcn_update_dpp(__builtin_bit_cast(int, old), __builtin_bit_cast(int, src), 0x101, 0xf, 0xf, false)); }
struct EpiConvAct {
    static constexpr bool PERM = true, PERMA = true, AFTER_DRAIN = false, PREFETCH = true;
    bf16* act; float* edge; const float* rss2; const float* c2; const float* convp; const float* cbp; LAS float* X; int pm0;
    __device__ __forceinline__ void prefetch(const pg8::Unit& u, int buf, int wid, int lane) const {
        if (wid < 6) {
            const int gpm = pm0 + u.pm, b = batch_of_tile(gpm);
            const float* src = wid == 0 ? rss2 + gpm * 256 : wid == 1 ? c2 + b * FF2 + u.pn * 256 : wid < 5 ? convp + (wid - 2) * FF2 + u.pn * 256 : cbp + u.pn * 256;
            __builtin_amdgcn_global_load_lds((const unsigned*)(src + 4 * lane), (LAS unsigned*)(X + 2048 + buf * 1536 + wid * 256), 16, 0, 0);
        }
    }
    __device__ __forceinline__ void run(f32x4 (&acc)[2][2][4][2], const pg8::Unit& u, int wr, int wc, int fr_, int fq_, int buf) const {
        int fr = fr_, fq = fq_; asm volatile("" : "+v"(fr), "+v"(fq));
        const int gpm = pm0 + u.pm, colL = wc * 32 + 8 * fq, colg = u.pn * 256 + colL;
        const LAS float* T = X + 2048 + buf * 1536; const LAS float* TB = T + 512;
        {   f32x4 rs[2];
#pragma unroll
            for (int ai = 0; ai < 2; ++ai) { const f32x4 q = *(const LAS f32x4*)(T + 128 * ai + 64 * wr + 4 * fr);
                rs[ai][0] = rsqrtf(q[0] * (1.0f / D) + EPS); rs[ai][1] = rsqrtf(q[1] * (1.0f / D) + EPS); rs[ai][2] = rsqrtf(q[2] * (1.0f / D) + EPS); rs[ai][3] = rsqrtf(q[3] * (1.0f / D) + EPS); }
#pragma unroll
            for (int bj = 0; bj < 2; ++bj)
#pragma unroll
                for (int n = 0; n < 2; ++n) { const f32x4 c2v = *(const LAS f32x4*)(T + 256 + 128 * bj + colL + 4 * n);
#pragma unroll
                    for (int ai = 0; ai < 2; ++ai)
#pragma unroll
                        for (int m = 0; m < 4; ++m) acc[ai][bj][m][n] = acc[ai][bj][m][n] * rs[ai][m] + c2v; } }
#pragma unroll
        for (int bj = 0; bj < 2; ++bj)
#pragma unroll
            for (int n = 0; n < 2; ++n)
#pragma unroll
                for (int ai = 0; ai < 2; ++ai) { const int rb = 2 * ai + wr;
                    if (fr == 0)  *(LAS f32x4*)(X + (rb * 2 + 0) * 256 + 128 * bj + colL + 4 * n) = acc[ai][bj][0][n];
                    if (fr == 15) *(LAS f32x4*)(X + (rb * 2 + 1) * 256 + 128 * bj + colL + 4 * n) = acc[ai][bj][3][n]; }
        asm volatile("s_waitcnt lgkmcnt(0)" ::: "memory"); __builtin_amdgcn_s_barrier(); asm volatile("" ::: "memory");
        if (wr == 0 && fr == 0) {
#pragma unroll
            for (int bj = 0; bj < 2; ++bj)
#pragma unroll
                for (int n = 0; n < 2; ++n) { float* ep = edge + ((size_t)gpm * 4 + 0) * FF2 + colg + 128 * bj + 4 * n; *(f32x4*)ep = acc[0][bj][0][n]; *(f32x4*)(ep + FF2) = acc[0][bj][1][n]; }
        }
        if (wr == 1 && fr == 15) {
#pragma unroll
            for (int bj = 0; bj < 2; ++bj)
#pragma unroll
                for (int n = 0; n < 2; ++n) { float* ep = edge + ((size_t)gpm * 4 + 2) * FF2 + colg + 128 * bj + 4 * n; *(f32x4*)ep = acc[1][bj][2][n]; *(f32x4*)(ep + FF2) = acc[1][bj][3][n]; }
        }
        typedef float f32x2 __attribute__((ext_vector_type(2)));
#pragma unroll
        for (int ai = 0; ai < 2; ++ai) { const int rb = 2 * ai + wr;
            unsigned pk[4][2][2];
#pragma unroll
            for (int n = 0; n < 2; ++n) {
#pragma unroll
                for (int eh = 0; eh < 2; ++eh) {
                    f32x2 sg[4];
#pragma unroll
                    for (int bj = 0; bj < 2; ++bj) { const int col = colg + 128 * bj + 4 * n + 2 * eh;
                        const int tcol = 128 * bj + colL + 4 * n + 2 * eh;
                        const f32x2 w0 = *(const LAS f32x2*)(TB + tcol), w1 = *(const LAS f32x2*)(TB + 256 + tcol), w2 = *(const LAS f32x2*)(TB + 512 + tcol), cb = *(const LAS f32x2*)(TB + 768 + tcol);
                        const int ia = rb > 0 ? (rb - 1) * 2 + 1 : 0, ib = rb < 3 ? (rb + 1) * 2 : 7;
                        const f32x2 above = *(const LAS f32x2*)(X + ia * 256 + 128 * bj + colL + 4 * n + 2 * eh);
                        const f32x2 below = *(const LAS f32x2*)(X + ib * 256 + 128 * bj + colL + 4 * n + 2 * eh);
                        f32x2 U0, U1, U2, U3;
                        U0[0] = acc[ai][bj][0][n][2 * eh]; U0[1] = acc[ai][bj][0][n][2 * eh + 1]; U1[0] = acc[ai][bj][1][n][2 * eh]; U1[1] = acc[ai][bj][1][n][2 * eh + 1];
                        U2[0] = acc[ai][bj][2][n][2 * eh]; U2[1] = acc[ai][bj][2][n][2 * eh + 1]; U3[0] = acc[ai][bj][3][n][2 * eh]; U3[1] = acc[ai][bj][3][n][2 * eh + 1];
                        f32x2 up0, dn3;
                        up0[0] = dpp_shr1(above[0], U3[0]); up0[1] = dpp_shr1(above[1], U3[1]); dn3[0] = dpp_shl1(below[0], U0[0]); dn3[1] = dpp_shl1(below[1], U0[1]);
                        f32x2 cv[4];
                        cv[0] = w0 * up0 + w1 * U0 + w2 * U1 + cb;
                        cv[1] = w0 * U0 + w1 * U1 + w2 * U2 + cb;
                        cv[2] = w0 * U1 + w1 * U2 + w2 * U3 + cb;
                        cv[3] = w0 * U2 + w1 * U3 + w2 * dn3 + cb;
                        if (bj == 0) {
#pragma unroll
                            for (int m = 0; m < 4; ++m)
#pragma unroll
                                for (int e = 0; e < 2; ++e) { const float g = cv[m][e]; sg[m][e] = g * __builtin_amdgcn_rcpf(1.0f + __builtin_amdgcn_exp2f(g * -1.4426950408889634f)); }
                        } else {
#pragma unroll
                            for (int m = 0; m < 4; ++m) { const f32x2 av = sg[m] * cv[m]; pk[m][n][eh] = cvt_pk(av[0], av[1]); }
                        }
                    }
                }
            }
#pragma unroll
            for (int m = 0; m < 4; ++m) { const int tr = 128 * ai + 64 * wr + 4 * fr + m; v4u w; w.x = pk[m][0][0]; w.y = pk[m][0][1]; w.z = pk[m][1][0]; w.w = pk[m][1][1];
                *(v4u*)(act + blk_off(u.pm * 256 + tr, u.pn * 128 + colL, FF)) = w; }
        }
    }
};
struct EpiDown {
    static constexpr bool PERM = true, PERMA = false, AFTER_DRAIN = false, PREFETCH = false;
    const unsigned short* x1; float* out; const float* g2t; int pm0;
    __device__ __forceinline__ void operator()(AccRef acc, const pg8::Unit& u, int wr, int wc, int fr_, int fq_) const {
        int fr = fr_, fq = fq_; asm volatile("" : "+v"(fr), "+v"(fq));
        const int gpm = pm0 + u.pm, b = batch_of_tile(gpm), cl = wc * 32 + 8 * fq;
        const char* xb = (const char*)(x1 + (size_t)u.pm * 256 * D) + (size_t)u.pn * 512;
        char* ob = (char*)(out + (size_t)gpm * 256 * D) + (size_t)u.pn * 1024;
        const unsigned loff = (unsigned)(((wr * 64 + fr) * D + cl) * 4);
        v4u xv[2][2][4];
#pragma unroll
        for (int bj = 0; bj < 2; ++bj)
#pragma unroll
            for (int ai = 0; ai < 2; ++ai)
#pragma unroll
                for (int m = 0; m < 4; ++m) xv[bj][ai][m] = *(const v4u*)(xb + (size_t)((ai * 128 + m * 16) * D + bj * 128) * 2 + (loff >> 1));
        f32x4 g2a[2][2];
#pragma unroll
        for (int bj = 0; bj < 2; ++bj)
#pragma unroll
            for (int n = 0; n < 2; ++n) g2a[bj][n] = *(const f32x4*)(g2t + b * D + u.pn * 256 + bj * 128 + cl + 4 * n);
        asm volatile("" ::: "memory");
#pragma unroll
        for (int bj = 0; bj < 2; ++bj) {
            const f32x4 g2[2] = {g2a[bj][0], g2a[bj][1]};
#pragma unroll
            for (int ai = 0; ai < 2; ++ai)
#pragma unroll
                for (int m = 0; m < 4; ++m) { char* orow = ob + (size_t)((ai * 128 + m * 16) * D + bj * 128) * 4; const v4u w = xv[bj][ai][m];
                    const f32x2_t a0 = h2f(w.x), a1 = h2f(w.y), a2 = h2f(w.z), a3 = h2f(w.w);
                    const f32x4 x0 = {a0[0], a0[1], a1[0], a1[1]}, x1v = {a2[0], a2[1], a3[0], a3[1]};
                    *(f32x4*)(orow + loff) = x0 + g2[0] * acc[ai][bj][m][0]; *(f32x4*)(orow + 16 + loff) = x1v + g2[1] * acc[ai][bj][m][1]; }
        }
    }
};

__device__ __forceinline__ void transpose_item(const float* W, int ldw, int k0, int n0, bf16* WT, int ldt, int drow0, int kd0, LAS float* scr, int lane) {
#pragma unroll 8
    for (int i = 0; i < 32; ++i) { const int kk = 2 * i + (lane >> 5); scr[kk * 33 + (lane & 31)] = W[(size_t)(k0 + kk) * ldw + n0 + (lane & 31)]; }
    LDS_WAIT(); asm volatile("" ::: "memory");
    const int c = lane & 7;
#pragma unroll
    for (int j = 0; j < 4; ++j) { const int n = (lane >> 3) + 8 * j; const LAS float* s = scr + (8 * c) * 33 + n;
        v4u o; o.x = pk2(s[0 * 33], s[1 * 33]); o.y = pk2(s[2 * 33], s[3 * 33]); o.z = pk2(s[4 * 33], s[5 * 33]); o.w = pk2(s[6 * 33], s[7 * 33]);
        *(v4u*)(WT + blk_off(drow0 + n, kd0 + 8 * c, ldt)) = o; }
    LDS_WAIT(); asm volatile("" ::: "memory");
}
template <class Fill> __device__ __forceinline__ void gemv10_item(const float* W, int ldw, int k0, int n, LAS float* sb, float* dst, int dstride, int dcol, float asc, const Fill& fill) {
    float w[64];
#pragma unroll
    for (int kk = 0; kk < 64; ++kk) w[kk] = W[(size_t)(k0 + kk) * ldw + n];
    fill(sb);
    LDS_WAIT(); asm volatile("" ::: "memory");
    float acc[NBATCH];
#pragma unroll
    for (int b = 0; b < NBATCH; ++b) acc[b] = 0.f;
#pragma unroll
    for (int kk = 0; kk < 64; ++kk) {
        const f32x4 s0 = *(const LAS f32x4*)(sb + kk * 12), s1 = *(const LAS f32x4*)(sb + kk * 12 + 4), s2 = *(const LAS f32x4*)(sb + kk * 12 + 8);
        acc[0] += w[kk] * s0[0]; acc[1] += w[kk] * s0[1]; acc[2] += w[kk] * s0[2]; acc[3] += w[kk] * s0[3];
        acc[4] += w[kk] * s1[0]; acc[5] += w[kk] * s1[1]; acc[6] += w[kk] * s1[2]; acc[7] += w[kk] * s1[3];
        acc[8] += w[kk] * s2[0]; acc[9] += w[kk] * s2[1];
    }
#pragma unroll
    for (int b = 0; b < NBATCH; ++b) atomicAdd(dst + (size_t)b * dstride + dcol, acc[b] * asc);
    LDS_WAIT(); asm volatile("" ::: "memory");
}

template <int HW> __device__ __forceinline__ void pool_group(const bf16* PROJ, bf16* CAT, int pbase, int T, int t0, int ch) {
    constexpr int NL = 2 * HW + 3;
    v4u x[NL];
#pragma unroll
    for (int i = 0; i < NL; ++i) { const int s = t0 - HW + i; const v4u z = {0u, 0u, 0u, 0u}; x[i] = (s >= 0 && s < T) ? *(const v4u*)(PROJ + (size_t)(pbase + s) * INW + 3 * ATTW + 8 * ch) : z; }
    float S[8];
#pragma unroll
    for (int c = 0; c < 8; ++c) S[c] = 0.f;
#define POOL_ADD(sgn, VV) do { S[0] += sgn bflo((VV).x); S[1] += sgn bfhi((VV).x); S[2] += sgn bflo((VV).y); S[3] += sgn bfhi((VV).y); S[4] += sgn bflo((VV).z); S[5] += sgn bfhi((VV).z); S[6] += sgn bflo((VV).w); S[7] += sgn bfhi((VV).w); } while (0)
#pragma unroll
    for (int i = 0; i < 2 * HW; ++i) POOL_ADD(+, x[i]);
#pragma unroll
    for (int k = 0; k < 4; ++k) {
        if (k > 0) { POOL_ADD(-, x[k - 1]); POOL_ADD(+, x[k - 1 + 2 * HW]); }
        const int t = t0 + k; const float ic = 1.0f / (float)(min(t + HW, T) - max(t - HW, 0)); const v4u w = x[HW + k];
        v4u ow; ow.x = pk2(S[0] * ic - bflo(w.x), S[1] * ic - bfhi(w.x)); ow.y = pk2(S[2] * ic - bflo(w.y), S[3] * ic - bfhi(w.y));
        ow.z = pk2(S[4] * ic - bflo(w.z), S[5] * ic - bfhi(w.z)); ow.w = pk2(S[6] * ic - bflo(w.w), S[7] * ic - bfhi(w.w));
        *(v4u*)(CAT + blk_off(pbase + t, ATTW + 8 * ch, D)) = ow;
    }
#undef POOL_ADD
}

struct Args { const float* in[19]; float* out; unsigned char* ws; int ph_lo, ph_hi, row0, nrows; };
enum { I_XP = 0, I_XS, I_CP, I_CS, I_WADA, I_BADA, I_N1G, I_N2G, I_WIN, I_QNG, I_KNG, I_RPB, I_WPOOL, I_PSCALE, I_WOUT, I_WUP, I_CONVW, I_CONVB, I_WDOWN };
constexpr int N_PHASES = 8;
#ifndef SW_PHASE
#define SW_PHASE -1
#endif
#ifndef SW_SEL
#define SW_SEL 0
#endif
#ifndef SW_SCALE
#define SW_SCALE 8
#endif
#define SW_PTR(k) ((SW_PHASE == (k) && blockIdx.x == 0) ? (volatile LAS unsigned*)(lds + LDSCTL_OFF + 64) : (volatile LAS unsigned*)nullptr)
#ifndef PROBE_MASK
#define PROBE_MASK 0
#endif
#ifndef PROBE_N
#define PROBE_N 0
#endif
#define PROBE_REPS(k) ((((PROBE_MASK) >> (k)) & 1) ? (PROBE_N) : 0)
#ifndef MK_ONE_LAUNCH
#define MK_ONE_LAUNCH 1
#endif

__global__ void __launch_bounds__(NWAVES * 64, 2) fwd(Args a) {
    extern __shared__ __attribute__((aligned(16))) unsigned char lds_raw[];
    LAS unsigned char* lds = (LAS unsigned char*)lds_raw;
    volatile LAS unsigned* MISC = (volatile LAS unsigned*)(lds + MISC_OFF);
    const int wave = __builtin_amdgcn_readfirstlane((int)threadIdx.x >> 6);
#define LANE_SETUP() int tid_ = threadIdx.x; asm volatile("" : "+v"(tid_)); const int tid = tid_, lane = tid & 63; (void)lane
    const int G = gridDim.x; const int bx = blockIdx.x; const int vcu = (bx % 8) * (G / 8) + bx / 8;
    const int gw = vcu * NWAVES + wave, NGW = G * NWAVES;
    const int grp = (bx & 7) >> 1, xh = bx & 1, gk = bx >> 3, cph = G >> 3, gsz = G >> 2, pm0 = GPANELS * grp;
    unsigned char* ws = a.ws;
    unsigned* ctl = (unsigned*)(ws + WS_CTL);
    float* macc = (float*)(ws + OFF_MOD); float* c2acc = (float*)(ws + OFF_C2); float* rss2 = (float*)(ws + OFF_RSS2); float* hss = (float*)(ws + OFF_HSS);
    bf16* WinT = (bf16*)(ws + WS_WIN); bf16* WoT = (bf16*)(ws + WS_WOUT); bf16* WupT = (bf16*)(ws + WS_WUP); bf16* WdT = (bf16*)(ws + WS_WDN);
    float* convp = (float*)(ws + WS_SMALL); float* cbp = convp + 3 * FF2;
    float* g1t = (float*)(ws + WS_SMALL + 131072); float* G2t = g1t + NBATCH * D; float* g2t = G2t + NBATCH * D;
    float* EDGE = (float*)(ws + WS_EDGE);
    unsigned char* slice = ws + WS_SLICE0 + (size_t)grp * WS_SLICE;
    bf16* H1g = (bf16*)(slice + SL_H1); bf16* PROJg = (bf16*)(slice + SL_PROJ); bf16* CATg = (bf16*)(slice + SL_CAT); unsigned short* X1g = (unsigned short*)(slice + SL_X1); bf16* XG2g = (bf16*)(slice + SL_XG2); bf16* ACTg = (bf16*)(slice + SL_ACT);
    const float* b_ada = a.in[I_BADA];

    for (int u = threadIdx.x; u < (LDS_BYTES - LDSCTL_OFF) / 4; u += NWAVES * 64) ((LAS unsigned*)(lds + LDSCTL_OFF))[u] = 0u;
    __syncthreads();
    XcdBarrier bar = xcd_barrier_post(ctl + CW_BAR, MISC + 8, (unsigned)G);
    XcdBarrier barg = xcd_barrier_post(ctl + CW_GBAR + grp * XCD_BAR_WORDS, MISC + 12, (unsigned)gsz);
#define IN(k) true
#define SEAM(k) do { if ((k) < 2) xcd_barrier(bar); else xcd_barrier(barg); } while (0)

    for (int rep = 0; rep <= PROBE_REPS(0); ++rep) { const float asc = rep ? 0.f : 1.f; (void)asc;
    if (IN(0)) {
        LANE_SETUP();
        LAS float* scr = (LAS float*)(lds + RING_OFF + wave * 16384);
        for (int it = gw; it < 16 * 96; it += NGW) {
            const int kc = it / 96, nc = it % 96, k = 64 * kc + lane;
            const float* cp = a.in[I_CP]; const float* cs = a.in[I_CS];
            gemv10_item(a.in[I_WADA], MODW, 64 * kc, 64 * nc + lane, scr, macc, MODW, 64 * nc + lane, asc, [=](LAS float* sb) {
#pragma unroll
                for (int b = 0; b < NBATCH; ++b) { const float c = b < 8 ? cp[b * D + k] : cs[(b - 8) * D + k]; sb[lane * 12 + b] = silu_f(c); } });
        }
    }
    if (rep < PROBE_REPS(0)) xcd_barrier(bar); }
    SEAM(0);

    for (int rep = 0; rep <= PROBE_REPS(1); ++rep) { const float asc = rep ? 0.f : 1.f; (void)asc;
    if (IN(1)) {
        LANE_SETUP();
        LAS float* scr = (LAS float*)(lds + RING_OFF + wave * 16384);
        constexpr int I0 = 16 * 64, I1 = I0 + 8 * 32, I2 = I1 + 16 * 176, I4 = I2 + 44 * 32, I5 = I4 + 4 * 16 * 16, I6 = I5 + 88, I7 = I6 + NBATCH * 16;
        for (int it = gw; it < I7; it += NGW) {
            if (it < I0) { const int kb = it / 64, nb = it % 64; transpose_item(a.in[I_WIN], INW, 64 * kb, 32 * nb, WinT, D, 32 * nb, 64 * kb, scr, lane); }
            else if (it < I1) { const int r = it - I0, kb = r / 32, nb = r % 32; transpose_item(a.in[I_WOUT], D, 64 * kb, 32 * nb, WoT, D, 32 * nb, 64 * kb, scr, lane); }
            else if (it < I2) { const int r = it - I1, kb = r / 176, nb = r % 176; transpose_item(a.in[I_WUP], FF2, 64 * kb, 32 * nb, WupT, D, permcol(32 * nb), 64 * kb, scr, lane);
                LAS float* sb2 = scr + 64 * 33 + 16;
#pragma unroll
                for (int b = 0; b < NBATCH; ++b) sb2[lane * 12 + b] = modv(macc, b_ada, b, 3 * D + 64 * kb + lane);
                LDS_WAIT(); asm volatile("" ::: "memory");
                const int cn = lane & 31, bh = 5 * (lane >> 5);
                float ac[5] = {0.f, 0.f, 0.f, 0.f, 0.f};
#pragma unroll 8
                for (int kk = 0; kk < 64; ++kk) { const float w = scr[kk * 33 + cn];
#pragma unroll
                    for (int i = 0; i < 5; ++i) ac[i] += w * sb2[kk * 12 + bh + i]; }
#pragma unroll
                for (int i = 0; i < 5; ++i) atomicAdd(c2acc + (size_t)(bh + i) * FF2 + permcol(32 * nb) + cn, ac[i] * asc);
                LDS_WAIT(); asm volatile("" ::: "memory"); }
            else if (it < I4) { const int r = it - I2, kb = r / 32, nb = r % 32; transpose_item(a.in[I_WDOWN], D, 64 * kb, 32 * nb, WdT, FF, 32 * nb, 64 * kb, scr, lane); }
            else if (it < I5) {
                const int r = it - I4, g = r / 256, cb = (r / 16) % 16, nb = r % 16, n = 64 * nb + lane;
                float acc[8];
#pragma unroll
                for (int i = 0; i < 8; ++i) acc[i] = 0.f;
                const float* wp = a.in[I_WPOOL] + (size_t)(g * 128 + 8 * cb) * 128;
#pragma unroll 8
                for (int d = 0; d < 128; ++d) {
                    const float wo = a.in[I_WOUT][(size_t)(ATTW + g * 128 + d) * D + n] * a.in[I_PSCALE][g * 128 + d];
#pragma unroll
                    for (int i = 0; i < 8; ++i) acc[i] += wp[i * 128 + d] * wo;
                }
                v4u o; o.x = pk2(acc[0], acc[1]); o.y = pk2(acc[2], acc[3]); o.z = pk2(acc[4], acc[5]); o.w = pk2(acc[6], acc[7]);
                *(v4u*)(WoT + blk_off(n, ATTW + g * 128 + 8 * cb, D)) = o;
            }
            else if (it < I6) { const int n = 64 * (it - I5) + lane, pc = permcol(n);
                convp[pc] = a.in[I_CONVW][n]; convp[FF2 + pc] = a.in[I_CONVW][FF2 + n]; convp[2 * FF2 + pc] = a.in[I_CONVW][2 * FF2 + n]; cbp[pc] = a.in[I_CONVB][n]; }
            else { const int r = it - I6, b = r / 16, j = 64 * (r % 16) + lane;
                g1t[b * D + j] = modv(macc, b_ada, b, 2 * D + j); G2t[b * D + j] = a.in[I_N2G][j] * (modv(macc, b_ada, b, 4 * D + j) + 1.0f); g2t[b * D + j] = modv(macc, b_ada, b, 5 * D + j); }
        }
        for (int r0 = gw * 16; r0 < MT; r0 += NGW * 16) {
            const int b = batch_of_row(r0);
            bf16* h1b = (bf16*)(ws + WS_SLICE0 + (size_t)(r0 / GROWS) * WS_SLICE + SL_H1);
            f32x4 Gv[4], Sv[4];
#pragma unroll
            for (int j = 0; j < 4; ++j) { const int c = 4 * lane + 256 * j; Gv[j] = *(const f32x4*)(a.in[I_N1G] + c) * (modv4(macc, b_ada, b, D + c) + 1.0f); Sv[j] = modv4(macc, b_ada, b, c); }
#pragma unroll 1
            for (int rr = 0; rr < 16; rr += 4) {
                f32x4 v[4][4]; float s[4];
#pragma unroll
                for (int q = 0; q < 4; ++q) { const int row = r0 + rr + q; const float* xrow = row < NPR ? a.in[I_XP] + (size_t)row * D : a.in[I_XS] + (size_t)(row - NPR) * D;
#pragma unroll
                    for (int j = 0; j < 4; ++j) v[q][j] = *(const f32x4*)(xrow + 4 * lane + 256 * j); }
#pragma unroll
                for (int q = 0; q < 4; ++q) { float t = 0.f;
#pragma unroll
                    for (int j = 0; j < 4; ++j) t += (v[q][j][0] * v[q][j][0] + v[q][j][1] * v[q][j][1]) + (v[q][j][2] * v[q][j][2] + v[q][j][3] * v[q][j][3]);
                    s[q] = t; }
#pragma unroll
                for (int o = 1; o < 64; o <<= 1) { s[0] += __shfl_xor(s[0], o); s[1] += __shfl_xor(s[1], o); s[2] += __shfl_xor(s[2], o); s[3] += __shfl_xor(s[3], o); }
#pragma unroll
                for (int q = 0; q < 4; ++q) { const int row = r0 + rr + q; const float rstd = rsqrtf(s[q] * (1.0f / D) + EPS);
#pragma unroll
                    for (int j = 0; j < 4; ++j) { const f32x4 h = v[q][j] * rstd * Gv[j] + Sv[j]; v2u w; w.x = pk2(h[0], h[1]); w.y = pk2(h[2], h[3]);
                        *(v2u*)(h1b + blk_off(row & (GROWS - 1), 4 * lane + 256 * j, D)) = w; } }
            }
        }
    }
    if (rep < PROBE_REPS(1)) xcd_barrier(bar); }
    SEAM(1);

#ifndef GROUP_SKEW_US
#define GROUP_SKEW_US 0
#endif
    if (GROUP_SKEW_US > 0 && grp > 0) {
        if (threadIdx.x == 0) { const unsigned long long t0 = __builtin_amdgcn_s_memrealtime(), tgt = (unsigned long long)(100 * GROUP_SKEW_US) * (unsigned)grp;
            while (__builtin_amdgcn_s_memrealtime() - t0 < tgt) __builtin_amdgcn_s_sleep(10); }
        __syncthreads();
    }
    for (int rep = 0; rep <= PROBE_REPS(2); ++rep) { const float asc = rep ? 0.f : 1.f; (void)asc;
    if (IN(2)) {
        pg8::Gemm g{H1g, WinT, GROWS, INW, D}; GroupOrder S; S.init(INW, gk, xh, cph);
        EpiProj E{PROJg, hss, asc, pm0};
        pg8::gemm_phase<EpiProj, GroupOrder, PG8_ALIGN, PG8_SP2>(lds + RING_OFF, g, S, E, SW_PTR(2));
    }
    if (rep < PROBE_REPS(2)) xcd_barrier(barg); }
    SEAM(2);

    for (int rep = 0; rep <= PROBE_REPS(3); ++rep) { const float asc = rep ? 0.f : 1.f; (void)asc;
    if (IN(3)) {
        LANE_SETUP();
        typedef short bf16x8 __attribute__((ext_vector_type(8)));
        typedef short s16x4 __attribute__((ext_vector_type(4)));
        LAS float* tbl = (LAS float*)(lds + BIAS_OFF);
        LAS float* rkr = (LAS float*)(lds + RK_OFF);
        const int fq = lane >> 4, l15 = lane & 15, tq = l15 >> 2, tp = lane & 3;
        const int j = wave & 3, kc0 = min(max(16 * j - 8, 0), 32);
        for (int task = xh * cph + gk; task < 64; task += 2 * cph) {
            int b, h, r0, rows;
            if (grp < 2) { b = 4 * grp + (task >> 4); h = (task >> 1) & 7; r0 = (task & 1) * 16; rows = 32; }
            else { b = 8 + (grp - 2); h = task >> 3; r0 = (task & 7) * 16; rows = 128; }
            const int base = b < 8 ? b * 2048 : NPR + (b - 8) * 8192;
            const int gbase = base - GROWS * grp;
            __syncthreads();
            { const int dr = tid >> 5, dc = tid & 31; tbl[tid] = (dr < 15 && dc < 31) ? a.in[I_RPB][h * 465 + dr * 31 + dc] * 1.4426950408889634f : -1e30f; }
            int dco[2][4];
            { const int qc = 16 * j + l15, cs = min(max(qc - 8, 0), 48);
#pragma unroll
              for (int cbk = 0; cbk < 2; ++cbk)
#pragma unroll
                  for (int e = 0; e < 4; ++e) { const int kc = kc0 + 16 * cbk + 4 * fq + e; dco[cbk][e] = 4 * ((kc >= cs && kc < cs + 16) ? (kc - qc + 15) : 31); } }
            const int koff0 = l15 * 128 + 16 * (fq ^ (l15 & 7)), koff1 = l15 * 128 + 16 * ((fq ^ (l15 & 7)) ^ 4);
            int voff[4];
#pragma unroll
            for (int db = 0; db < 4; ++db) voff[db] = (4 * fq + tq) * 128 + 16 * ((2 * db + (tp >> 1)) ^ (4 * (fq & 1) + tq)) + 8 * (tp & 1);
#define STAGE_ROW(kr) do { const int kr_ = (kr); const int slot_ = kr_ % 9; const int tc_ = 8 * wave + (lane >> 3), c16_ = (lane & 7) ^ (tc_ & 7); \
                const bf16* src_ = PROJg + (size_t)(gbase + kr_ * 64 + tc_) * INW + ATTW + h * 64 + 8 * c16_; \
                __builtin_amdgcn_global_load_lds((const unsigned*)src_, (LAS unsigned*)(lds + KRING_OFF + slot_ * 8192 + wave * 1024), 16, 0, 0); \
                __builtin_amdgcn_global_load_lds((const unsigned*)(src_ + ATTW), (LAS unsigned*)(lds + VRING_OFF + slot_ * 8192 + wave * 1024), 16, 0, 0); \
                if (wave == 4) rkr[slot_ * 64 + lane] = rsqrtf(hss[(size_t)(8 + h) * MT + base + kr_ * 64 + lane] * (1.0f / 64.0f) + EPS) * 1.4426950408889634f; } while (0)
            { const int lo0 = min(max(r0 - 4, 0), rows - 8);
              for (int kr = lo0; kr < lo0 + 8; ++kr) STAGE_ROW(kr); }
            const int pu0 = 128 * grp + 2 * task;
            v4u qraw[2] = {{0u, 0u, 0u, 0u}, {0u, 0u, 0u, 0u}}; float qss = 0.f;
            if (wave < 4) { const int qrow0 = base + r0 * 64 + 16 * j + l15; qss = hss[(size_t)h * MT + qrow0];
                qraw[0] = *(const v4u*)(PROJg + (size_t)(qrow0 - GROWS * grp) * INW + h * 64 + 8 * fq); qraw[1] = *(const v4u*)(PROJg + (size_t)(qrow0 - GROWS * grp) * INW + h * 64 + 32 + 8 * fq); }
#pragma unroll 1
            for (int st = 0; st < 16; ++st) {
                if (wave < 4 && st > 0) asm volatile("s_waitcnt vmcnt(4)" ::: "memory"); else VM_WAIT();
                LDS_WAIT(); __builtin_amdgcn_s_barrier(); asm volatile("" ::: "memory");
                const int r = r0 + st, rs = min(max(r - 4, 0), rows - 8);
                if (st < 15) { const int rsn = min(max(r + 1 - 4, 0), rows - 8); if (rsn != rs) STAGE_ROW(rsn + 7); }
                if (wave < 4) {
                    const int dr0 = rs - r + 7;
                    const int qrow = base + r * 64 + 16 * j + l15;
                    bf16x8 qf[2];
                    { const float rqs = rsqrtf(qss * (1.0f / 64.0f) + EPS) * 0.125f;
#pragma unroll
                      for (int ks = 0; ks < 2; ++ks) { const int d0 = 32 * ks + 8 * fq; const v4u w = qraw[ks];
                          const f32x4 g0 = *(const f32x4*)(a.in[I_QNG] + d0) * *(const f32x4*)(a.in[I_KNG] + d0) * rqs, g1 = *(const f32x4*)(a.in[I_QNG] + d0 + 4) * *(const f32x4*)(a.in[I_KNG] + d0 + 4) * rqs;
                          v4u o; o.x = pk2(bflo(w.x) * g0[0], bfhi(w.x) * g0[1]); o.y = pk2(bflo(w.y) * g0[2], bfhi(w.y) * g0[3]); o.z = pk2(bflo(w.z) * g1[0], bfhi(w.z) * g1[1]); o.w = pk2(bflo(w.w) * g1[2], bfhi(w.w) * g1[3]);
                          qf[ks] = __builtin_bit_cast(bf16x8, o); } }
                    if (st < 15) { qss = hss[(size_t)h * MT + qrow + 64]; qraw[0] = *(const v4u*)(PROJg + (size_t)(qrow + 64 - GROWS * grp) * INW + h * 64 + 8 * fq); qraw[1] = *(const v4u*)(PROJg + (size_t)(qrow + 64 - GROWS * grp) * INW + h * 64 + 32 + 8 * fq); }
                    f32x4 sc[16]; float mx = -3e38f;
                    bf16x8 kA[2][2], kB[2][2]; f32x4 rkv[2]; float bsv[2][4];
                    const LAS unsigned char* tba[2][4];
#pragma unroll
                    for (int cbk = 0; cbk < 2; ++cbk)
#pragma unroll
                        for (int e = 0; e < 4; ++e) tba[cbk][e] = (const LAS unsigned char*)(tbl + dr0 * 32) + dco[cbk][e];
#define ATT_LOAD_K(KF, i) do { const LAS unsigned char* kb_ = lds + KRING_OFF + ((rs + (i)) % 9) * 8192 + kc0 * 128; \
                        _Pragma("unroll") for (int cbk = 0; cbk < 2; ++cbk) { KF[cbk][0] = *(const LAS bf16x8*)(kb_ + cbk * 2048 + koff0); KF[cbk][1] = *(const LAS bf16x8*)(kb_ + cbk * 2048 + koff1); } } while (0)
#define ATT_LOAD_RB(i) do { const LAS float* rkb_ = rkr + ((rs + (i)) % 9) * 64 + kc0 + 4 * fq; \
                        _Pragma("unroll") for (int cbk = 0; cbk < 2; ++cbk) { rkv[cbk] = *(const LAS f32x4*)(rkb_ + 16 * cbk); \
                            bsv[cbk][0] = *(const LAS float*)(tba[cbk][0] + (i) * 128); bsv[cbk][1] = *(const LAS float*)(tba[cbk][1] + (i) * 128); bsv[cbk][2] = *(const LAS float*)(tba[cbk][2] + (i) * 128); bsv[cbk][3] = *(const LAS float*)(tba[cbk][3] + (i) * 128); } } while (0)
#define ATT_COMP_ROW(KF, i) do { f32x4 c_[2]; _Pragma("unroll") for (int cbk = 0; cbk < 2; ++cbk) { c_[cbk] = (f32x4){0.f, 0.f, 0.f, 0.f}; \
                            c_[cbk] = __builtin_amdgcn_mfma_f32_16x16x32_bf16(KF[cbk][0], qf[0], c_[cbk], 0, 0, 0); c_[cbk] = __builtin_amdgcn_mfma_f32_16x16x32_bf16(KF[cbk][1], qf[1], c_[cbk], 0, 0, 0); } \
                        _Pragma("unroll") for (int cbk = 0; cbk < 2; ++cbk) { \
                            f32x4 s; s[0] = c_[cbk][0] * rkv[cbk][0] + bsv[cbk][0]; s[1] = c_[cbk][1] * rkv[cbk][1] + bsv[cbk][1]; s[2] = c_[cbk][2] * rkv[cbk][2] + bsv[cbk][2]; s[3] = c_[cbk][3] * rkv[cbk][3] + bsv[cbk][3]; \
                            sc[2 * (i) + cbk] = s; mx = fmaxf(fmaxf(mx, fmaxf(s[0], s[1])), fmaxf(s[2], s[3])); } } while (0)
                    ATT_LOAD_K(kA, 0);
#pragma unroll
                    for (int i2 = 0; i2 < 4; ++i2) {
                        ATT_LOAD_K(kB, 2 * i2 + 1); ATT_LOAD_RB(2 * i2); __builtin_amdgcn_sched_barrier(0);
                        ATT_COMP_ROW(kA, 2 * i2);     __builtin_amdgcn_sched_barrier(0);
                        if (i2 < 3) { ATT_LOAD_K(kA, 2 * i2 + 2); } ATT_LOAD_RB(2 * i2 + 1); __builtin_amdgcn_sched_barrier(0);
                        ATT_COMP_ROW(kB, 2 * i2 + 1); __builtin_amdgcn_sched_barrier(0);
                    }
#undef ATT_LOAD_K
#undef ATT_LOAD_RB
#undef ATT_COMP_ROW
                    mx = fmaxf(mx, __shfl_xor(mx, 16)); mx = fmaxf(mx, __shfl_xor(mx, 32));
                    float lsum = 0.f;
#pragma unroll
                    for (int kb = 0; kb < 16; ++kb) { f32x4 e; e[0] = __builtin_amdgcn_exp2f(sc[kb][0] - mx); e[1] = __builtin_amdgcn_exp2f(sc[kb][1] - mx); e[2] = __builtin_amdgcn_exp2f(sc[kb][2] - mx); e[3] = __builtin_amdgcn_exp2f(sc[kb][3] - mx);
                        sc[kb] = e; lsum += (e[0] + e[1]) + (e[2] + e[3]); }
                    lsum += __shfl_xor(lsum, 16); lsum += __shfl_xor(lsum, 32);
                    f32x4 oacc[4];
#pragma unroll
                    for (int db = 0; db < 4; ++db) oacc[db] = (f32x4){0.f, 0.f, 0.f, 0.f};
                    s16x4 vaA[4], vbA[4], vaB[4], vbB[4];
#define ATT_LOAD_V(VA, VB, t) do { const LAS unsigned char* pA_ = lds + VRING_OFF + ((rs + (t)) % 9) * 8192 + kc0 * 128, * pB_ = pA_ + 2048; \
                        _Pragma("unroll") for (int db = 0; db < 4; ++db) { VA[db] = __builtin_bit_cast(s16x4, __builtin_amdgcn_ds_read_tr16_b64_v4i16((LAS s16x4*)(pA_ + voff[db]))); \
                            VB[db] = __builtin_bit_cast(s16x4, __builtin_amdgcn_ds_read_tr16_b64_v4i16((LAS s16x4*)(pB_ + voff[db]))); } } while (0)
#define ATT_COMP_V(VA, VB, t) do { const int kbA_ = 2 * (t), kbB_ = 2 * (t) + 1; \
                        v4u pw_; pw_.x = cvt_pk(sc[kbA_][0], sc[kbA_][1]); pw_.y = cvt_pk(sc[kbA_][2], sc[kbA_][3]); pw_.z = cvt_pk(sc[kbB_][0], sc[kbB_][1]); pw_.w = cvt_pk(sc[kbB_][2], sc[kbB_][3]); \
                        const bf16x8 pf_ = __builtin_bit_cast(bf16x8, pw_); \
                        _Pragma("unroll") for (int db = 0; db < 4; ++db) { bf16x8 vf_; vf_[0] = VA[db][0]; vf_[1] = VA[db][1]; vf_[2] = VA[db][2]; vf_[3] = VA[db][3]; vf_[4] = VB[db][0]; vf_[5] = VB[db][1]; vf_[6] = VB[db][2]; vf_[7] = VB[db][3]; \
                            oacc[db] = __builtin_amdgcn_mfma_f32_16x16x32_bf16(vf_, pf_, oacc[db], 0, 0, 0); } } while (0)
                    ATT_LOAD_V(vaA, vbA, 0);
#pragma unroll
                    for (int t2 = 0; t2 < 4; ++t2) {
                        ATT_LOAD_V(vaB, vbB, 2 * t2 + 1); __builtin_amdgcn_sched_barrier(0);
                        ATT_COMP_V(vaA, vbA, 2 * t2);     __builtin_amdgcn_sched_barrier(0);
                        if (t2 < 3) { ATT_LOAD_V(vaA, vbA, 2 * t2 + 2); } __builtin_amdgcn_sched_barrier(0);
                        ATT_COMP_V(vaB, vbB, 2 * t2 + 1); __builtin_amdgcn_sched_barrier(0);
                    }
#undef ATT_LOAD_V
#undef ATT_COMP_V
                    const float il = 1.0f / lsum;
#pragma unroll
                    for (int db = 0; db < 4; ++db) { v2u w; w.x = cvt_pk(oacc[db][0] * il, oacc[db][1] * il); w.y = cvt_pk(oacc[db][2] * il, oacc[db][3] * il);
                        *(v2u*)(CATg + blk_off(qrow - GROWS * grp, h * 64 + 16 * db + 4 * fq, D)) = w; }
                } else if ((st & 1) == 0) {
                    const int it = st >> 1, g = wave - 4, pu = pu0 + (it >> 2), tg = 4 * (it & 3) + (lane >> 4), ch = 16 * g + (lane & 15);
                    int pb, prr, prows;
                    if (pu < 256) { pb = pu >> 5; prr = pu & 31; prows = 32; } else { pb = 8 + ((pu - 256) >> 7); prr = (pu - 256) & 127; prows = 128; }
                    const int pbase = (pb < 8 ? pb * 2048 : NPR + (pb - 8) * 8192) - GROWS * grp, T = prows * 64, t0 = prr * 64 + 4 * tg;
                    if (g == 0) pool_group<1>(PROJg, CATg, pbase, T, t0, ch); else if (g == 1) pool_group<2>(PROJg, CATg, pbase, T, t0, ch);
                    else if (g == 2) pool_group<4>(PROJg, CATg, pbase, T, t0, ch); else pool_group<8>(PROJg, CATg, pbase, T, t0, ch);
                }
            }
#undef STAGE_ROW
        }
    }
    if (rep < PROBE_REPS(3)) xcd_barrier(barg); }
    SEAM(3);

    for (int rep = 0; rep <= PROBE_REPS(4); ++rep) { const float asc = rep ? 0.f : 1.f; (void)asc;
    if (IN(4)) {
        pg8::Gemm g{CATg, WoT, GROWS, D, D}; GroupOrder S; S.init(D, gk, xh, cph);
        EpiOut E{a.in[I_XP], a.in[I_XS], X1g, XG2g, rss2, g1t, G2t, asc, pm0};
        for (int i = 0; ; ++i) {
            OneUnit S1; if (!S.next(i, S1.u)) break;
            pg8::gemm_phase<EpiOut, OneUnit, PG8_ALIGN, PG8_SP2>(lds + RING_OFF, g, S1, E, SW_PTR(4));
            __syncthreads();
        }
    }
    if (rep < PROBE_REPS(4)) xcd_barrier(barg); }
    SEAM(4);

    for (int rep = 0; rep <= PROBE_REPS(5); ++rep) { const float asc = rep ? 0.f : 1.f; (void)asc;
    if (IN(5)) {
        pg8::Gemm g{XG2g, WupT, GROWS, FF2, D}; GroupOrder S; S.init(FF2, gk, xh, cph);
        EpiConvAct E{ACTg, EDGE, rss2, c2acc, convp, cbp, (LAS float*)(lds + XCH_OFF), pm0};
        pg8::gemm_phase<EpiConvAct, GroupOrder, PG8_ALIGN, PG8_SP2>(lds + RING_OFF, g, S, E, SW_PTR(5));
    }
    if (rep < PROBE_REPS(5)) xcd_barrier(barg); }
    SEAM(5);

    for (int rep = 0; rep <= PROBE_REPS(6); ++rep) { const float asc = rep ? 0.f : 1.f; (void)asc;
    if (IN(6)) {
        LANE_SETUP();
        for (int idx = (xh * cph + gk) * 512 + tid; idx < 2 * GPANELS * (FF / 8); idx += gsz * 512) {
            const int br = idx / (FF / 8), f = 8 * (idx % (FF / 8)), gcol = (f >> 7) * 256 + (f & 127);
            const int pm = pm0 + (br >> 1), last = br & 1, row = pm * 256 + (last ? 255 : 0);
            const int b = batch_of_row(row), t = row < NPR ? (row & 2047) : ((row - NPR) & 8191), T = b < 8 ? 2048 : 8192;
            const float* em; const float* e0; const float* ep;
            if (!last) { em = EDGE + ((size_t)(pm - 1) * 4 + 3) * FF2; e0 = EDGE + ((size_t)pm * 4 + 0) * FF2; ep = EDGE + ((size_t)pm * 4 + 1) * FF2; }
            else       { em = EDGE + ((size_t)pm * 4 + 2) * FF2; e0 = EDGE + ((size_t)pm * 4 + 3) * FF2; ep = EDGE + ((size_t)(pm + 1) * 4 + 0) * FF2; }
            const bool hm = t > 0, hp = t < T - 1;
            float res[2][8];
#pragma unroll
            for (int part = 0; part < 2; ++part) {
                const int col = gcol + 128 * part;
#pragma unroll
                for (int hh = 0; hh < 2; ++hh) {
                    const int c = col + 4 * hh; const f32x4 zero = {0.f, 0.f, 0.f, 0.f};
                    const f32x4 um = hm ? *(const f32x4*)(em + c) : zero, u0 = *(const f32x4*)(e0 + c), up = hp ? *(const f32x4*)(ep + c) : zero;
                    const f32x4 w0 = *(const f32x4*)(convp + c), w1 = *(const f32x4*)(convp + FF2 + c), w2 = *(const f32x4*)(convp + 2 * FF2 + c), cb = *(const f32x4*)(cbp + c);
                    const f32x4 r = w0 * um + w1 * u0 + w2 * up + cb;
                    res[part][4 * hh + 0] = r[0]; res[part][4 * hh + 1] = r[1]; res[part][4 * hh + 2] = r[2]; res[part][4 * hh + 3] = r[3];
                }
            }
            v4u ow; ow.x = pk2(silu_f(res[0][0]) * res[1][0], silu_f(res[0][1]) * res[1][1]); ow.y = pk2(silu_f(res[0][2]) * res[1][2], silu_f(res[0][3]) * res[1][3]);
            ow.z = pk2(silu_f(res[0][4]) * res[1][4], silu_f(res[0][5]) * res[1][5]); ow.w = pk2(silu_f(res[0][6]) * res[1][6], silu_f(res[0][7]) * res[1][7]);
            *(v4u*)(ACTg + blk_off(row - GROWS * grp, f, FF)) = ow;
        }
    }
    if (rep < PROBE_REPS(6)) xcd_barrier(barg); }
    SEAM(6);

    for (int rep = 0; rep <= PROBE_REPS(7); ++rep) { const float asc = rep ? 0.f : 1.f; (void)asc;
    if (IN(7)) {
        pg8::Gemm g{ACTg, WdT, GROWS, D, FF}; GroupOrder S; S.init(D, gk, xh, cph);
        EpiDown E{X1g, a.out, g2t, pm0};
        pg8::gemm_phase<EpiDown, GroupOrder, PG8_ALIGN, PG8_SP2>(lds + RING_OFF, g, S, E, SW_PTR(7));
    }
    if (rep < PROBE_REPS(7)) xcd_barrier(barg); }
    if (SW_PHASE >= 0 && blockIdx.x == 0 && threadIdx.x == 0) {
        const unsigned long long tgt = (unsigned long long)SW_SCALE * ((volatile LAS unsigned*)(lds + LDSCTL_OFF + 64))[SW_SEL], t0 = __builtin_amdgcn_s_memrealtime();
        while (__builtin_amdgcn_s_memrealtime() - t0 < tgt) __builtin_amdgcn_s_sleep(20);
    }
#undef IN
#undef SEAM
}

extern "C" void kernel_launch(void* const* d_in, const int* in_sizes, int n_in, void* d_out, int out_size, void* d_ws, size_t ws_size, hipStream_t stream) {
    static int grid = 0;
    if (grid == 0) {
        if (n_in != 19 || out_size != MT * D || ws_size < WS_END) { fprintf(stderr, "kernel_launch: unexpected shapes (n_in %d, out %d, ws %zu)\n", n_in, out_size, ws_size); grid = -1; return; }
        int dev = 0, cus = 0;
        if (hipGetDevice(&dev) != hipSuccess || hipDeviceGetAttribute(&cus, hipDeviceAttributeMultiprocessorCount, dev) != hipSuccess) { grid = -1; return; }
        if (hipFuncSetAttribute((const void*)fwd, hipFuncAttributeMaxDynamicSharedMemorySize, LDS_BYTES) != hipSuccess) { fprintf(stderr, "kernel_launch: hipFuncSetAttribute failed\n"); grid = -1; return; }
        int per_cu = 0;
        if (hipOccupancyMaxActiveBlocksPerMultiprocessor(&per_cu, (const void*)fwd, NWAVES * 64, LDS_BYTES) != hipSuccess || per_cu < 1) { fprintf(stderr, "kernel_launch: the occupancy query admits %d workgroups per CU; nothing launched\n", per_cu); grid = -1; return; }
        (void)hipGetLastError();
        grid = cus;
        if (grid % 8 != 0 || grid < 8) { fprintf(stderr, "kernel_launch: needs a multiple of 8 CUs (got %d)\n", grid); grid = -1; return; }
    }
    if (grid < 0) return;
    if (hipMemsetAsync((char*)d_ws + WS_CTL, 0, CTL_ZERO_BYTES, stream) != hipSuccess) return;
    Args a{};
    for (int i = 0; i < 19; ++i) a.in[i] = (const float*)d_in[i];
    a.out = (float*)d_out; a.ws = (unsigned char*)d_ws;
    a.ph_lo = 0; a.ph_hi = N_PHASES; a.row0 = 0; a.nrows = 0;
    hipLaunchKernelGGL(fwd, dim3(grid), dim3(NWAVES * 64), LDS_BYTES, stream, a);
}
```

```cpp
#include <hip/hip_runtime.h>
#include <cstdio>
#include <cstdint>

constexpr int D = 1024, MT = 32768, NPR = 16384, INW = 2048, ATTW = 512, HD = 64, NH = 8, FF = 2816, FF2 = 5632, NBATCH = 10, MODW = 6144;
constexpr float EPS = 1e-6f;

namespace pg8 {
#define PG8_LAS __attribute__((address_space(3)))
typedef unsigned short bf16_t;
typedef short bf16x8 __attribute__((ext_vector_type(8)));
typedef float f32x4 __attribute__((ext_vector_type(4)));
typedef unsigned u32x4 __attribute__((ext_vector_type(4)));
constexpr int BM = 256, BK = 64, HALF = 128, HTB = HALF * BK * 2  , STAGE_BYTES = 8 * HTB, NXCD = 8, WGM = 8;

__host__ __device__ __forceinline__ int lds_byte(int r, int c) { const int st = (r >> 4) * 2 + (c >> 5), rr = r & 15, cc = c & 31, ob = rr * 64 + cc * 2; return st * 1024 + (ob ^ (((ob >> 9) & 1) << 5)); }
__host__ __device__ __forceinline__ void stage_rc(int b, int& R, int& C) { const int st = b / 1024, sb = b % 1024, swz = sb ^ (((sb >> 9) & 1) << 5); R = (st >> 1) * 16 + swz / 64; C = (st & 1) * 32 + (swz % 64) / 2; }
__host__ __device__ __forceinline__ int perm32(int rho) { const int n = rho >> 4, i = rho & 15; return 8 * (i >> 2) + 4 * n + (i & 3); }

struct Unit { int pm, pn; };
struct Gemm { const bf16_t* A; const bf16_t* Bt; int M, N, K; };

struct StaticOrder {
    int nM, nN, nwg, G, c;
    __host__ __device__ void init(int M, int N, int G_, int c_) { nM = M / BM; nN = N / BM; nwg = nM * nN; G = G_; c = c_; }
    __host__ __device__ bool next(int i, Unit& u) const {
        const long L = (long)i * G + c; if (L >= nwg) return false;
        int wgid = (int)L; { const int q = nwg / NXCD, r = nwg % NXCD, xcd = wgid % NXCD, off = wgid / NXCD; wgid = (xcd < r ? xcd * (q + 1) : r * (q + 1) + (xcd - r) * q) + off; }
        const int nig = WGM * nN, gid = wgid / nig, fm = gid * WGM, gsz = (nM - fm) < WGM ? (nM - fm) : WGM;
        u.pm = fm + ((wgid % nig) % gsz); u.pn = (wgid % nig) / gsz; return true;
    }
    __device__ __forceinline__ void a_ready(const Unit&) const {}
    __device__ __forceinline__ void done(const Unit&) const {}
};

template <class Epi, class Sched, bool ALIGN_EPI = false, bool SP2 = false>
__device__ __forceinline__ void gemm_phase(PG8_LAS unsigned char* lds, const Gemm g, const Sched& S, const Epi& E, volatile PG8_LAS unsigned* sw = nullptr) {
    unsigned long long sw_t = 0;
    int tid_ = threadIdx.x; asm volatile("" : "+v"(tid_));
    const int tid = tid_, wid = __builtin_amdgcn_readfirstlane(tid >> 6), lane = tid & 63, wr = wid >> 2, wc = wid & 3, fr = lane & 15, fq = lane >> 4;
    const int K = g.K, nt = K / BK;
    unsigned voffA[2], voffB[2];
#pragma unroll
    for (int i = 0; i < 2; ++i) { int R, C; stage_rc(tid * 16 + i * 8192, R, C); const int Rb = Epi::PERM ? ((R & ~31) + perm32(R & 31)) : R;
        const int Ra = Epi::PERMA ? ((R & 64) + 4 * (R & 15) + ((R >> 4) & 3)) : R;
        voffA[i] = (unsigned)(Ra * BK + C) * 2u; voffB[i] = (unsigned)(Rb * BK + C) * 2u; }
    const size_t kstep = (size_t)(BM * BK * 2);
    const size_t hstep = (size_t)HALF * BK * 2;
    const size_t tstep = (size_t)K * BM * 2;
    const unsigned ldsw = (unsigned)wid * 1024u;
    const int aoff = lds_byte(wr * 64 + fr, fq * 8), boff = lds_byte(wc * 32 + fr, fq * 8);
#define PG8_SA(b, h) (((b) * 2 + (h)) * HTB)
#define PG8_SB(b, h) ((4 + (b) * 2 + (h)) * HTB)
#define PG8_STAGE(bufoff, gbase, voff) do { _Pragma("unroll") for (int _i = 0; _i < 2; ++_i) \
        __builtin_amdgcn_global_load_lds((const unsigned*)((const char*)(gbase) + (voff)[_i]), (PG8_LAS unsigned*)(lds + (bufoff) + ldsw + _i * 8192), 16, 0, 0); } while (0)
#define PG8_LDA(dst, b, h) do { _Pragma("unroll") for (int m = 0; m < 4; ++m) _Pragma("unroll") for (int k = 0; k < 2; ++k) dst[m][k] = *(const PG8_LAS bf16x8*)(lds + PG8_SA(b, h) + aoff + m * 2048 + k * 1024); } while (0)
#define PG8_LDB(dst, b, h) do { _Pragma("unroll") for (int n = 0; n < 2; ++n) _Pragma("unroll") for (int k = 0; k < 2; ++k) dst[n][k] = *(const PG8_LAS bf16x8*)(lds + PG8_SB(b, h) + boff + n * 2048 + k * 1024); } while (0)
#define PG8_MMA(ai, bj, At, Bt) do { __builtin_amdgcn_s_setprio(1); _Pragma("unroll") for (int m = 0; m < 4; ++m) _Pragma("unroll") for (int n = 0; n < 2; ++n) _Pragma("unroll") for (int k = 0; k < 2; ++k) \
        acc[ai][bj][m][n] = __builtin_amdgcn_mfma_f32_16x16x32_bf16(Bt[n][k], At[m][k], acc[ai][bj][m][n], 0, 0, 0); __builtin_amdgcn_s_setprio(0); } while (0)
#define PG8_WAIT_V(n) asm volatile("s_waitcnt vmcnt(" #n ")" ::: "memory")
#define PG8_WAIT_L(n) asm volatile("s_waitcnt lgkmcnt(" #n ")" ::: "memory")
#define PG8_BAR __builtin_amdgcn_s_barrier()
#define PG8_SCHED __builtin_amdgcn_sched_barrier(0)
    Unit cur, nxt; int ui = 0;
    if (!S.next(0, cur)) return;
    if constexpr (Epi::PREFETCH) E.prefetch(cur, 0, wid, lane);
    f32x4 acc[2][2][4][2];
#pragma unroll
    for (int a = 0; a < 2; ++a)
#pragma unroll
        for (int b = 0; b < 2; ++b)
#pragma unroll
            for (int m = 0; m < 4; ++m)
#pragma unroll
                for (int n = 0; n < 2; ++n) acc[a][b][m][n] = (f32x4){0.f, 0.f, 0.f, 0.f};
    bf16x8 At[4][2], B0[2][2], B1[2][2];
    const char* cA = (const char*)g.A + (size_t)cur.pm * tstep; const char* cB = (const char*)g.Bt + (size_t)cur.pn * tstep;
    S.a_ready(cur);
    if constexpr (SP2) {
        PG8_STAGE(PG8_SB(0, 0), cB, voffB); PG8_STAGE(PG8_SB(0, 1), cB + hstep, voffB); PG8_STAGE(PG8_SA(0, 0), cA, voffA); PG8_STAGE(PG8_SA(0, 1), cA + hstep, voffA);
        if (wr == 1) PG8_BAR;
        PG8_WAIT_V(2); PG8_BAR;
        PG8_STAGE(PG8_SB(1, 0), cB + kstep, voffB); PG8_STAGE(PG8_SA(1, 0), cA + kstep, voffA); PG8_STAGE(PG8_SB(1, 1), cB + hstep + kstep, voffB);
        PG8_WAIT_V(6); PG8_BAR;
    } else {
        PG8_STAGE(PG8_SB(0, 0), cB, voffB); PG8_STAGE(PG8_SA(0, 0), cA, voffA); PG8_STAGE(PG8_SB(0, 1), cB + hstep, voffB); PG8_STAGE(PG8_SA(0, 1), cA + hstep, voffA);
        if (wr == 1) PG8_BAR;
        PG8_WAIT_V(4); PG8_BAR;
        PG8_STAGE(PG8_SB(1, 0), cB + kstep, voffB); PG8_STAGE(PG8_SA(1, 0), cA + kstep, voffA); PG8_STAGE(PG8_SB(1, 1), cB + hstep + kstep, voffB);
        PG8_WAIT_V(6); PG8_BAR;
    }
    for (;;) {
        if (sw) { __builtin_amdgcn_sched_barrier(0); sw_t = __builtin_amdgcn_s_memrealtime(); __builtin_amdgcn_sched_barrier(0); }
        const bool has_next = S.next(ui + 1, nxt);
        const char* nA = has_next ? (const char*)g.A + (size_t)nxt.pm * tstep : cA; const char* nB = has_next ? (const char*)g.Bt + (size_t)nxt.pn * tstep : cB;
        for (int t = 0; t < nt; t += 2) {
            const bool last = (t == nt - 2);
            const char* a1 = cA + (size_t)(t + 1) * kstep;
            const char* a2 = last ? nA : cA + (size_t)(t + 2) * kstep; const char* b2 = last ? nB : cB + (size_t)(t + 2) * kstep;
            const char* a3 = a2 + kstep; const char* b3 = b2 + kstep;
            if (last && has_next) S.a_ready(nxt);
            if constexpr (SP2) {
            PG8_LDB(B0, 0, 0); PG8_LDB(B1, 0, 1); PG8_SCHED; PG8_LDA(At, 0, 0); PG8_STAGE(PG8_SA(1, 1), a1 + hstep, voffA);
            PG8_WAIT_V(8); PG8_WAIT_L(0); PG8_BAR; PG8_MMA(0, 0, At, B0); PG8_MMA(0, 1, At, B1); PG8_BAR; PG8_SCHED;
            PG8_LDA(At, 0, 1); PG8_STAGE(PG8_SB(0, 0), b2, voffB); PG8_STAGE(PG8_SB(0, 1), b2 + hstep, voffB); PG8_STAGE(PG8_SA(0, 0), a2, voffA);
            PG8_WAIT_V(8); PG8_WAIT_L(0); PG8_BAR; PG8_MMA(1, 0, At, B0); PG8_MMA(1, 1, At, B1); PG8_BAR; PG8_SCHED;
            PG8_LDB(B0, 1, 0); PG8_LDB(B1, 1, 1); PG8_SCHED; PG8_LDA(At, 1, 0); PG8_STAGE(PG8_SA(0, 1), a2 + hstep, voffA);
            PG8_WAIT_V(8); PG8_WAIT_L(0); PG8_BAR; PG8_MMA(0, 0, At, B0); PG8_MMA(0, 1, At, B1); PG8_BAR; PG8_SCHED;
            PG8_LDA(At, 1, 1); PG8_STAGE(PG8_SB(1, 0), b3, voffB); PG8_STAGE(PG8_SB(1, 1), b3 + hstep, voffB); PG8_STAGE(PG8_SA(1, 0), a3, voffA);
            PG8_WAIT_V(8); PG8_WAIT_L(0); PG8_BAR; PG8_MMA(1, 0, At, B0); PG8_MMA(1, 1, At, B1); PG8_BAR; PG8_SCHED;
            } else {
            PG8_LDB(B0, 0, 0); PG8_SCHED; PG8_LDA(At, 0, 0); PG8_STAGE(PG8_SA(1, 1), a1 + hstep, voffA);
            PG8_WAIT_L(8); PG8_BAR; PG8_WAIT_L(0); PG8_MMA(0, 0, At, B0); PG8_BAR; PG8_SCHED;
            PG8_LDB(B1, 0, 1); PG8_STAGE(PG8_SB(0, 0), b2, voffB);
            PG8_BAR; PG8_WAIT_L(0); PG8_MMA(0, 1, At, B1); PG8_BAR;
            PG8_LDA(At, 0, 1); PG8_STAGE(PG8_SA(0, 0), a2, voffA);
            PG8_BAR; PG8_WAIT_L(0); PG8_MMA(1, 0, At, B0); PG8_BAR; PG8_SCHED;
            PG8_STAGE(PG8_SB(0, 1), b2 + hstep, voffB);
            PG8_WAIT_V(6); PG8_BAR; PG8_MMA(1, 1, At, B1); PG8_BAR;
            PG8_LDB(B0, 1, 0); PG8_SCHED; PG8_LDA(At, 1, 0); PG8_STAGE(PG8_SA(0, 1), a2 + hstep, voffA);
            PG8_WAIT_L(8); PG8_BAR; PG8_WAIT_L(0); PG8_MMA(0, 0, At, B0); PG8_BAR; PG8_SCHED;
            PG8_LDB(B1, 1, 1); PG8_STAGE(PG8_SB(1, 0), b3, voffB);
            PG8_BAR; PG8_WAIT_L(0); PG8_MMA(0, 1, At, B1); PG8_BAR;
            PG8_LDA(At, 1, 1); PG8_STAGE(PG8_SA(1, 0), a3, voffA);
            PG8_BAR; PG8_WAIT_L(0); PG8_MMA(1, 0, At, B0); PG8_BAR; PG8_SCHED;
            PG8_STAGE(PG8_SB(1, 1), b3 + hstep, voffB);
            PG8_WAIT_V(6); PG8_BAR; PG8_MMA(1, 1, At, B1); PG8_BAR;
            }
        }
        if constexpr (ALIGN_EPI) { if (wr == 0) PG8_BAR; }
        if (sw) { __builtin_amdgcn_sched_barrier(0); const unsigned long long t1 = __builtin_amdgcn_s_memrealtime(); if (threadIdx.x == 0) sw[0] += (unsigned)(t1 - sw_t); sw_t = t1; __builtin_amdgcn_sched_barrier(0); }
        if constexpr (Epi::PREFETCH) { E.run(acc, cur, wr, wc, fr, fq, ui & 1); if (has_next) E.prefetch(nxt, (ui + 1) & 1, wid, lane); S.done(cur); }
        else if constexpr (!Epi::AFTER_DRAIN) { E(acc, cur, wr, wc, fr, fq); S.done(cur); }
        if (sw) { __builtin_amdgcn_sched_barrier(0); const unsigned long long t1 = __builtin_amdgcn_s_memrealtime(); if (threadIdx.x == 0) sw[1] += (unsigned)(t1 - sw_t); __builtin_amdgcn_sched_barrier(0); }
        if (!has_next) break;
#pragma unroll
        for (int a = 0; a < 2; ++a)
#pragma unroll
            for (int b = 0; b < 2; ++b)
#pragma unroll
                for (int m = 0; m < 4; ++m)
#pragma unroll
                    for (int n = 0; n < 2; ++n) acc[a][b][m][n] = (f32x4){0.f, 0.f, 0.f, 0.f};
        cur = nxt; cA = nA; cB = nB; ++ui;
        if constexpr (ALIGN_EPI) { if (wr == 1) PG8_BAR; }
    }
    PG8_WAIT_V(0);
    if constexpr (!ALIGN_EPI) { if (wr == 0) PG8_BAR; }
    PG8_BAR;
    if constexpr (Epi::AFTER_DRAIN) { E.fused(acc, cur, wr, wc, fr, fq, lds, wid, lane); S.done(cur); }
#undef PG8_SA
#undef PG8_SB
#undef PG8_STAGE
#undef PG8_LDA
#undef PG8_LDB
#undef PG8_MMA
#undef PG8_WAIT_V
#undef PG8_WAIT_L
#undef PG8_BAR
#undef PG8_SCHED
}
}
#ifndef PG8_SP2
#define PG8_SP2 true
#endif
#ifndef PG8_ALIGN
#define PG8_ALIGN true
#endif
constexpr size_t MiB = 1u << 20;
constexpr size_t WS_CTL = 0, CTL_ZERO_BYTES = 3 * MiB;
constexpr size_t OFF_MOD = 131072, OFF_C2 = 393216, OFF_RSS2 = 622592, OFF_HSS = 1 * MiB;
constexpr size_t WS_WIN = 3 * MiB, WS_WOUT = 7 * MiB, WS_WUP = 9 * MiB, WS_WDN = 20 * MiB, WS_SMALL = 26 * MiB, WS_EDGE = 27 * MiB, WS_SLICE0 = 40 * MiB, WS_SLICE = 112 * MiB;
constexpr size_t SL_H1 = 0, SL_PROJ = 16 * MiB, SL_CAT = 48 * MiB, SL_XG2 = 64 * MiB, SL_X1 = 80 * MiB, SL_ACT = 0;
constexpr size_t WS_END = 512 * MiB;
constexpr int NGROUPS = 4, GROWS = MT / NGROUPS, GPANELS = GROWS / 256;
constexpr int CW_BAR = 4096, CW_GBAR = 8192;
constexpr int RING_OFF = 0, RING_BYTES = 131072;
constexpr int XCH_OFF = 131072;
constexpr int KRING_OFF = 0, VRING_OFF = 73728;
constexpr int BIAS_OFF = 147456, RK_OFF = 149504;
constexpr int LDSCTL_OFF = 155648, MISC_OFF = LDSCTL_OFF + 320, LDS_BYTES = 163840;
constexpr int NWAVES = 8;

#define GAS __attribute__((address_space(1)))
#define LAS __attribute__((address_space(3)))
typedef unsigned short bf16;
typedef unsigned v4u __attribute__((ext_vector_type(4)));
typedef unsigned v2u __attribute__((ext_vector_type(2)));
using pg8::f32x4;
#define LDS_WAIT() asm volatile("s_waitcnt lgkmcnt(0)" ::: "memory")
#define VM_WAIT() asm volatile("s_waitcnt vmcnt(0)" ::: "memory")
__device__ __forceinline__ unsigned f2bf(float f) { unsigned u = __builtin_bit_cast(unsigned, f); return (u + 0x7fffu + ((u >> 16) & 1u)) >> 16; }
__device__ __forceinline__ unsigned pk2(float lo, float hi) { return f2bf(lo) | (f2bf(hi) << 16); }
__device__ __forceinline__ float bflo(unsigned w) { return __builtin_bit_cast(float, w << 16); }
__device__ __forceinline__ float bfhi(unsigned w) { return __builtin_bit_cast(float, w & 0xffff0000u); }
typedef float f32x2_t __attribute__((ext_vector_type(2))); typedef __bf16 bf16x2_t __attribute__((ext_vector_type(2))); typedef _Float16 f16x2_t __attribute__((ext_vector_type(2)));
__device__ __forceinline__ unsigned cvt_pk_h(float lo, float hi) { f32x2_t v = {lo, hi}; f16x2_t h = __builtin_convertvector(v, f16x2_t); return __builtin_bit_cast(unsigned, h); }
__device__ __forceinline__ f32x2_t h2f(unsigned w) { return __builtin_convertvector(__builtin_bit_cast(f16x2_t, w), f32x2_t); }
__device__ __forceinline__ unsigned cvt_pk(float lo, float hi) { f32x2_t v = {lo, hi}; bf16x2_t b = __builtin_convertvector(v, bf16x2_t); return __builtin_bit_cast(unsigned, b); }
__device__ __forceinline__ size_t blk_off(int row, int col, int K) { return ((size_t)((row >> 8) * (K >> 6) + (col >> 6)) << 14) + (size_t)(((row & 255) << 6) + (col & 63)); }
__device__ __forceinline__ int batch_of_row(int row) { return row < NPR ? (row >> 11) : 8 + ((row - NPR) >> 13); }
__device__ __forceinline__ int batch_of_tile(int pm) { return pm < 64 ? (pm >> 3) : 8 + ((pm - 64) >> 5); }
__device__ __forceinline__ int permcol(int n) { const int f = n < FF ? n : n - FF; return (f >> 7) * 256 + (f & 127) + (n < FF ? 0 : 128); }
__device__ __forceinline__ float wave_sum(float v) {
#pragma unroll
    for (int o = 1; o < 64; o <<= 1) v += __shfl_xor(v, o);
    return v;
}
__device__ __forceinline__ float silu_f(float x) { return x / (1.0f + __expf(-x)); }

#define XB_TMO      128
#define XB_XCNT(j)  (256  + 64 * (j))
#define XB_XSUB(j)  (1280 + 64 * (j))
#define XB_XGEN(j)  (2304 + 64 * (j))
#define XB_TOP      3328
#define XB_TOPGEN   3392
#define XCD_BAR_WORDS 3456
#define XB_SPIN_CAP (1u << 18)

__device__ __forceinline__ unsigned xb_ld(unsigned* p)              { return __hip_atomic_load(p, __ATOMIC_RELAXED, __HIP_MEMORY_SCOPE_AGENT); }
__device__ __forceinline__ unsigned xb_add(unsigned* p, unsigned v) { return __hip_atomic_fetch_add(p, v, __ATOMIC_RELAXED, __HIP_MEMORY_SCOPE_AGENT); }
__device__ __forceinline__ unsigned xb_xcc_id() { return (unsigned)__builtin_amdgcn_s_getreg((3 << 11) | 20) & 0xFu; }
#define XB_SPIN(cond, bar) do { unsigned _sp = 0; while (cond) { __builtin_amdgcn_s_sleep(1); \
    if ((++_sp & 255u) == 0u) { if (xb_ld(&(bar)[XB_TMO])) break; if (_sp > XB_SPIN_CAP) { atomicAdd(&(bar)[XB_TMO], 1u); break; } } } } while (0)

struct XcdBarrier {
    unsigned* bar; unsigned x; unsigned gsize;
    volatile LAS unsigned* st;
};

__device__ __forceinline__ XcdBarrier xcd_barrier_post(unsigned* bar, volatile LAS unsigned* st, unsigned gsize) {
    XcdBarrier b; b.bar = bar; b.x = xb_xcc_id(); b.st = st; b.gsize = gsize;
    if (threadIdx.x == 0) (void)xb_add(&bar[XB_XCNT(b.x)], 1u);
    return b;
}
__device__ __forceinline__ void xcd_barrier_complete(unsigned* bar, unsigned x, unsigned G, unsigned& nloc, unsigned& nx) {
    unsigned sum, cnt, mine, sp = 0u;
    for (;;) {
        sum = 0u; cnt = 0u; mine = 0u;
#pragma unroll
        for (unsigned j = 0; j < 16; ++j) { const unsigned c = xb_ld(&bar[XB_XCNT(j)]); sum += c; cnt += (c > 0u) ? 1u : 0u; mine = (j == x) ? c : mine; }
        if (sum == G) break;
        __builtin_amdgcn_s_sleep(1);
        if ((++sp & 255u) == 0u) { if (xb_ld(&bar[XB_TMO])) break; if (sp > XB_SPIN_CAP) { atomicAdd(&bar[XB_TMO], 1u); break; } }
    }
    nloc = mine > 0u ? mine : 1u; nx = cnt > 0u ? cnt : 1u;
}

__device__ __forceinline__ void xcd_barrier(const XcdBarrier& b) {
    asm volatile("s_waitcnt vmcnt(0)" ::: "memory");
    __syncthreads();
    if (threadIdx.x == 0) {
        unsigned* bar = b.bar;
        __builtin_amdgcn_s_waitcnt(0);
        unsigned nloc = b.st[0], nx = b.st[1];
        if (nloc == 0u) { xcd_barrier_complete(bar, b.x, b.gsize, nloc, nx); b.st[0] = nloc; b.st[1] = nx; }
        const unsigned old = xb_add(&bar[XB_XSUB(b.x)], 1u);
        const unsigned gen = old / nloc;
        if (old + 1u == (gen + 1u) * nloc) {
            __builtin_amdgcn_fence(__ATOMIC_RELEASE, "agent");
            asm volatile("s_waitcnt vmcnt(0)" ::: "memory");
            const unsigned og = xb_add(&bar[XB_TOP], 1u);
            const unsigned tg = og / nx;
            if (og + 1u == (tg + 1u) * nx) xb_add(&bar[XB_TOPGEN], 1u);
            else XB_SPIN(xb_ld(&bar[XB_TOPGEN]) == tg, bar);
            __builtin_amdgcn_fence(__ATOMIC_ACQUIRE, "agent");
            xb_add(&bar[XB_XGEN(b.x)], 1u);
            asm volatile("s_waitcnt vmcnt(0)" ::: "memory");
        } else {
            XB_SPIN(xb_ld(&bar[XB_XGEN(b.x)]) == gen, bar);
            __builtin_amdgcn_fence(__ATOMIC_ACQUIRE, "agent");
            asm volatile("s_waitcnt vmcnt(0)" ::: "memory");
        }
    }
    __syncthreads();
}

struct GroupOrder {
    int nN, k, xh, cph, nunits;
    __device__ void init(int N, int k_, int xh_, int cph_) { nN = N / 256; k = k_; xh = xh_; cph = cph_; nunits = 16 * nN; }
    __device__ bool next(int i, pg8::Unit& u) const { const int L = i * cph + k; if (L >= nunits) return false; const int nig = 8 * nN, gid = L / nig, w = L % nig; u.pm = 16 * xh + 8 * gid + (w & 7); u.pn = w >> 3; return true; }
    __device__ __forceinline__ void a_ready(const pg8::Unit&) const {}
    __device__ __forceinline__ void done(const pg8::Unit&) const {}
};

typedef const f32x4 (&AccRef)[2][2][4][2];
__device__ __forceinline__ float modv(const float* macc, const float* b_ada, int b, int j) { return macc[b * MODW + j] + b_ada[j]; }
__device__ __forceinline__ f32x4 modv4(const float* macc, const float* b_ada, int b, int j) { return *(const f32x4*)(macc + b * MODW + j) + *(const f32x4*)(b_ada + j); }

struct EpiProj {
    static constexpr bool PERM = true, PERMA = false, AFTER_DRAIN = false, PREFETCH = false;
    bf16* O; float* hss; float asc; int pm0;
    __device__ __forceinline__ void operator()(AccRef acc, const pg8::Unit& u, int wr, int wc, int fr, int fq) const {
        const int row0 = u.pm * 256 + wr * 64 + fr, col0 = u.pn * 256 + wc * 32 + 8 * fq;
#pragma unroll
        for (int ai = 0; ai < 2; ++ai)
#pragma unroll
            for (int m = 0; m < 4; ++m) { bf16* rowp = O + (size_t)(row0 + ai * 128 + m * 16) * INW + col0;
#pragma unroll
                for (int bj = 0; bj < 2; ++bj) { const f32x4 v0 = acc[ai][bj][m][0], v1 = acc[ai][bj][m][1];
                    v4u w; w.x = cvt_pk(v0[0], v0[1]); w.y = cvt_pk(v0[2], v0[3]); w.z = cvt_pk(v1[0], v1[1]); w.w = cvt_pk(v1[2], v1[3]);
                    *(v4u*)(rowp + bj * 128) = w; } }
        if (u.pn < 4) {
#pragma unroll
            for (int ai = 0; ai < 2; ++ai)
#pragma unroll
                for (int m = 0; m < 4; ++m)
#pragma unroll
                    for (int bj = 0; bj < 2; ++bj) { const f32x4 v0 = acc[ai][bj][m][0], v1 = acc[ai][bj][m][1];
                        float s = ((v0[0] * v0[0] + v0[1] * v0[1]) + (v0[2] * v0[2] + v0[3] * v0[3])) + ((v1[0] * v1[0] + v1[1] * v1[1]) + (v1[2] * v1[2] + v1[3] * v1[3]));
                        s += __shfl_xor(s, 16); s += __shfl_xor(s, 32);
                        if (fq == 0) atomicAdd(hss + (size_t)(4 * u.pn + 2 * bj + (wc >> 1)) * MT + pm0 * 256 + row0 + ai * 128 + m * 16, s * asc); }
        }
    }
};
struct EpiOut {
    static constexpr bool PERM = true, PERMA = false, AFTER_DRAIN = false, PREFETCH = false;
    const float* xp; const float* xs; unsigned short* x1; bf16* xg2; float* rss2; const float* g1t; const float* G2t; float asc; int pm0;
    __device__ __forceinline__ void operator()(AccRef acc, const pg8::Unit& u, int wr, int wc, int fr_, int fq_) const {
        int fr = fr_, fq = fq_; asm volatile("" : "+v"(fr), "+v"(fq));
        const int gpm = pm0 + u.pm, b = batch_of_tile(gpm), grow0 = gpm * 256 + wr * 64 + fr, cl = wc * 32 + 8 * fq;
        const char* xb = (const char*)(gpm * 256 < NPR ? xp + (size_t)gpm * 256 * D : xs + ((size_t)gpm * 256 - NPR) * D) + (size_t)u.pn * 1024;
        char* x1b = (char*)(x1 + (size_t)u.pm * 256 * D) + (size_t)u.pn * 512;
        char* xgb = (char*)(xg2 + ((size_t)(u.pm * 16 + u.pn * 4 + (wc >> 1)) << 14));
        const unsigned loff = (unsigned)(((wr * 64 + fr) * D + cl) * 4), xgl = (unsigned)(((wr * 64 + fr) * 64 + (wc & 1) * 32 + 8 * fq) * 2);
        float ss[2][4];
#pragma unroll
        for (int ai = 0; ai < 2; ++ai)
#pragma unroll
            for (int m = 0; m < 4; ++m) ss[ai][m] = 0.f;
        f32x4 xv[2][2][2], g1a[2][2], G2a[2][2];
#define EO_LOADG(bj) do { _Pragma("unroll") for (int n = 0; n < 2; ++n) { const int c_ = u.pn * 256 + (bj) * 128 + cl + 4 * n; g1a[bj][n] = *(const f32x4*)(g1t + b * D + c_); G2a[bj][n] = *(const f32x4*)(G2t + b * D + c_); } } while (0)
#define EO_LOADB(k) do { _Pragma("unroll") for (int mm = 0; mm < 2; ++mm) { const char* xr = xb + (size_t)(((((k) >> 1) & 1) * 128 + (2 * ((k) & 1) + mm) * 16) * D + ((k) >> 2) * 128) * 4; \
            xv[(k) & 1][mm][0] = *(const f32x4*)(xr + loff); xv[(k) & 1][mm][1] = *(const f32x4*)(xr + 16 + loff); } } while (0)
        EO_LOADG(0); EO_LOADB(0);
#pragma unroll
        for (int k = 0; k < 8; ++k) {
            const int bj = k >> 2, ai = (k >> 1) & 1;
            if (k + 1 < 8) EO_LOADB(k + 1);
            if (k == 3) EO_LOADG(1);
            asm volatile("" ::: "memory");
#pragma unroll
            for (int mm = 0; mm < 2; ++mm) { const int m = 2 * (k & 1) + mm;
                const f32x4 v0 = xv[k & 1][mm][0] + g1a[bj][0] * acc[ai][bj][m][0], v1 = xv[k & 1][mm][1] + g1a[bj][1] * acc[ai][bj][m][1];
                { v4u xw; xw.x = cvt_pk_h(v0[0], v0[1]); xw.y = cvt_pk_h(v0[2], v0[3]); xw.z = cvt_pk_h(v1[0], v1[1]); xw.w = cvt_pk_h(v1[2], v1[3]);
                  *(v4u*)(x1b + (size_t)((ai * 128 + m * 16) * D + bj * 128) * 2 + (loff >> 1)) = xw; }
                ss[ai][m] += ((v0[0] * v0[0] + v0[1] * v0[1]) + (v0[2] * v0[2] + v0[3] * v0[3])) + ((v1[0] * v1[0] + v1[1] * v1[1]) + (v1[2] * v1[2] + v1[3] * v1[3]));
                const f32x4 h0 = v0 * G2a[bj][0], h1 = v1 * G2a[bj][1]; v4u w; w.x = cvt_pk(h0[0], h0[1]); w.y = cvt_pk(h0[2], h0[3]); w.z = cvt_pk(h1[0], h1[1]); w.w = cvt_pk(h1[2], h1[3]);
                *(v4u*)(xgb + (size_t)((2 * bj) << 15) + (size_t)((ai * 128 + m * 16) * 128) + xgl) = w;
            }
            asm volatile("" ::: "memory");
        }
#undef EO_LOADG
#undef EO_LOADB
#pragma unroll
        for (int ai = 0; ai < 2; ++ai)
#pragma unroll
            for (int m = 0; m < 4; ++m) { float s = ss[ai][m]; s += __shfl_xor(s, 16); s += __shfl_xor(s, 32);
                if (fq == 0) atomicAdd(rss2 + grow0 + ai * 128 + m * 16, s * asc); }
    }
};
__device__ __forceinline__ float dpp_shr1(float old, float src) { return __builtin_bit_cast(float, __builtin_amdgcn_update_dpp(__builtin_bit_cast(int, old), __builtin_bit_cast(int, src), 0x111, 0xf, 0xf, false)); }
__device__ __forceinline__ float dpp_shl1(float old, float src) { return __builtin_bit_cast(float, __builtin_amdgcn_update_dpp(__builtin_bit_cast(int, old), __builtin_bit_cast(int, src), 0x101, 0xf, 0xf, false)); }
struct EpiConvAct {
    static constexpr bool PERM = true, PERMA = true, AFTER_DRAIN = false, PREFETCH = true;
    bf16* act; float* edge; const float* rss2; const float* c2; const float* convp; const float* cbp; LAS float* X; int pm0;
    __device__ __forceinline__ void prefetch(const pg8::Unit& u, int buf, int wid, int lane) const {
        if (wid < 6) {
            const int gpm = pm0 + u.pm, b = batch_of_tile(gpm);
            const float* src = wid == 0 ? rss2 + gpm * 256 : wid == 1 ? c2 + b * FF2 + u.pn * 256 : wid < 5 ? convp + (wid - 2) * FF2 + u.pn * 256 : cbp + u.pn * 256;
            __builtin_amdgcn_global_load_lds((const unsigned*)(src + 4 * lane), (LAS unsigned*)(X + 2048 + buf * 1536 + wid * 256), 16, 0, 0);
        }
    }
    __device__ __forceinline__ void run(f32x4 (&acc)[2][2][4][2], const pg8::Unit& u, int wr, int wc, int fr_, int fq_, int buf) const {
        int fr = fr_, fq = fq_; asm volatile("" : "+v"(fr), "+v"(fq));
        const int gpm = pm0 + u.pm, colL = wc * 32 + 8 * fq, colg = u.pn * 256 + colL;
        const LAS float* T = X + 2048 + buf * 1536; const LAS float* TB = T + 512;
        {   f32x4 rs[2];
#pragma unroll
            for (int ai = 0; ai < 2; ++ai) { const f32x4 q = *(const LAS f32x4*)(T + 128 * ai + 64 * wr + 4 * fr);
                rs[ai][0] = rsqrtf(q[0] * (1.0f / D) + EPS); rs[ai][1] = rsqrtf(q[1] * (1.0f / D) + EPS); rs[ai][2] = rsqrtf(q[2] * (1.0f / D) + EPS); rs[ai][3] = rsqrtf(q[3] * (1.0f / D) + EPS); }
#pragma unroll
            for (int bj = 0; bj < 2; ++bj)
#pragma unroll
                for (int n = 0; n < 2; ++n) { const f32x4 c2v = *(const LAS f32x4*)(T + 256 + 128 * bj + colL + 4 * n);
#pragma unroll
                    for (int ai = 0; ai < 2; ++ai)
#pragma unroll
                        for (int m = 0; m < 4; ++m) acc[ai][bj][m][n] = acc[ai][bj][m][n] * rs[ai][m] + c2v; } }
#pragma unroll
        for (int bj = 0; bj < 2; ++bj)
#pragma unroll
            for (int n = 0; n < 2; ++n)
#pragma unroll
                for (int ai = 0; ai < 2; ++ai) { const int rb = 2 * ai + wr;
                    if (fr == 0)  *(LAS f32x4*)(X + (rb * 2 + 0) * 256 + 128 * bj + colL + 4 * n) = acc[ai][bj][0][n];
                    if (fr == 15) *(LAS f32x4*)(X + (rb * 2 + 1) * 256 + 128 * bj + colL + 4 * n) = acc[ai][bj][3][n]; }
        asm volatile("s_waitcnt lgkmcnt(0)" ::: "memory"); __builtin_amdgcn_s_barrier(); asm volatile("" ::: "memory");
        if (wr == 0 && fr == 0) {
#pragma unroll
            for (int bj = 0; bj < 2; ++bj)
#pragma unroll
                for (int n = 0; n < 2; ++n) { float* ep = edge + ((size_t)gpm * 4 + 0) * FF2 + colg + 128 * bj + 4 * n; *(f32x4*)ep = acc[0][bj][0][n]; *(f32x4*)(ep + FF2) = acc[0][bj][1][n]; }
        }
        if (wr == 1 && fr == 15) {
#pragma unroll
            for (int bj = 0; bj < 2; ++bj)
#pragma unroll
                for (int n = 0; n < 2; ++n) { float* ep = edge + ((size_t)gpm * 4 + 2) * FF2 + colg + 128 * bj + 4 * n; *(f32x4*)ep = acc[1][bj][2][n]; *(f32x4*)(ep + FF2) = acc[1][bj][3][n]; }
        }
        typedef float f32x2 __attribute__((ext_vector_type(2)));
#pragma unroll
        for (int ai = 0; ai < 2; ++ai) { const int rb = 2 * ai + wr;
            unsigned pk[4][2][2];
#pragma unroll
            for (int n = 0; n < 2; ++n) {
#pragma unroll
                for (int eh = 0; eh < 2; ++eh) {
                    f32x2 sg[4];
#pragma unroll
                    for (int bj = 0; bj < 2; ++bj) { const int col = colg + 128 * bj + 4 * n + 2 * eh;
                        const int tcol = 128 * bj + colL + 4 * n + 2 * eh;
                        const f32x2 w0 = *(const LAS f32x2*)(TB + tcol), w1 = *(const LAS f32x2*)(TB + 256 + tcol), w2 = *(const LAS f32x2*)(TB + 512 + tcol), cb = *(const LAS f32x2*)(TB + 768 + tcol);
                        const int ia = rb > 0 ? (rb - 1) * 2 + 1 : 0, ib = rb < 3 ? (rb + 1) * 2 : 7;
                        const f32x2 above = *(const LAS f32x2*)(X + ia * 256 + 128 * bj + colL + 4 * n + 2 * eh);
                        const f32x2 below = *(const LAS f32x2*)(X + ib * 256 + 128 * bj + colL + 4 * n + 2 * eh);
                        f32x2 U0, U1, U2, U3;
                        U0[0] = acc[ai][bj][0][n][2 * eh]; U0[1] = acc[ai][bj][0][n][2 * eh + 1]; U1[0] = acc[ai][bj][1][n][2 * eh]; U1[1] = acc[ai][bj][1][n][2 * eh + 1];
                        U2[0] = acc[ai][bj][2][n][2 * eh]; U2[1] = acc[ai][bj][2][n][2 * eh + 1]; U3[0] = acc[ai][bj][3][n][2 * eh]; U3[1] = acc[ai][bj][3][n][2 * eh + 1];
                        f32x2 up0, dn3;
                        up0[0] = dpp_shr1(above[0], U3[0]); up0[1] = dpp_shr1(above[1], U3[1]); dn3[0] = dpp_shl1(below[0], U0[0]); dn3[1] = dpp_shl1(below[1], U0[1]);
                        f32x2 cv[4];
                        cv[0] = w0 * up0 + w1 * U0 + w2 * U1 + cb;
                        cv[1] = w0 * U0 + w1 * U1 + w2 * U2 + cb;
                        cv[2] = w0 * U1 + w1 * U2 + w2 * U3 + cb;
                        cv[3] = w0 * U2 + w1 * U3 + w2 * dn3 + cb;
                        if (bj == 0) {
#pragma unroll
                            for (int m = 0; m < 4; ++m)
#pragma unroll
                                for (int e = 0; e < 2; ++e) { const float g = cv[m][e]; sg[m][e] = g * __builtin_amdgcn_rcpf(1.0f + __builtin_amdgcn_exp2f(g * -1.4426950408889634f)); }
                        } else {
#pragma unroll
                            for (int m = 0; m < 4; ++m) { const f32x2 av = sg[m] * cv[m]; pk[m][n][eh] = cvt_pk(av[0], av[1]); }
                        }
                    }
                }
            }
#pragma unroll
            for (int m = 0; m < 4; ++m) { const int tr = 128 * ai + 64 * wr + 4 * fr + m; v4u w; w.x = pk[m][0][0]; w.y = pk[m][0][1]; w.z = pk[m][1][0]; w.w = pk[m][1][1];
                *(v4u*)(act + blk_off(u.pm * 256 + tr, u.pn * 128 + colL, FF)) = w; }
        }
    }
};
struct EpiDown {
    static constexpr bool PERM = true, PERMA = false, AFTER_DRAIN = false, PREFETCH = false;
    const unsigned short* x1; float* out; const float* g2t; int pm0;
    __device__ __forceinline__ void operator()(AccRef acc, const pg8::Unit& u, int wr, int wc, int fr_, int fq_) const {
        int fr = fr_, fq = fq_; asm volatile("" : "+v"(fr), "+v"(fq));
        const int gpm = pm0 + u.pm, b = batch_of_tile(gpm), cl = wc * 32 + 8 * fq;
        const char* xb = (const char*)(x1 + (size_t)u.pm * 256 * D) + (size_t)u.pn * 512;
        char* ob = (char*)(out + (size_t)gpm * 256 * D) + (size_t)u.pn * 1024;
        const unsigned loff = (unsigned)(((wr * 64 + fr) * D + cl) * 4);
        v4u xv[2][2][4];
#pragma unroll
        for (int bj = 0; bj < 2; ++bj)
#pragma unroll
            for (int ai = 0; ai < 2; ++ai)
#pragma unroll
                for (int m = 0; m < 4; ++m) xv[bj][ai][m] = *(const v4u*)(xb + (size_t)((ai * 128 + m * 16) * D + bj * 128) * 2 + (loff >> 1));
        f32x4 g2a[2][2];
#pragma unroll
        for (int bj = 0; bj < 2; ++bj)
#pragma unroll
            for (int n = 0; n < 2; ++n) g2a[bj][n] = *(const f32x4*)(g2t + b * D + u.pn * 256 + bj * 128 + cl + 4 * n);
        asm volatile("" ::: "memory");
#pragma unroll
        for (int bj = 0; bj < 2; ++bj) {
            const f32x4 g2[2] = {g2a[bj][0], g2a[bj][1]};
#pragma unroll
            for (int ai = 0; ai < 2; ++ai)
#pragma unroll
                for (int m = 0; m < 4; ++m) { char* orow = ob + (size_t)((ai * 128 + m * 16) * D + bj * 128) * 4; const v4u w = xv[bj][ai][m];
                    const f32x2_t a0 = h2f(w.x), a1 = h2f(w.y), a2 = h2f(w.z), a3 = h2f(w.w);
                    const f32x4 x0 = {a0[0], a0[1], a1[0], a1[1]}, x1v = {a2[0], a2[1], a3[0], a3[1]};
                    __builtin_nontemporal_store(x0 + g2[0] * acc[ai][bj][m][0], (f32x4*)(orow + loff)); __builtin_nontemporal_store(x1v + g2[1] * acc[ai][bj][m][1], (f32x4*)(orow + 16 + loff)); }
        }
    }
};

__device__ __forceinline__ void transpose_item(const float* W, int ldw, int k0, int n0, bf16* WT, int ldt, int drow0, int kd0, LAS float* scr, int lane) {
#pragma unroll 8
    for (int i = 0; i < 32; ++i) { const int kk = 2 * i + (lane >> 5); scr[kk * 33 + (lane & 31)] = W[(size_t)(k0 + kk) * ldw + n0 + (lane & 31)]; }
    LDS_WAIT(); asm volatile("" ::: "memory");
    const int c = lane & 7;
#pragma unroll
    for (int j = 0; j < 4; ++j) { const int n = (lane >> 3) + 8 * j; const LAS float* s = scr + (8 * c) * 33 + n;
        v4u o; o.x = pk2(s[0 * 33], s[1 * 33]); o.y = pk2(s[2 * 33], s[3 * 33]); o.z = pk2(s[4 * 33], s[5 * 33]); o.w = pk2(s[6 * 33], s[7 * 33]);
        *(v4u*)(WT + blk_off(drow0 + n, kd0 + 8 * c, ldt)) = o; }
    LDS_WAIT(); asm volatile("" ::: "memory");
}
template <class Fill> __device__ __forceinline__ void gemv10_item(const float* W, int ldw, int k0, int n, LAS float* sb, float* dst, int dstride, int dcol, float asc, const Fill& fill) {
    float w[64];
#pragma unroll
    for (int kk = 0; kk < 64; ++kk) w[kk] = W[(size_t)(k0 + kk) * ldw + n];
    fill(sb);
    LDS_WAIT(); asm volatile("" ::: "memory");
    float acc[NBATCH];
#pragma unroll
    for (int b = 0; b < NBATCH; ++b) acc[b] = 0.f;
#pragma unroll
    for (int kk = 0; kk < 64; ++kk) {
        const f32x4 s0 = *(const LAS f32x4*)(sb + kk * 12), s1 = *(const LAS f32x4*)(sb + kk * 12 + 4), s2 = *(const LAS f32x4*)(sb + kk * 12 + 8);
        acc[0] += w[kk] * s0[0]; acc[1] += w[kk] * s0[1]; acc[2] += w[kk] * s0[2]; acc[3] += w[kk] * s0[3];
        acc[4] += w[kk] * s1[0]; acc[5] += w[kk] * s1[1]; acc[6] += w[kk] * s1[2]; acc[7] += w[kk] * s1[3];
        acc[8] += w[kk] * s2[0]; acc[9] += w[kk] * s2[1];
    }
#pragma unroll
    for (int b = 0; b < NBATCH; ++b) atomicAdd(dst + (size_t)b * dstride + dcol, acc[b] * asc);
    LDS_WAIT(); asm volatile("" ::: "memory");
}

template <int HW> __device__ __forceinline__ void pool_group(const bf16* PROJ, bf16* CAT, int pbase, int T, int t0, int ch) {
    constexpr int NL = 2 * HW + 3;
    v4u x[NL];
#pragma unroll
    for (int i = 0; i < NL; ++i) { const int s = t0 - HW + i; const v4u z = {0u, 0u, 0u, 0u}; x[i] = (s >= 0 && s < T) ? *(const v4u*)(PROJ + (size_t)(pbase + s) * INW + 3 * ATTW + 8 * ch) : z; }
    float S[8];
#pragma unroll
    for (int c = 0; c < 8; ++c) S[c] = 0.f;
#define POOL_ADD(sgn, VV) do { S[0] += sgn bflo((VV).x); S[1] += sgn bfhi((VV).x); S[2] += sgn bflo((VV).y); S[3] += sgn bfhi((VV).y); S[4] += sgn bflo((VV).z); S[5] += sgn bfhi((VV).z); S[6] += sgn bflo((VV).w); S[7] += sgn bfhi((VV).w); } while (0)
#pragma unroll
    for (int i = 0; i < 2 * HW; ++i) POOL_ADD(+, x[i]);
#pragma unroll
    for (int k = 0; k < 4; ++k) {
        if (k > 0) { POOL_ADD(-, x[k - 1]); POOL_ADD(+, x[k - 1 + 2 * HW]); }
        const int t = t0 + k; const float ic = 1.0f / (float)(min(t + HW, T) - max(t - HW, 0)); const v4u w = x[HW + k];
        v4u ow; ow.x = pk2(S[0] * ic - bflo(w.x), S[1] * ic - bfhi(w.x)); ow.y = pk2(S[2] * ic - bflo(w.y), S[3] * ic - bfhi(w.y));
        ow.z = pk2(S[4] * ic - bflo(w.z), S[5] * ic - bfhi(w.z)); ow.w = pk2(S[6] * ic - bflo(w.w), S[7] * ic - bfhi(w.w));
        *(v4u*)(CAT + blk_off(pbase + t, ATTW + 8 * ch, D)) = ow;
    }
#undef POOL_ADD
}

struct Args { const float* in[19]; float* out; unsigned char* ws; int ph_lo, ph_hi, row0, nrows; };
enum { I_XP = 0, I_XS, I_CP, I_CS, I_WADA, I_BADA, I_N1G, I_N2G, I_WIN, I_QNG, I_KNG, I_RPB, I_WPOOL, I_PSCALE, I_WOUT, I_WUP, I_CONVW, I_CONVB, I_WDOWN };
constexpr int N_PHASES = 8;
#ifndef SW_PHASE
#define SW_PHASE -1
#endif
#ifndef SW_SEL
#define SW_SEL 0
#endif
#ifndef SW_SCALE
#define SW_SCALE 8
#endif
#define SW_PTR(k) ((SW_PHASE == (k) && blockIdx.x == 0) ? (volatile LAS unsigned*)(lds + LDSCTL_OFF + 64) : (volatile LAS unsigned*)nullptr)
#ifndef PROBE_MASK
#define PROBE_MASK 0
#endif
#ifndef PROBE_N
#define PROBE_N 0
#endif
#define PROBE_REPS(k) ((((PROBE_MASK) >> (k)) & 1) ? (PROBE_N) : 0)
#ifndef MK_ONE_LAUNCH
#define MK_ONE_LAUNCH 1
#endif

__global__ void __launch_bounds__(NWAVES * 64, 2) fwd(Args a) {
    extern __shared__ __attribute__((aligned(16))) unsigned char lds_raw[];
    LAS unsigned char* lds = (LAS unsigned char*)lds_raw;
    volatile LAS unsigned* MISC = (volatile LAS unsigned*)(lds + MISC_OFF);
    const int wave = __builtin_amdgcn_readfirstlane((int)threadIdx.x >> 6);
#define LANE_SETUP() int tid_ = threadIdx.x; asm volatile("" : "+v"(tid_)); const int tid = tid_, lane = tid & 63; (void)lane
    const int G = gridDim.x; const int bx = blockIdx.x; const int vcu = (bx % 8) * (G / 8) + bx / 8;
    const int gw = vcu * NWAVES + wave, NGW = G * NWAVES;
    const int grp = (bx & 7) >> 1, xh = bx & 1, gk = bx >> 3, cph = G >> 3, gsz = G >> 2, pm0 = GPANELS * grp;
    unsigned char* ws = a.ws;
    unsigned* ctl = (unsigned*)(ws + WS_CTL);
    float* macc = (float*)(ws + OFF_MOD); float* c2acc = (float*)(ws + OFF_C2); float* rss2 = (float*)(ws + OFF_RSS2); float* hss = (float*)(ws + OFF_HSS);
    bf16* WinT = (bf16*)(ws + WS_WIN); bf16* WoT = (bf16*)(ws + WS_WOUT); bf16* WupT = (bf16*)(ws + WS_WUP); bf16* WdT = (bf16*)(ws + WS_WDN);
    float* convp = (float*)(ws + WS_SMALL); float* cbp = convp + 3 * FF2;
    float* g1t = (float*)(ws + WS_SMALL + 131072); float* G2t = g1t + NBATCH * D; float* g2t = G2t + NBATCH * D;
    float* EDGE = (float*)(ws + WS_EDGE);
    unsigned char* slice = ws + WS_SLICE0 + (size_t)grp * WS_SLICE;
    bf16* H1g = (bf16*)(slice + SL_H1); bf16* PROJg = (bf16*)(slice + SL_PROJ); bf16* CATg = (bf16*)(slice + SL_CAT); unsigned short* X1g = (unsigned short*)(slice + SL_X1); bf16* XG2g = (bf16*)(slice + SL_XG2); bf16* ACTg = (bf16*)(slice + SL_ACT);
    const float* b_ada = a.in[I_BADA];

    for (int u = threadIdx.x; u < (LDS_BYTES - LDSCTL_OFF) / 4; u += NWAVES * 64) ((LAS unsigned*)(lds + LDSCTL_OFF))[u] = 0u;
    __syncthreads();
    XcdBarrier bar = xcd_barrier_post(ctl + CW_BAR, MISC + 8, (unsigned)G);
    XcdBarrier barg = xcd_barrier_post(ctl + CW_GBAR + grp * XCD_BAR_WORDS, MISC + 12, (unsigned)gsz);
#define IN(k) true
#define SEAM(k) do { if ((k) < 2) xcd_barrier(bar); else xcd_barrier(barg); } while (0)

    for (int rep = 0; rep <= PROBE_REPS(0); ++rep) { const float asc = rep ? 0.f : 1.f; (void)asc;
    if (IN(0)) {
        LANE_SETUP();
        LAS float* scr = (LAS float*)(lds + RING_OFF + wave * 16384);
        for (int it = gw; it < 16 * 96; it += NGW) {
            const int kc = it / 96, nc = it % 96, k = 64 * kc + lane;
            const float* cp = a.in[I_CP]; const float* cs = a.in[I_CS];
            gemv10_item(a.in[I_WADA], MODW, 64 * kc, 64 * nc + lane, scr, macc, MODW, 64 * nc + lane, asc, [=](LAS float* sb) {
#pragma unroll
                for (int b = 0; b < NBATCH; ++b) { const float c = b < 8 ? cp[b * D + k] : cs[(b - 8) * D + k]; sb[lane * 12 + b] = silu_f(c); } });
        }
    }
    if (rep < PROBE_REPS(0)) xcd_barrier(bar); }
    SEAM(0);

    for (int rep = 0; rep <= PROBE_REPS(1); ++rep) { const float asc = rep ? 0.f : 1.f; (void)asc;
    if (IN(1)) {
        LANE_SETUP();
        LAS float* scr = (LAS float*)(lds + RING_OFF + wave * 16384);
        constexpr int I0 = 16 * 64, I1 = I0 + 8 * 32, I2 = I1 + 16 * 176, I4 = I2 + 44 * 32, I5 = I4 + 4 * 16 * 16, I6 = I5 + 88, I7 = I6 + NBATCH * 16;
        for (int it = gw; it < I7; it += NGW) {
            if (it < I0) { const int kb = it / 64, nb = it % 64; transpose_item(a.in[I_WIN], INW, 64 * kb, 32 * nb, WinT, D, 32 * nb, 64 * kb, scr, lane); }
            else if (it < I1) { const int r = it - I0, kb = r / 32, nb = r % 32; transpose_item(a.in[I_WOUT], D, 64 * kb, 32 * nb, WoT, D, 32 * nb, 64 * kb, scr, lane); }
            else if (it < I2) { const int r = it - I1, kb = r / 176, nb = r % 176; transpose_item(a.in[I_WUP], FF2, 64 * kb, 32 * nb, WupT, D, permcol(32 * nb), 64 * kb, scr, lane);
                LAS float* sb2 = scr + 64 * 33 + 16;
#pragma unroll
                for (int b = 0; b < NBATCH; ++b) sb2[lane * 12 + b] = modv(macc, b_ada, b, 3 * D + 64 * kb + lane);
                LDS_WAIT(); asm volatile("" ::: "memory");
                const int cn = lane & 31, bh = 5 * (lane >> 5);
                float ac[5] = {0.f, 0.f, 0.f, 0.f, 0.f};
#pragma unroll 8
                for (int kk = 0; kk < 64; ++kk) { const float w = scr[kk * 33 + cn];
#pragma unroll
                    for (int i = 0; i < 5; ++i) ac[i] += w * sb2[kk * 12 + bh + i]; }
#pragma unroll
                for (int i = 0; i < 5; ++i) atomicAdd(c2acc + (size_t)(bh + i) * FF2 + permcol(32 * nb) + cn, ac[i] * asc);
                LDS_WAIT(); asm volatile("" ::: "memory"); }
            else if (it < I4) { const int r = it - I2, kb = r / 32, nb = r % 32; transpose_item(a.in[I_WDOWN], D, 64 * kb, 32 * nb, WdT, FF, 32 * nb, 64 * kb, scr, lane); }
            else if (it < I5) {
                const int r = it - I4, g = r / 256, cb = (r / 16) % 16, nb = r % 16, n = 64 * nb + lane;
                float acc[8];
#pragma unroll
                for (int i = 0; i < 8; ++i) acc[i] = 0.f;
                const float* wp = a.in[I_WPOOL] + (size_t)(g * 128 + 8 * cb) * 128;
#pragma unroll 8
                for (int d = 0; d < 128; ++d) {
                    const float wo = a.in[I_WOUT][(size_t)(ATTW + g * 128 + d) * D + n] * a.in[I_PSCALE][g * 128 + d];
#pragma unroll
                    for (int i = 0; i < 8; ++i) acc[i] += wp[i * 128 + d] * wo;
                }
                v4u o; o.x = pk2(acc[0], acc[1]); o.y = pk2(acc[2], acc[3]); o.z = pk2(acc[4], acc[5]); o.w = pk2(acc[6], acc[7]);
                *(v4u*)(WoT + blk_off(n, ATTW + g * 128 + 8 * cb, D)) = o;
            }
            else if (it < I6) { const int n = 64 * (it - I5) + lane, pc = permcol(n);
                convp[pc] = a.in[I_CONVW][n]; convp[FF2 + pc] = a.in[I_CONVW][FF2 + n]; convp[2 * FF2 + pc] = a.in[I_CONVW][2 * FF2 + n]; cbp[pc] = a.in[I_CONVB][n]; }
            else { const int r = it - I6, b = r / 16, j = 64 * (r % 16) + lane;
                g1t[b * D + j] = modv(macc, b_ada, b, 2 * D + j); G2t[b * D + j] = a.in[I_N2G][j] * (modv(macc, b_ada, b, 4 * D + j) + 1.0f); g2t[b * D + j] = modv(macc, b_ada, b, 5 * D + j); }
        }
        for (int r0 = gw * 16; r0 < MT; r0 += NGW * 16) {
            const int b = batch_of_row(r0);
            bf16* h1b = (bf16*)(ws + WS_SLICE0 + (size_t)(r0 / GROWS) * WS_SLICE + SL_H1);
            f32x4 Gv[4], Sv[4];
#pragma unroll
            for (int j = 0; j < 4; ++j) { const int c = 4 * lane + 256 * j; Gv[j] = *(const f32x4*)(a.in[I_N1G] + c) * (modv4(macc, b_ada, b, D + c) + 1.0f); Sv[j] = modv4(macc, b_ada, b, c); }
#pragma unroll 1
            for (int rr = 0; rr < 16; rr += 4) {
                f32x4 v[4][4]; float s[4];
#pragma unroll
                for (int q = 0; q < 4; ++q) { const int row = r0 + rr + q; const float* xrow = row < NPR ? a.in[I_XP] + (size_t)row * D : a.in[I_XS] + (size_t)(row - NPR) * D;
#pragma unroll
                    for (int j = 0; j < 4; ++j) v[q][j] = *(const f32x4*)(xrow + 4 * lane + 256 * j); }
#pragma unroll
                for (int q = 0; q < 4; ++q) { float t = 0.f;
#pragma unroll
                    for (int j = 0; j < 4; ++j) t += (v[q][j][0] * v[q][j][0] + v[q][j][1] * v[q][j][1]) + (v[q][j][2] * v[q][j][2] + v[q][j][3] * v[q][j][3]);
                    s[q] = t; }
#pragma unroll
                for (int o = 1; o < 64; o <<= 1) { s[0] += __shfl_xor(s[0], o); s[1] += __shfl_xor(s[1], o); s[2] += __shfl_xor(s[2], o); s[3] += __shfl_xor(s[3], o); }
#pragma unroll
                for (int q = 0; q < 4; ++q) { const int row = r0 + rr + q; const float rstd = rsqrtf(s[q] * (1.0f / D) + EPS);
#pragma unroll
                    for (int j = 0; j < 4; ++j) { const f32x4 h = v[q][j] * rstd * Gv[j] + Sv[j]; v2u w; w.x = pk2(h[0], h[1]); w.y = pk2(h[2], h[3]);
                        *(v2u*)(h1b + blk_off(row & (GROWS - 1), 4 * lane + 256 * j, D)) = w; } }
            }
        }
    }
    if (rep < PROBE_REPS(1)) xcd_barrier(bar); }
    SEAM(1);

#ifndef GROUP_SKEW_US
#define GROUP_SKEW_US 0
#endif
    if (GROUP_SKEW_US > 0 && grp > 0) {
        if (threadIdx.x == 0) { const unsigned long long t0 = __builtin_amdgcn_s_memrealtime(), tgt = (unsigned long long)(100 * GROUP_SKEW_US) * (unsigned)grp;
            while (__builtin_amdgcn_s_memrealtime() - t0 < tgt) __builtin_amdgcn_s_sleep(10); }
        __syncthreads();
    }
    for (int rep = 0; rep <= PROBE_REPS(2); ++rep) { const float asc = rep ? 0.f : 1.f; (void)asc;
    if (IN(2)) {
        pg8::Gemm g{H1g, WinT, GROWS, INW, D}; GroupOrder S; S.init(INW, gk, xh, cph);
        EpiProj E{PROJg, hss, asc, pm0};
        pg8::gemm_phase<EpiProj, GroupOrder, PG8_ALIGN, PG8_SP2>(lds + RING_OFF, g, S, E, SW_PTR(2));
    }
    if (rep < PROBE_REPS(2)) xcd_barrier(barg); }
    SEAM(2);

    for (int rep = 0; rep <= PROBE_REPS(3); ++rep) { const float asc = rep ? 0.f : 1.f; (void)asc;
    if (IN(3)) {
        LANE_SETUP();
        typedef short bf16x8 __attribute__((ext_vector_type(8)));
        typedef short s16x4 __attribute__((ext_vector_type(4)));
        LAS float* tbl = (LAS float*)(lds + BIAS_OFF);
        LAS float* rkr = (LAS float*)(lds + RK_OFF);
        const int fq = lane >> 4, l15 = lane & 15, tq = l15 >> 2, tp = lane & 3;
        const int j = wave & 3, kc0 = min(max(16 * j - 8, 0), 32);
        for (int task = xh * cph + gk; task < 64; task += 2 * cph) {
            int b, h, r0, rows;
            if (grp < 2) { b = 4 * grp + (task >> 4); h = (task >> 1) & 7; r0 = (task & 1) * 16; rows = 32; }
            else { b = 8 + (grp - 2); h = task >> 3; r0 = (task & 7) * 16; rows = 128; }
            const int base = b < 8 ? b * 2048 : NPR + (b - 8) * 8192;
            const int gbase = base - GROWS * grp;
            __syncthreads();
            { const int dr = tid >> 5, dc = tid & 31; tbl[tid] = (dr < 15 && dc < 31) ? a.in[I_RPB][h * 465 + dr * 31 + dc] * 1.4426950408889634f : -1e30f; }
            int dco[2][4];
            { const int qc = 16 * j + l15, cs = min(max(qc - 8, 0), 48);
#pragma unroll
              for (int cbk = 0; cbk < 2; ++cbk)
#pragma unroll
                  for (int e = 0; e < 4; ++e) { const int kc = kc0 + 16 * cbk + 4 * fq + e; dco[cbk][e] = 4 * ((kc >= cs && kc < cs + 16) ? (kc - qc + 15) : 31); } }
            const int koff0 = l15 * 128 + 16 * (fq ^ (l15 & 7)), koff1 = l15 * 128 + 16 * ((fq ^ (l15 & 7)) ^ 4);
            int voff[4];
#pragma unroll
            for (int db = 0; db < 4; ++db) voff[db] = (4 * fq + tq) * 128 + 16 * ((2 * db + (tp >> 1)) ^ (4 * (fq & 1) + tq)) + 8 * (tp & 1);
#define STAGE_ROW(kr) do { const int kr_ = (kr); const int slot_ = kr_ % 9; const int tc_ = 8 * wave + (lane >> 3), c16_ = (lane & 7) ^ (tc_ & 7); \
                const bf16* src_ = PROJg + (size_t)(gbase + kr_ * 64 + tc_) * INW + ATTW + h * 64 + 8 * c16_; \
                __builtin_amdgcn_global_load_lds((const unsigned*)src_, (LAS unsigned*)(lds + KRING_OFF + slot_ * 8192 + wave * 1024), 16, 0, 0); \
                __builtin_amdgcn_global_load_lds((const unsigned*)(src_ + ATTW), (LAS unsigned*)(lds + VRING_OFF + slot_ * 8192 + wave * 1024), 16, 0, 0); \
                if (wave == 4) rkr[slot_ * 64 + lane] = rsqrtf(hss[(size_t)(8 + h) * MT + base + kr_ * 64 + lane] * (1.0f / 64.0f) + EPS) * 1.4426950408889634f; } while (0)
            { const int lo0 = min(max(r0 - 4, 0), rows - 8);
              for (int kr = lo0; kr < lo0 + 8; ++kr) STAGE_ROW(kr); }
            const int pu0 = 128 * grp + 2 * task;
            v4u qraw[2] = {{0u, 0u, 0u, 0u}, {0u, 0u, 0u, 0u}}; float qss = 0.f;
            if (wave < 4) { const int qrow0 = base + r0 * 64 + 16 * j + l15; qss = hss[(size_t)h * MT + qrow0];
                qraw[0] = *(const v4u*)(PROJg + (size_t)(qrow0 - GROWS * grp) * INW + h * 64 + 8 * fq); qraw[1] = *(const v4u*)(PROJg + (size_t)(qrow0 - GROWS * grp) * INW + h * 64 + 32 + 8 * fq); }
#pragma unroll 1
            for (int st = 0; st < 16; ++st) {
                if (wave < 4 && st > 0) asm volatile("s_waitcnt vmcnt(4)" ::: "memory"); else VM_WAIT();
                LDS_WAIT(); __builtin_amdgcn_s_barrier(); asm volatile("" ::: "memory");
                const int r = r0 + st, rs = min(max(r - 4, 0), rows - 8);
                if (st < 15) { const int rsn = min(max(r + 1 - 4, 0), rows - 8); if (rsn != rs) STAGE_ROW(rsn + 7); }
                if (wave < 4) {
                    const int dr0 = rs - r + 7;
                    const int qrow = base + r * 64 + 16 * j + l15;
                    bf16x8 qf[2];
                    { const float rqs = rsqrtf(qss * (1.0f / 64.0f) + EPS) * 0.125f;
#pragma unroll
                      for (int ks = 0; ks < 2; ++ks) { const int d0 = 32 * ks + 8 * fq; const v4u w = qraw[ks];
                          const f32x4 g0 = *(const f32x4*)(a.in[I_QNG] + d0) * *(const f32x4*)(a.in[I_KNG] + d0) * rqs, g1 = *(const f32x4*)(a.in[I_QNG] + d0 + 4) * *(const f32x4*)(a.in[I_KNG] + d0 + 4) * rqs;
                          v4u o; o.x = pk2(bflo(w.x) * g0[0], bfhi(w.x) * g0[1]); o.y = pk2(bflo(w.y) * g0[2], bfhi(w.y) * g0[3]); o.z = pk2(bflo(w.z) * g1[0], bfhi(w.z) * g1[1]); o.w = pk2(bflo(w.w) * g1[2], bfhi(w.w) * g1[3]);
                          qf[ks] = __builtin_bit_cast(bf16x8, o); } }
                    if (st < 15) { qss = hss[(size_t)h * MT + qrow + 64]; qraw[0] = *(const v4u*)(PROJg + (size_t)(qrow + 64 - GROWS * grp) * INW + h * 64 + 8 * fq); qraw[1] = *(const v4u*)(PROJg + (size_t)(qrow + 64 - GROWS * grp) * INW + h * 64 + 32 + 8 * fq); }
                    f32x4 sc[16]; float mx = -3e38f;
                    bf16x8 kA[2][2], kB[2][2]; f32x4 rkv[2]; float bsv[2][4];
                    const LAS unsigned char* tba[2][4];
#pragma unroll
                    for (int cbk = 0; cbk < 2; ++cbk)
#pragma unroll
                        for (int e = 0; e < 4; ++e) tba[cbk][e] = (const LAS unsigned char*)(tbl + dr0 * 32) + dco[cbk][e];
#define ATT_LOAD_K(KF, i) do { const LAS unsigned char* kb_ = lds + KRING_OFF + ((rs + (i)) % 9) * 8192 + kc0 * 128; \
                        _Pragma("unroll") for (int cbk = 0; cbk < 2; ++cbk) { KF[cbk][0] = *(const LAS bf16x8*)(kb_ + cbk * 2048 + koff0); KF[cbk][1] = *(const LAS bf16x8*)(kb_ + cbk * 2048 + koff1); } } while (0)
#define ATT_LOAD_RB(i) do { const LAS float* rkb_ = rkr + ((rs + (i)) % 9) * 64 + kc0 + 4 * fq; \
                        _Pragma("unroll") for (int cbk = 0; cbk < 2; ++cbk) { rkv[cbk] = *(const LAS f32x4*)(rkb_ + 16 * cbk); \
                            bsv[cbk][0] = *(const LAS float*)(tba[cbk][0] + (i) * 128); bsv[cbk][1] = *(const LAS float*)(tba[cbk][1] + (i) * 128); bsv[cbk][2] = *(const LAS float*)(tba[cbk][2] + (i) * 128); bsv[cbk][3] = *(const LAS float*)(tba[cbk][3] + (i) * 128); } } while (0)
#define ATT_COMP_ROW(KF, i) do { f32x4 c_[2]; _Pragma("unroll") for (int cbk = 0; cbk < 2; ++cbk) { c_[cbk] = (f32x4){0.f, 0.f, 0.f, 0.f}; \
                            c_[cbk] = __builtin_amdgcn_mfma_f32_16x16x32_bf16(KF[cbk][0], qf[0], c_[cbk], 0, 0, 0); c_[cbk] = __builtin_amdgcn_mfma_f32_16x16x32_bf16(KF[cbk][1], qf[1], c_[cbk], 0, 0, 0); } \
                        _Pragma("unroll") for (int cbk = 0; cbk < 2; ++cbk) { \
                            f32x4 s; s[0] = c_[cbk][0] * rkv[cbk][0] + bsv[cbk][0]; s[1] = c_[cbk][1] * rkv[cbk][1] + bsv[cbk][1]; s[2] = c_[cbk][2] * rkv[cbk][2] + bsv[cbk][2]; s[3] = c_[cbk][3] * rkv[cbk][3] + bsv[cbk][3]; \
                            sc[2 * (i) + cbk] = s; mx = fmaxf(fmaxf(mx, fmaxf(s[0], s[1])), fmaxf(s[2], s[3])); } } while (0)
                    ATT_LOAD_K(kA, 0);
#pragma unroll
                    for (int i2 = 0; i2 < 4; ++i2) {
                        ATT_LOAD_K(kB, 2 * i2 + 1); ATT_LOAD_RB(2 * i2); __builtin_amdgcn_sched_barrier(0);
                        ATT_COMP_ROW(kA, 2 * i2);     __builtin_amdgcn_sched_barrier(0);
                        if (i2 < 3) { ATT_LOAD_K(kA, 2 * i2 + 2); } ATT_LOAD_RB(2 * i2 + 1); __builtin_amdgcn_sched_barrier(0);
                        ATT_COMP_ROW(kB, 2 * i2 + 1); __builtin_amdgcn_sched_barrier(0);
                    }
#undef ATT_LOAD_K
#undef ATT_LOAD_RB
#undef ATT_COMP_ROW
                    mx = fmaxf(mx, __shfl_xor(mx, 16)); mx = fmaxf(mx, __shfl_xor(mx, 32));
                    float lsum = 0.f;
#pragma unroll
                    for (int kb = 0; kb < 16; ++kb) { f32x4 e; e[0] = __builtin_amdgcn_exp2f(sc[kb][0] - mx); e[1] = __builtin_amdgcn_exp2f(sc[kb][1] - mx); e[2] = __builtin_amdgcn_exp2f(sc[kb][2] - mx); e[3] = __builtin_amdgcn_exp2f(sc[kb][3] - mx);
                        sc[kb] = e; lsum += (e[0] + e[1]) + (e[2] + e[3]); }
                    lsum += __shfl_xor(lsum, 16); lsum += __shfl_xor(lsum, 32);
                    f32x4 oacc[4];
#pragma unroll
                    for (int db = 0; db < 4; ++db) oacc[db] = (f32x4){0.f, 0.f, 0.f, 0.f};
                    s16x4 vaA[4], vbA[4], vaB[4], vbB[4];
#define ATT_LOAD_V(VA, VB, t) do { const LAS unsigned char* pA_ = lds + VRING_OFF + ((rs + (t)) % 9) * 8192 + kc0 * 128, * pB_ = pA_ + 2048; \
                        _Pragma("unroll") for (int db = 0; db < 4; ++db) { VA[db] = __builtin_bit_cast(s16x4, __builtin_amdgcn_ds_read_tr16_b64_v4i16((LAS s16x4*)(pA_ + voff[db]))); \
                            VB[db] = __builtin_bit_cast(s16x4, __builtin_amdgcn_ds_read_tr16_b64_v4i16((LAS s16x4*)(pB_ + voff[db]))); } } while (0)
#define ATT_COMP_V(VA, VB, t) do { const int kbA_ = 2 * (t), kbB_ = 2 * (t) + 1; \
                        v4u pw_; pw_.x = cvt_pk(sc[kbA_][0], sc[kbA_][1]); pw_.y = cvt_pk(sc[kbA_][2], sc[kbA_][3]); pw_.z = cvt_pk(sc[kbB_][0], sc[kbB_][1]); pw_.w = cvt_pk(sc[kbB_][2], sc[kbB_][3]); \
                        const bf16x8 pf_ = __builtin_bit_cast(bf16x8, pw_); \
                        _Pragma("unroll") for (int db = 0; db < 4; ++db) { bf16x8 vf_; vf_[0] = VA[db][0]; vf_[1] = VA[db][1]; vf_[2] = VA[db][2]; vf_[3] = VA[db][3]; vf_[4] = VB[db][0]; vf_[5] = VB[db][1]; vf_[6] = VB[db][2]; vf_[7] = VB[db][3]; \
                            oacc[db] = __builtin_amdgcn_mfma_f32_16x16x32_bf16(vf_, pf_, oacc[db], 0, 0, 0); } } while (0)
                    ATT_LOAD_V(vaA, vbA, 0);
#pragma unroll
                    for (int t2 = 0; t2 < 4; ++t2) {
                        ATT_LOAD_V(vaB, vbB, 2 * t2 + 1); __builtin_amdgcn_sched_barrier(0);
                        ATT_COMP_V(vaA, vbA, 2 * t2);     __builtin_amdgcn_sched_barrier(0);
                        if (t2 < 3) { ATT_LOAD_V(vaA, vbA, 2 * t2 + 2); } __builtin_amdgcn_sched_barrier(0);
                        ATT_COMP_V(vaB, vbB, 2 * t2 + 1); __builtin_amdgcn_sched_barrier(0);
                    }
#undef ATT_LOAD_V
#undef ATT_COMP_V
                    const float il = 1.0f / lsum;
#pragma unroll
                    for (int db = 0; db < 4; ++db) { v2u w; w.x = cvt_pk(oacc[db][0] * il, oacc[db][1] * il); w.y = cvt_pk(oacc[db][2] * il, oacc[db][3] * il);
                        *(v2u*)(CATg + blk_off(qrow - GROWS * grp, h * 64 + 16 * db + 4 * fq, D)) = w; }
                } else if ((st & 1) == 0) {
                    const int it = st >> 1, g = wave - 4, pu = pu0 + (it >> 2), tg = 4 * (it & 3) + (lane >> 4), ch = 16 * g + (lane & 15);
                    int pb, prr, prows;
                    if (pu < 256) { pb = pu >> 5; prr = pu & 31; prows = 32; } else { pb = 8 + ((pu - 256) >> 7); prr = (pu - 256) & 127; prows = 128; }
                    const int pbase = (pb < 8 ? pb * 2048 : NPR + (pb - 8) * 8192) - GROWS * grp, T = prows * 64, t0 = prr * 64 + 4 * tg;
                    if (g == 0) pool_group<1>(PROJg, CATg, pbase, T, t0, ch); else if (g == 1) pool_group<2>(PROJg, CATg, pbase, T, t0, ch);
                    else if (g == 2) pool_group<4>(PROJg, CATg, pbase, T, t0, ch); else pool_group<8>(PROJg, CATg, pbase, T, t0, ch);
                }
            }
#undef STAGE_ROW
        }
    }
    if (rep < PROBE_REPS(3)) xcd_barrier(barg); }
    SEAM(3);

    for (int rep = 0; rep <= PROBE_REPS(4); ++rep) { const float asc = rep ? 0.f : 1.f; (void)asc;
    if (IN(4)) {
        pg8::Gemm g{CATg, WoT, GROWS, D, D}; GroupOrder S; S.init(D, gk, xh, cph);
        EpiOut E{a.in[I_XP], a.in[I_XS], X1g, XG2g, rss2, g1t, G2t, asc, pm0};
        pg8::gemm_phase<EpiOut, GroupOrder, PG8_ALIGN, PG8_SP2>(lds + RING_OFF, g, S, E, SW_PTR(4));
    }
    if (rep < PROBE_REPS(4)) xcd_barrier(barg); }
    SEAM(4);

    for (int rep = 0; rep <= PROBE_REPS(5); ++rep) { const float asc = rep ? 0.f : 1.f; (void)asc;
    if (IN(5)) {
        pg8::Gemm g{XG2g, WupT, GROWS, FF2, D}; GroupOrder S; S.init(FF2, gk, xh, cph);
        EpiConvAct E{ACTg, EDGE, rss2, c2acc, convp, cbp, (LAS float*)(lds + XCH_OFF), pm0};
        pg8::gemm_phase<EpiConvAct, GroupOrder, PG8_ALIGN, PG8_SP2>(lds + RING_OFF, g, S, E, SW_PTR(5));
    }
    if (rep < PROBE_REPS(5)) xcd_barrier(barg); }
    SEAM(5);

    for (int rep = 0; rep <= PROBE_REPS(6); ++rep) { const float asc = rep ? 0.f : 1.f; (void)asc;
    if (IN(6)) {
        LANE_SETUP();
        for (int idx = (xh * cph + gk) * 512 + tid; idx < 2 * GPANELS * (FF / 8); idx += gsz * 512) {
            const int br = idx / (FF / 8), f = 8 * (idx % (FF / 8)), gcol = (f >> 7) * 256 + (f & 127);
            const int pm = pm0 + (br >> 1), last = br & 1, row = pm * 256 + (last ? 255 : 0);
            const int b = batch_of_row(row), t = row < NPR ? (row & 2047) : ((row - NPR) & 8191), T = b < 8 ? 2048 : 8192;
            const float* em; const float* e0; const float* ep;
            if (!last) { em = EDGE + ((size_t)(pm - 1) * 4 + 3) * FF2; e0 = EDGE + ((size_t)pm * 4 + 0) * FF2; ep = EDGE + ((size_t)pm * 4 + 1) * FF2; }
            else       { em = EDGE + ((size_t)pm * 4 + 2) * FF2; e0 = EDGE + ((size_t)pm * 4 + 3) * FF2; ep = EDGE + ((size_t)(pm + 1) * 4 + 0) * FF2; }
            const bool hm = t > 0, hp = t < T - 1;
            float res[2][8];
#pragma unroll
            for (int part = 0; part < 2; ++part) {
                const int col = gcol + 128 * part;
#pragma unroll
                for (int hh = 0; hh < 2; ++hh) {
                    const int c = col + 4 * hh; const f32x4 zero = {0.f, 0.f, 0.f, 0.f};
                    const f32x4 um = hm ? *(const f32x4*)(em + c) : zero, u0 = *(const f32x4*)(e0 + c), up = hp ? *(const f32x4*)(ep + c) : zero;
                    const f32x4 w0 = *(const f32x4*)(convp + c), w1 = *(const f32x4*)(convp + FF2 + c), w2 = *(const f32x4*)(convp + 2 * FF2 + c), cb = *(const f32x4*)(cbp + c);
                    const f32x4 r = w0 * um + w1 * u0 + w2 * up + cb;
                    res[part][4 * hh + 0] = r[0]; res[part][4 * hh + 1] = r[1]; res[part][4 * hh + 2] = r[2]; res[part][4 * hh + 3] = r[3];
                }
            }
            v4u ow; ow.x = pk2(silu_f(res[0][0]) * res[1][0], silu_f(res[0][1]) * res[1][1]); ow.y = pk2(silu_f(res[0][2]) * res[1][2], silu_f(res[0][3]) * res[1][3]);
            ow.z = pk2(silu_f(res[0][4]) * res[1][4], silu_f(res[0][5]) * res[1][5]); ow.w = pk2(silu_f(res[0][6]) * res[1][6], silu_f(res[0][7]) * res[1][7]);
            *(v4u*)(ACTg + blk_off(row - GROWS * grp, f, FF)) = ow;
        }
    }
    if (rep < PROBE_REPS(6)) xcd_barrier(barg); }
    SEAM(6);

    for (int rep = 0; rep <= PROBE_REPS(7); ++rep) { const float asc = rep ? 0.f : 1.f; (void)asc;
    if (IN(7)) {
        pg8::Gemm g{ACTg, WdT, GROWS, D, FF}; GroupOrder S; S.init(D, gk, xh, cph);
        EpiDown E{X1g, a.out, g2t, pm0};
        pg8::gemm_phase<EpiDown, GroupOrder, PG8_ALIGN, PG8_SP2>(lds + RING_OFF, g, S, E, SW_PTR(7));
    }
    if (rep < PROBE_REPS(7)) xcd_barrier(barg); }
    if (SW_PHASE >= 0 && blockIdx.x == 0 && threadIdx.x == 0) {
        const unsigned long long tgt = (unsigned long long)SW_SCALE * ((volatile LAS unsigned*)(lds + LDSCTL_OFF + 64))[SW_SEL], t0 = __builtin_amdgcn_s_memrealtime();
        while (__builtin_amdgcn_s_memrealtime() - t0 < tgt) __builtin_amdgcn_s_sleep(20);
    }
#undef IN
#undef SEAM
}

extern "C" void kernel_launch(void* const* d_in, const int* in_sizes, int n_in, void* d_out, int out_size, void* d_ws, size_t ws_size, hipStream_t stream) {
    static int grid = 0;
    if (grid == 0) {
        if (n_in != 19 || out_size != MT * D || ws_size < WS_END) { fprintf(stderr, "kernel_launch: unexpected shapes (n_in %d, out %d, ws %zu)\n", n_in, out_size, ws_size); grid = -1; return; }
        int dev = 0, cus = 0;
        if (hipGetDevice(&dev) != hipSuccess || hipDeviceGetAttribute(&cus, hipDeviceAttributeMultiprocessorCount, dev) != hipSuccess) { grid = -1; return; }
        if (hipFuncSetAttribute((const void*)fwd, hipFuncAttributeMaxDynamicSharedMemorySize, LDS_BYTES) != hipSuccess) { fprintf(stderr, "kernel_launch: hipFuncSetAttribute failed\n"); grid = -1; return; }
        int per_cu = 0;
        if (hipOccupancyMaxActiveBlocksPerMultiprocessor(&per_cu, (const void*)fwd, NWAVES * 64, LDS_BYTES) != hipSuccess || per_cu < 1) { fprintf(stderr, "kernel_launch: the occupancy query admits %d workgroups per CU; nothing launched\n", per_cu); grid = -1; return; }
        (void)hipGetLastError();
        grid = cus;
        if (grid % 8 != 0 || grid < 8) { fprintf(stderr, "kernel_launch: needs a multiple of 8 CUs (got %d)\n", grid); grid = -1; return; }
    }
    if (grid < 0) return;
    if (hipMemsetAsync((char*)d_ws + WS_CTL, 0, CTL_ZERO_BYTES, stream) != hipSuccess) return;
    Args a{};
    for (int i = 0; i < 19; ++i) a.in[i] = (const float*)d_in[i];
    a.out = (float*)d_out; a.ws = (unsigned char*)d_ws;
    a.ph_lo = 0; a.ph_hi = N_PHASES; a.row0 = 0; a.nrows = 0;
    hipLaunchKernelGGL(fwd, dim3(grid), dim3(NWAVES * 64), LDS_BYTES, stream, a);
}
```

```cpp
#include <hip/hip_runtime.h>
#include <cstdio>
#include <cstdint>

constexpr int D = 1024, MT = 32768, NPR = 16384, INW = 2048, ATTW = 512, HD = 64, NH = 8, FF = 2816, FF2 = 5632, NBATCH = 10, MODW = 6144;
constexpr float EPS = 1e-6f;

namespace pg8 {
#define PG8_LAS __attribute__((address_space(3)))
typedef unsigned short bf16_t;
typedef short bf16x8 __attribute__((ext_vector_type(8)));
typedef float f32x4 __attribute__((ext_vector_type(4)));
typedef unsigned u32x4 __attribute__((ext_vector_type(4)));
constexpr int BM = 256, BK = 64, HALF = 128, HTB = HALF * BK * 2  , STAGE_BYTES = 8 * HTB, NXCD = 8, WGM = 8;

__host__ __device__ __forceinline__ int lds_byte(int r, int c) { const int st = (r >> 4) * 2 + (c >> 5), rr = r & 15, cc = c & 31, ob = rr * 64 + cc * 2; return st * 1024 + (ob ^ (((ob >> 9) & 1) << 5)); }
__host__ __device__ __forceinline__ void stage_rc(int b, int& R, int& C) { const int st = b / 1024, sb = b % 1024, swz = sb ^ (((sb >> 9) & 1) << 5); R = (st >> 1) * 16 + swz / 64; C = (st & 1) * 32 + (swz % 64) / 2; }
__host__ __device__ __forceinline__ int perm32(int rho) { const int n = rho >> 4, i = rho & 15; return 8 * (i >> 2) + 4 * n + (i & 3); }

struct Unit { int pm, pn; };
struct Gemm { const bf16_t* A; const bf16_t* Bt; int M, N, K; };

struct StaticOrder {
    int nM, nN, nwg, G, c;
    __host__ __device__ void init(int M, int N, int G_, int c_) { nM = M / BM; nN = N / BM; nwg = nM * nN; G = G_; c = c_; }
    __host__ __device__ bool next(int i, Unit& u) const {
        const long L = (long)i * G + c; if (L >= nwg) return false;
        int wgid = (int)L; { const int q = nwg / NXCD, r = nwg % NXCD, xcd = wgid % NXCD, off = wgid / NXCD; wgid = (xcd < r ? xcd * (q + 1) : r * (q + 1) + (xcd - r) * q) + off; }
        const int nig = WGM * nN, gid = wgid / nig, fm = gid * WGM, gsz = (nM - fm) < WGM ? (nM - fm) : WGM;
        u.pm = fm + ((wgid % nig) % gsz); u.pn = (wgid % nig) / gsz; return true;
    }
    __device__ __forceinline__ void a_ready(const Unit&) const {}
    __device__ __forceinline__ void done(const Unit&) const {}
};

template <class Epi, class Sched, bool ALIGN_EPI = false, bool SP2 = false>
__device__ __forceinline__ void gemm_phase(PG8_LAS unsigned char* lds, const Gemm g, const Sched& S, const Epi& E, volatile PG8_LAS unsigned* sw = nullptr) {
    unsigned long long sw_t = 0;
    int tid_ = threadIdx.x; asm volatile("" : "+v"(tid_));
    const int tid = tid_, wid = __builtin_amdgcn_readfirstlane(tid >> 6), lane = tid & 63, wr = wid >> 2, wc = wid & 3, fr = lane & 15, fq = lane >> 4;
    const int K = g.K, nt = K / BK;
    unsigned voffA[2], voffB[2];
#pragma unroll
    for (int i = 0; i < 2; ++i) { int R, C; stage_rc(tid * 16 + i * 8192, R, C); const int Rb = Epi::PERM ? ((R & ~31) + perm32(R & 31)) : R;
        const int Ra = Epi::PERMA ? ((R & 64) + 4 * (R & 15) + ((R >> 4) & 3)) : R;
        voffA[i] = (unsigned)(Ra * BK + C) * 2u; voffB[i] = (unsigned)(Rb * BK + C) * 2u; }
    const size_t kstep = (size_t)(BM * BK * 2);
    const size_t hstep = (size_t)HALF * BK * 2;
    const size_t tstep = (size_t)K * BM * 2;
    const unsigned ldsw = (unsigned)wid * 1024u;
    const int aoff = lds_byte(wr * 64 + fr, fq * 8), boff = lds_byte(wc * 32 + fr, fq * 8);
#define PG8_SA(b, h) (((b) * 2 + (h)) * HTB)
#define PG8_SB(b, h) ((4 + (b) * 2 + (h)) * HTB)
#define PG8_STAGE(bufoff, gbase, voff) do { _Pragma("unroll") for (int _i = 0; _i < 2; ++_i) \
        __builtin_amdgcn_global_load_lds((const unsigned*)((const char*)(gbase) + (voff)[_i]), (PG8_LAS unsigned*)(lds + (bufoff) + ldsw + _i * 8192), 16, 0, 0); } while (0)
#define PG8_LDA(dst, b, h) do { _Pragma("unroll") for (int m = 0; m < 4; ++m) _Pragma("unroll") for (int k = 0; k < 2; ++k) dst[m][k] = *(const PG8_LAS bf16x8*)(lds + PG8_SA(b, h) + aoff + m * 2048 + k * 1024); } while (0)
#define PG8_LDB(dst, b, h) do { _Pragma("unroll") for (int n = 0; n < 2; ++n) _Pragma("unroll") for (int k = 0; k < 2; ++k) dst[n][k] = *(const PG8_LAS bf16x8*)(lds + PG8_SB(b, h) + boff + n * 2048 + k * 1024); } while (0)
#define PG8_MMA(ai, bj, At, Bt) do { __builtin_amdgcn_s_setprio(1); _Pragma("unroll") for (int m = 0; m < 4; ++m) _Pragma("unroll") for (int n = 0; n < 2; ++n) _Pragma("unroll") for (int k = 0; k < 2; ++k) \
        acc[ai][bj][m][n] = __builtin_amdgcn_mfma_f32_16x16x32_bf16(Bt[n][k], At[m][k], acc[ai][bj][m][n], 0, 0, 0); __builtin_amdgcn_s_setprio(0); } while (0)
#define PG8_WAIT_V(n) asm volatile("s_waitcnt vmcnt(" #n ")" ::: "memory")
#define PG8_WAIT_L(n) asm volatile("s_waitcnt lgkmcnt(" #n ")" ::: "memory")
#define PG8_BAR __builtin_amdgcn_s_barrier()
#define PG8_SCHED __builtin_amdgcn_sched_barrier(0)
    Unit cur, nxt; int ui = 0;
    if (!S.next(0, cur)) return;
    if constexpr (Epi::PREFETCH) E.prefetch(cur, 0, wid, lane);
    f32x4 acc[2][2][4][2];
#pragma unroll
    for (int a = 0; a < 2; ++a)
#pragma unroll
        for (int b = 0; b < 2; ++b)
#pragma unroll
            for (int m = 0; m < 4; ++m)
#pragma unroll
                for (int n = 0; n < 2; ++n) acc[a][b][m][n] = (f32x4){0.f, 0.f, 0.f, 0.f};
    bf16x8 At[4][2], B0[2][2], B1[2][2];
    const char* cA = (const char*)g.A + (size_t)cur.pm * tstep; const char* cB = (const char*)g.Bt + (size_t)cur.pn * tstep;
    S.a_ready(cur);
    if constexpr (SP2) {
        PG8_STAGE(PG8_SB(0, 0), cB, voffB); PG8_STAGE(PG8_SB(0, 1), cB + hstep, voffB); PG8_STAGE(PG8_SA(0, 0), cA, voffA); PG8_STAGE(PG8_SA(0, 1), cA + hstep, voffA);
        if (wr == 1) PG8_BAR;
        PG8_WAIT_V(2); PG8_BAR;
        PG8_STAGE(PG8_SB(1, 0), cB + kstep, voffB); PG8_STAGE(PG8_SA(1, 0), cA + kstep, voffA); PG8_STAGE(PG8_SB(1, 1), cB + hstep + kstep, voffB);
        PG8_WAIT_V(6); PG8_BAR;
    } else {
        PG8_STAGE(PG8_SB(0, 0), cB, voffB); PG8_STAGE(PG8_SA(0, 0), cA, voffA); PG8_STAGE(PG8_SB(0, 1), cB + hstep, voffB); PG8_STAGE(PG8_SA(0, 1), cA + hstep, voffA);
        if (wr == 1) PG8_BAR;
        PG8_WAIT_V(4); PG8_BAR;
        PG8_STAGE(PG8_SB(1, 0), cB + kstep, voffB); PG8_STAGE(PG8_SA(1, 0), cA + kstep, voffA); PG8_STAGE(PG8_SB(1, 1), cB + hstep + kstep, voffB);
        PG8_WAIT_V(6); PG8_BAR;
    }
    for (;;) {
        if (sw) { __builtin_amdgcn_sched_barrier(0); sw_t = __builtin_amdgcn_s_memrealtime(); __builtin_amdgcn_sched_barrier(0); }
        const bool has_next = S.next(ui + 1, nxt);
        const char* nA = has_next ? (const char*)g.A + (size_t)nxt.pm * tstep : cA; const char* nB = has_next ? (const char*)g.Bt + (size_t)nxt.pn * tstep : cB;
        for (int t = 0; t < nt; t += 2) {
            const bool last = (t == nt - 2);
            const char* a1 = cA + (size_t)(t + 1) * kstep;
            const char* a2 = last ? nA : cA + (size_t)(t + 2) * kstep; const char* b2 = last ? nB : cB + (size_t)(t + 2) * kstep;
            const char* a3 = a2 + kstep; const char* b3 = b2 + kstep;
            if (last && has_next) S.a_ready(nxt);
            if constexpr (SP2) {
            PG8_LDB(B0, 0, 0); PG8_LDB(B1, 0, 1); PG8_SCHED; PG8_LDA(At, 0, 0); PG8_STAGE(PG8_SA(1, 1), a1 + hstep, voffA);
            PG8_WAIT_V(8); PG8_WAIT_L(0); PG8_BAR; PG8_MMA(0, 0, At, B0); PG8_MMA(0, 1, At, B1); PG8_BAR; PG8_SCHED;
            PG8_LDA(At, 0, 1); PG8_STAGE(PG8_SB(0, 0), b2, voffB); PG8_STAGE(PG8_SB(0, 1), b2 + hstep, voffB); PG8_STAGE(PG8_SA(0, 0), a2, voffA);
            PG8_WAIT_V(8); PG8_WAIT_L(0); PG8_BAR; PG8_MMA(1, 0, At, B0); PG8_MMA(1, 1, At, B1); PG8_BAR; PG8_SCHED;
            PG8_LDB(B0, 1, 0); PG8_LDB(B1, 1, 1); PG8_SCHED; PG8_LDA(At, 1, 0); PG8_STAGE(PG8_SA(0, 1), a2 + hstep, voffA);
            PG8_WAIT_V(8); PG8_WAIT_L(0); PG8_BAR; PG8_MMA(0, 0, At, B0); PG8_MMA(0, 1, At, B1); PG8_BAR; PG8_SCHED;
            PG8_LDA(At, 1, 1); PG8_STAGE(PG8_SB(1, 0), b3, voffB); PG8_STAGE(PG8_SB(1, 1), b3 + hstep, voffB); PG8_STAGE(PG8_SA(1, 0), a3, voffA);
            PG8_WAIT_V(8); PG8_WAIT_L(0); PG8_BAR; PG8_MMA(1, 0, At, B0); PG8_MMA(1, 1, At, B1); PG8_BAR; PG8_SCHED;
            } else {
            PG8_LDB(B0, 0, 0); PG8_SCHED; PG8_LDA(At, 0, 0); PG8_STAGE(PG8_SA(1, 1), a1 + hstep, voffA);
            PG8_WAIT_L(8); PG8_BAR; PG8_WAIT_L(0); PG8_MMA(0, 0, At, B0); PG8_BAR; PG8_SCHED;
            PG8_LDB(B1, 0, 1); PG8_STAGE(PG8_SB(0, 0), b2, voffB);
            PG8_BAR; PG8_WAIT_L(0); PG8_MMA(0, 1, At, B1); PG8_BAR;
            PG8_LDA(At, 0, 1); PG8_STAGE(PG8_SA(0, 0), a2, voffA);
            PG8_BAR; PG8_WAIT_L(0); PG8_MMA(1, 0, At, B0); PG8_BAR; PG8_SCHED;
            PG8_STAGE(PG8_SB(0, 1), b2 + hstep, voffB);
            PG8_WAIT_V(6); PG8_BAR; PG8_MMA(1, 1, At, B1); PG8_BAR;
            PG8_LDB(B0, 1, 0); PG8_SCHED; PG8_LDA(At, 1, 0); PG8_STAGE(PG8_SA(0, 1), a2 + hstep, voffA);
            PG8_WAIT_L(8); PG8_BAR; PG8_WAIT_L(0); PG8_MMA(0, 0, At, B0); PG8_BAR; PG8_SCHED;
            PG8_LDB(B1, 1, 1); PG8_STAGE(PG8_SB(1, 0), b3, voffB);
            PG8_BAR; PG8_WAIT_L(0); PG8_MMA(0, 1, At, B1); PG8_BAR;
            PG8_LDA(At, 1, 1); PG8_STAGE(PG8_SA(1, 0), a3, voffA);
            PG8_BAR; PG8_WAIT_L(0); PG8_MMA(1, 0, At, B0); PG8_BAR; PG8_SCHED;
            PG8_STAGE(PG8_SB(1, 1), b3 + hstep, voffB);
            PG8_WAIT_V(6); PG8_BAR; PG8_MMA(1, 1, At, B1); PG8_BAR;
            }
        }
        if constexpr (ALIGN_EPI) { if (wr == 0) PG8_BAR; }
        if (sw) { __builtin_amdgcn_sched_barrier(0); const unsigned long long t1 = __builtin_amdgcn_s_memrealtime(); if (threadIdx.x == 0) sw[0] += (unsigned)(t1 - sw_t); sw_t = t1; __builtin_amdgcn_sched_barrier(0); }
        if constexpr (Epi::PREFETCH) { E.run(acc, cur, wr, wc, fr, fq, ui & 1); if (has_next) E.prefetch(nxt, (ui + 1) & 1, wid, lane); S.done(cur); }
        else if constexpr (!Epi::AFTER_DRAIN) { E(acc, cur, wr, wc, fr, fq); S.done(cur); }
        if (sw) { __builtin_amdgcn_sched_barrier(0); const unsigned long long t1 = __builtin_amdgcn_s_memrealtime(); if (threadIdx.x == 0) sw[1] += (unsigned)(t1 - sw_t); __builtin_amdgcn_sched_barrier(0); }
        if (!has_next) break;
#pragma unroll
        for (int a = 0; a < 2; ++a)
#pragma unroll
            for (int b = 0; b < 2; ++b)
#pragma unroll
                for (int m = 0; m < 4; ++m)
#pragma unroll
                    for (int n = 0; n < 2; ++n) acc[a][b][m][n] = (f32x4){0.f, 0.f, 0.f, 0.f};
        cur = nxt; cA = nA; cB = nB; ++ui;
        if constexpr (ALIGN_EPI) { if (wr == 1) PG8_BAR; }
    }
    PG8_WAIT_V(0);
    if constexpr (!ALIGN_EPI) { if (wr == 0) PG8_BAR; }
    PG8_BAR;
    if constexpr (Epi::AFTER_DRAIN) { E.fused(acc, cur, wr, wc, fr, fq, lds, wid, lane); S.done(cur); }
#undef PG8_SA
#undef PG8_SB
#undef PG8_STAGE
#undef PG8_LDA
#undef PG8_LDB
#undef PG8_MMA
#undef PG8_WAIT_V
#undef PG8_WAIT_L
#undef PG8_BAR
#undef PG8_SCHED
}
}
#ifndef PG8_SP2
#define PG8_SP2 true
#endif
#ifndef PG8_ALIGN
#define PG8_ALIGN true
#endif
constexpr size_t MiB = 1u << 20;
constexpr size_t WS_CTL = 0, CTL_ZERO_BYTES = 3 * MiB;
constexpr size_t OFF_MOD = 131072, OFF_C2 = 393216, OFF_RSS2 = 622592, OFF_HSS = 1 * MiB;
constexpr size_t WS_WIN = 3 * MiB, WS_WOUT = 7 * MiB, WS_WUP = 9 * MiB, WS_WDN = 20 * MiB, WS_SMALL = 26 * MiB, WS_EDGE = 27 * MiB, WS_SLICE0 = 40 * MiB, WS_SLICE = 112 * MiB;
constexpr size_t SL_H1 = 0, SL_PROJ = 16 * MiB, SL_CAT = 48 * MiB, SL_XG2 = 64 * MiB, SL_X1 = 80 * MiB, SL_ACT = 0;
constexpr size_t WS_END = 512 * MiB;
constexpr int NGROUPS = 4, GROWS = MT / NGROUPS, GPANELS = GROWS / 256;
constexpr int CW_BAR = 4096, CW_GBAR = 8192;
constexpr int RING_OFF = 0, RING_BYTES = 131072;
constexpr int XCH_OFF = 131072;
constexpr int KRING_OFF = 0, VRING_OFF = 73728;
constexpr int BIAS_OFF = 147456, RK_OFF = 149504;
constexpr int LDSCTL_OFF = 155648, MISC_OFF = LDSCTL_OFF + 320, LDS_BYTES = 163840;
constexpr int NWAVES = 8;

#define GAS __attribute__((address_space(1)))
#define LAS __attribute__((address_space(3)))
typedef unsigned short bf16;
typedef unsigned v4u __attribute__((ext_vector_type(4)));
typedef unsigned v2u __attribute__((ext_vector_type(2)));
using pg8::f32x4;
#define LDS_WAIT() asm volatile("s_waitcnt lgkmcnt(0)" ::: "memory")
#define VM_WAIT() asm volatile("s_waitcnt vmcnt(0)" ::: "memory")
__device__ __forceinline__ unsigned f2bf(float f) { unsigned u = __builtin_bit_cast(unsigned, f); return (u + 0x7fffu + ((u >> 16) & 1u)) >> 16; }
__device__ __forceinline__ unsigned pk2(float lo, float hi) { return f2bf(lo) | (f2bf(hi) << 16); }
__device__ __forceinline__ float bflo(unsigned w) { return __builtin_bit_cast(float, w << 16); }
__device__ __forceinline__ float bfhi(unsigned w) { return __builtin_bit_cast(float, w & 0xffff0000u); }
typedef float f32x2_t __attribute__((ext_vector_type(2))); typedef __bf16 bf16x2_t __attribute__((ext_vector_type(2))); typedef _Float16 f16x2_t __attribute__((ext_vector_type(2)));
__device__ __forceinline__ unsigned cvt_pk_h(float lo, float hi) { f32x2_t v = {lo, hi}; f16x2_t h = __builtin_convertvector(v, f16x2_t); return __builtin_bit_cast(unsigned, h); }
__device__ __forceinline__ f32x2_t h2f(unsigned w) { return __builtin_convertvector(__builtin_bit_cast(f16x2_t, w), f32x2_t); }
__device__ __forceinline__ unsigned cvt_pk(float lo, float hi) { f32x2_t v = {lo, hi}; bf16x2_t b = __builtin_convertvector(v, bf16x2_t); return __builtin_bit_cast(unsigned, b); }
__device__ __forceinline__ size_t blk_off(int row, int col, int K) { return ((size_t)((row >> 8) * (K >> 6) + (col >> 6)) << 14) + (size_t)(((row & 255) << 6) + (col & 63)); }
__device__ __forceinline__ int batch_of_row(int row) { return row < NPR ? (row >> 11) : 8 + ((row - NPR) >> 13); }
__device__ __forceinline__ int batch_of_tile(int pm) { return pm < 64 ? (pm >> 3) : 8 + ((pm - 64) >> 5); }
__device__ __forceinline__ int permcol(int n) { const int f = n < FF ? n : n - FF; return (f >> 7) * 256 + (f & 127) + (n < FF ? 0 : 128); }
__device__ __forceinline__ float wave_sum(float v) {
#pragma unroll
    for (int o = 1; o < 64; o <<= 1) v += __shfl_xor(v, o);
    return v;
}
__device__ __forceinline__ float silu_f(float x) { return x / (1.0f + __expf(-x)); }

#define XB_TMO      128
#define XB_XCNT(j)  (256  + 64 * (j))
#define XB_XSUB(j)  (1280 + 64 * (j))
#define XB_XGEN(j)  (2304 + 64 * (j))
#define XB_TOP      3328
#define XB_TOPGEN   3392
#define XCD_BAR_WORDS 3456
#define XB_SPIN_CAP (1u << 18)

__device__ __forceinline__ unsigned xb_ld(unsigned* p)              { return __hip_atomic_load(p, __ATOMIC_RELAXED, __HIP_MEMORY_SCOPE_AGENT); }
__device__ __forceinline__ unsigned xb_add(unsigned* p, unsigned v) { return __hip_atomic_fetch_add(p, v, __ATOMIC_RELAXED, __HIP_MEMORY_SCOPE_AGENT); }
__device__ __forceinline__ unsigned xb_xcc_id() { return (unsigned)__builtin_amdgcn_s_getreg((3 << 11) | 20) & 0xFu; }
#define XB_SPIN(cond, bar) do { unsigned _sp = 0; while (cond) { __builtin_amdgcn_s_sleep(1); \
    if ((++_sp & 255u) == 0u) { if (xb_ld(&(bar)[XB_TMO])) break; if (_sp > XB_SPIN_CAP) { atomicAdd(&(bar)[XB_TMO], 1u); break; } } } } while (0)

struct XcdBarrier {
    unsigned* bar; unsigned x; unsigned gsize;
    volatile LAS unsigned* st;
};

__device__ __forceinline__ XcdBarrier xcd_barrier_post(unsigned* bar, volatile LAS unsigned* st, unsigned gsize) {
    XcdBarrier b; b.bar = bar; b.x = xb_xcc_id(); b.st = st; b.gsize = gsize;
    if (threadIdx.x == 0) (void)xb_add(&bar[XB_XCNT(b.x)], 1u);
    return b;
}
__device__ __forceinline__ void xcd_barrier_complete(unsigned* bar, unsigned x, unsigned G, unsigned& nloc, unsigned& nx) {
    unsigned sum, cnt, mine, sp = 0u;
    for (;;) {
        sum = 0u; cnt = 0u; mine = 0u;
#pragma unroll
        for (unsigned j = 0; j < 16; ++j) { const unsigned c = xb_ld(&bar[XB_XCNT(j)]); sum += c; cnt += (c > 0u) ? 1u : 0u; mine = (j == x) ? c : mine; }
        if (sum == G) break;
        __builtin_amdgcn_s_sleep(1);
        if ((++sp & 255u) == 0u) { if (xb_ld(&bar[XB_TMO])) break; if (sp > XB_SPIN_CAP) { atomicAdd(&bar[XB_TMO], 1u); break; } }
    }
    nloc = mine > 0u ? mine : 1u; nx = cnt > 0u ? cnt : 1u;
}

__device__ __forceinline__ void xcd_barrier(const XcdBarrier& b) {
    asm volatile("s_waitcnt vmcnt(0)" ::: "memory");
    __syncthreads();
    if (threadIdx.x == 0) {
        unsigned* bar = b.bar;
        __builtin_amdgcn_s_waitcnt(0);
        unsigned nloc = b.st[0], nx = b.st[1];
        if (nloc == 0u) { xcd_barrier_complete(bar, b.x, b.gsize, nloc, nx); b.st[0] = nloc; b.st[1] = nx; }
        const unsigned old = xb_add(&bar[XB_XSUB(b.x)], 1u);
        const unsigned gen = old / nloc;
        if (old + 1u == (gen + 1u) * nloc) {
            __builtin_amdgcn_fence(__ATOMIC_RELEASE, "agent");
            asm volatile("s_waitcnt vmcnt(0)" ::: "memory");
            const unsigned og = xb_add(&bar[XB_TOP], 1u);
            const unsigned tg = og / nx;
            if (og + 1u == (tg + 1u) * nx) xb_add(&bar[XB_TOPGEN], 1u);
            else XB_SPIN(xb_ld(&bar[XB_TOPGEN]) == tg, bar);
            __builtin_amdgcn_fence(__ATOMIC_ACQUIRE, "agent");
            xb_add(&bar[XB_XGEN(b.x)], 1u);
            asm volatile("s_waitcnt vmcnt(0)" ::: "memory");
        } else {
            XB_SPIN(xb_ld(&bar[XB_XGEN(b.x)]) == gen, bar);
            __builtin_amdgcn_fence(__ATOMIC_ACQUIRE, "agent");
            asm volatile("s_waitcnt vmcnt(0)" ::: "memory");
        }
    }
    __syncthreads();
}

struct GroupOrder {
    int nN, k, xh, cph, nunits;
    __device__ void init(int N, int k_, int xh_, int cph_) { nN = N / 256; k = k_; xh = xh_; cph = cph_; nunits = 16 * nN; }
    __device__ bool next(int i, pg8::Unit& u) const { const int L = i * cph + k; if (L >= nunits) return false; const int nig = 8 * nN, gid = L / nig, w = L % nig; u.pm = 16 * xh + 8 * gid + (w & 7); u.pn = w >> 3; return true; }
    __device__ __forceinline__ void a_ready(const pg8::Unit&) const {}
    __device__ __forceinline__ void done(const pg8::Unit&) const {}
};

typedef const f32x4 (&AccRef)[2][2][4][2];
__device__ __forceinline__ float modv(const float* macc, const float* b_ada, int b, int j) { return macc[b * MODW + j] + b_ada[j]; }
__device__ __forceinline__ f32x4 modv4(const float* macc, const float* b_ada, int b, int j) { return *(const f32x4*)(macc + b * MODW + j) + *(const f32x4*)(b_ada + j); }

struct EpiProj {
    static constexpr bool PERM = true, PERMA = false, AFTER_DRAIN = false, PREFETCH = false;
    bf16* O; float* hss; float asc; int pm0;
    __device__ __forceinline__ void operator()(AccRef acc, const pg8::Unit& u, int wr, int wc, int fr, int fq) const {
        const int row0 = u.pm * 256 + wr * 64 + fr, col0 = u.pn * 256 + wc * 32 + 8 * fq;
#pragma unroll
        for (int ai = 0; ai < 2; ++ai)
#pragma unroll
            for (int m = 0; m < 4; ++m) { bf16* rowp = O + (size_t)(row0 + ai * 128 + m * 16) * INW + col0;
#pragma unroll
                for (int bj = 0; bj < 2; ++bj) { const f32x4 v0 = acc[ai][bj][m][0], v1 = acc[ai][bj][m][1];
                    v4u w; w.x = cvt_pk(v0[0], v0[1]); w.y = cvt_pk(v0[2], v0[3]); w.z = cvt_pk(v1[0], v1[1]); w.w = cvt_pk(v1[2], v1[3]);
                    *(v4u*)(rowp + bj * 128) = w; } }
        if (u.pn < 4) {
#pragma unroll
            for (int ai = 0; ai < 2; ++ai)
#pragma unroll
                for (int m = 0; m < 4; ++m)
#pragma unroll
                    for (int bj = 0; bj < 2; ++bj) { const f32x4 v0 = acc[ai][bj][m][0], v1 = acc[ai][bj][m][1];
                        float s = ((v0[0] * v0[0] + v0[1] * v0[1]) + (v0[2] * v0[2] + v0[3] * v0[3])) + ((v1[0] * v1[0] + v1[1] * v1[1]) + (v1[2] * v1[2] + v1[3] * v1[3]));
                        s += __shfl_xor(s, 16); s += __shfl_xor(s, 32);
                        if (fq == 0) atomicAdd(hss + (size_t)(4 * u.pn + 2 * bj + (wc >> 1)) * MT + pm0 * 256 + row0 + ai * 128 + m * 16, s * asc); }
        }
    }
};
struct EpiOut {
    static constexpr bool PERM = true, PERMA = false, AFTER_DRAIN = false, PREFETCH = false;
    const float* xp; const float* xs; unsigned short* x1; bf16* xg2; float* rss2; const float* g1t; const float* G2t; float asc; int pm0;
    __device__ __forceinline__ void operator()(AccRef acc, const pg8::Unit& u, int wr, int wc, int fr_, int fq_) const {
        int fr = fr_, fq = fq_; asm volatile("" : "+v"(fr), "+v"(fq));
        const int gpm = pm0 + u.pm, b = batch_of_tile(gpm), grow0 = gpm * 256 + wr * 64 + fr, cl = wc * 32 + 8 * fq;
        const char* xb = (const char*)(gpm * 256 < NPR ? xp + (size_t)gpm * 256 * D : xs + ((size_t)gpm * 256 - NPR) * D) + (size_t)u.pn * 1024;
        char* x1b = (char*)(x1 + (size_t)u.pm * 256 * D) + (size_t)u.pn * 512;
        char* xgb = (char*)(xg2 + ((size_t)(u.pm * 16 + u.pn * 4 + (wc >> 1)) << 14));
        const unsigned loff = (unsigned)(((wr * 64 + fr) * D + cl) * 4), xgl = (unsigned)(((wr * 64 + fr) * 64 + (wc & 1) * 32 + 8 * fq) * 2);
        float ss[2][4];
#pragma unroll
        for (int ai = 0; ai < 2; ++ai)
#pragma unroll
            for (int m = 0; m < 4; ++m) ss[ai][m] = 0.f;
        f32x4 xv[2][2][2], g1a[2][2], G2a[2][2];
#define EO_LOADG(bj) do { _Pragma("unroll") for (int n = 0; n < 2; ++n) { const int c_ = u.pn * 256 + (bj) * 128 + cl + 4 * n; g1a[bj][n] = *(const f32x4*)(g1t + b * D + c_); G2a[bj][n] = *(const f32x4*)(G2t + b * D + c_); } } while (0)
#define EO_LOADB(k) do { _Pragma("unroll") for (int mm = 0; mm < 2; ++mm) { const char* xr = xb + (size_t)(((((k) >> 1) & 1) * 128 + (2 * ((k) & 1) + mm) * 16) * D + ((k) >> 2) * 128) * 4; \
            xv[(k) & 1][mm][0] = *(const f32x4*)(xr + loff); xv[(k) & 1][mm][1] = *(const f32x4*)(xr + 16 + loff); } } while (0)
        EO_LOADG(0); EO_LOADB(0);
#pragma unroll
        for (int k = 0; k < 8; ++k) {
            const int bj = k >> 2, ai = (k >> 1) & 1;
            if (k + 1 < 8) EO_LOADB(k + 1);
            if (k == 3) EO_LOADG(1);
            asm volatile("" ::: "memory");
#pragma unroll
            for (int mm = 0; mm < 2; ++mm) { const int m = 2 * (k & 1) + mm;
                const f32x4 v0 = xv[k & 1][mm][0] + g1a[bj][0] * acc[ai][bj][m][0], v1 = xv[k & 1][mm][1] + g1a[bj][1] * acc[ai][bj][m][1];
                { v4u xw; xw.x = cvt_pk_h(v0[0], v0[1]); xw.y = cvt_pk_h(v0[2], v0[3]); xw.z = cvt_pk_h(v1[0], v1[1]); xw.w = cvt_pk_h(v1[2], v1[3]);
                  *(v4u*)(x1b + (size_t)((ai * 128 + m * 16) * D + bj * 128) * 2 + (loff >> 1)) = xw; }
                ss[ai][m] += ((v0[0] * v0[0] + v0[1] * v0[1]) + (v0[2] * v0[2] + v0[3] * v0[3])) + ((v1[0] * v1[0] + v1[1] * v1[1]) + (v1[2] * v1[2] + v1[3] * v1[3]));
                const f32x4 h0 = v0 * G2a[bj][0], h1 = v1 * G2a[bj][1]; v4u w; w.x = cvt_pk(h0[0], h0[1]); w.y = cvt_pk(h0[2], h0[3]); w.z = cvt_pk(h1[0], h1[1]); w.w = cvt_pk(h1[2], h1[3]);
                *(v4u*)(xgb + (size_t)((2 * bj) << 15) + (size_t)((ai * 128 + m * 16) * 128) + xgl) = w;
            }
            asm volatile("" ::: "memory");
        }
#undef EO_LOADG
#undef EO_LOADB
#pragma unroll
        for (int ai = 0; ai < 2; ++ai)
#pragma unroll
            for (int m = 0; m < 4; ++m) { float s = ss[ai][m]; s += __shfl_xor(s, 16); s += __shfl_xor(s, 32);
                if (fq == 0) atomicAdd(rss2 + grow0 + ai * 128 + m * 16, s * asc); }
    }
};
__device__ __forceinline__ float dpp_shr1(float old, float src) { return __builtin_bit_cast(float, __builtin_amdgcn_update_dpp(__builtin_bit_cast(int, old), __builtin_bit_cast(int, src), 0x111, 0xf, 0xf, false)); }
__device__ __forceinline__ float dpp_shl1(float old, float src) { return __builtin_bit_cast(float, __builtin_amdgcn_update_dpp(__builtin_bit_cast(int, old), __builtin_bit_cast(int, src), 0x101, 0xf, 0xf, false)); }
struct EpiConvAct {
    static constexpr bool PERM = true, PERMA = true, AFTER_DRAIN = false, PREFETCH = true;
    bf16* act; float* edge; const float* rss2; const float* c2; const float* convp; const float* cbp; LAS float* X; int pm0;
    __device__ __forceinline__ void prefetch(const pg8::Unit& u, int buf, int wid, int lane) const {
        if (wid < 6) {
            const int gpm = pm0 + u.pm, b = batch_of_tile(gpm);
            const float* src = wid == 0 ? rss2 + gpm * 256 : wid == 1 ? c2 + b * FF2 + u.pn * 256 : wid < 5 ? convp + (wid - 2) * FF2 + u.pn * 256 : cbp + u.pn * 256;
            __builtin_amdgcn_global_load_lds((const unsigned*)(src + 4 * lane), (LAS unsigned*)(X + 2048 + buf * 1536 + wid * 256), 16, 0, 0);
        }
    }
    __device__ __forceinline__ void run(f32x4 (&acc)[2][2][4][2], const pg8::Unit& u, int wr, int wc, int fr_, int fq_, int buf) const {
        int fr = fr_, fq = fq_; asm volatile("" : "+v"(fr), "+v"(fq));
        const int gpm = pm0 + u.pm, colL = wc * 32 + 8 * fq, colg = u.pn * 256 + colL;
        const LAS float* T = X + 2048 + buf * 1536; const LAS float* TB = T + 512;
        {   f32x4 rs[2];
#pragma unroll
            for (int ai = 0; ai < 2; ++ai) { const f32x4 q = *(const LAS f32x4*)(T + 128 * ai + 64 * wr + 4 * fr);
                rs[ai][0] = rsqrtf(q[0] * (1.0f / D) + EPS); rs[ai][1] = rsqrtf(q[1] * (1.0f / D) + EPS); rs[ai][2] = rsqrtf(q[2] * (1.0f / D) + EPS); rs[ai][3] = rsqrtf(q[3] * (1.0f / D) + EPS); }
#pragma unroll
            for (int bj = 0; bj < 2; ++bj)
#pragma unroll
                for (int n = 0; n < 2; ++n) { const f32x4 c2v = *(const LAS f32x4*)(T + 256 + 128 * bj + colL + 4 * n);
#pragma unroll
                    for (int ai = 0; ai < 2; ++ai)
#pragma unroll
                        for (int m = 0; m < 4; ++m) acc[ai][bj][m][n] = acc[ai][bj][m][n] * rs[ai][m] + c2v; } }
#pragma unroll
        for (int bj = 0; bj < 2; ++bj)
#pragma unroll
            for (int n = 0; n < 2; ++n)
#pragma unroll
                for (int ai = 0; ai < 2; ++ai) { const int rb = 2 * ai + wr;
                    if (fr == 0)  *(LAS f32x4*)(X + (rb * 2 + 0) * 256 + 128 * bj + colL + 4 * n) = acc[ai][bj][0][n];
                    if (fr == 15) *(LAS f32x4*)(X + (rb * 2 + 1) * 256 + 128 * bj + colL + 4 * n) = acc[ai][bj][3][n]; }
        asm volatile("s_waitcnt lgkmcnt(0)" ::: "memory"); __builtin_amdgcn_s_barrier(); asm volatile("" ::: "memory");
        if (wr == 0 && fr == 0) {
#pragma unroll
            for (int bj = 0; bj < 2; ++bj)
#pragma unroll
                for (int n = 0; n < 2; ++n) { float* ep = edge + ((size_t)gpm * 4 + 0) * FF2 + colg + 128 * bj + 4 * n; *(f32x4*)ep = acc[0][bj][0][n]; *(f32x4*)(ep + FF2) = acc[0][bj][1][n]; }
        }
        if (wr == 1 && fr == 15) {
#pragma unroll
            for (int bj = 0; bj < 2; ++bj)
#pragma unroll
                for (int n = 0; n < 2; ++n) { float* ep = edge + ((size_t)gpm * 4 + 2) * FF2 + colg + 128 * bj + 4 * n; *(f32x4*)ep = acc[1][bj][2][n]; *(f32x4*)(ep + FF2) = acc[1][bj][3][n]; }
        }
        typedef float f32x2 __attribute__((ext_vector_type(2)));
#pragma unroll
        for (int ai = 0; ai < 2; ++ai) { const int rb = 2 * ai + wr;
            unsigned pk[4][2][2];
#pragma unroll
            for (int n = 0; n < 2; ++n) {
#pragma unroll
                for (int eh = 0; eh < 2; ++eh) {
                    f32x2 sg[4];
#pragma unroll
                    for (int bj = 0; bj < 2; ++bj) { const int col = colg + 128 * bj + 4 * n + 2 * eh;
                        const int tcol = 128 * bj + colL + 4 * n + 2 * eh;
                        const f32x2 w0 = *(const LAS f32x2*)(TB + tcol), w1 = *(const LAS f32x2*)(TB + 256 + tcol), w2 = *(const LAS f32x2*)(TB + 512 + tcol), cb = *(const LAS f32x2*)(TB + 768 + tcol);
                        const int ia = rb > 0 ? (rb - 1) * 2 + 1 : 0, ib = rb < 3 ? (rb + 1) * 2 : 7;
                        const f32x2 above = *(const LAS f32x2*)(X + ia * 256 + 128 * bj + colL + 4 * n + 2 * eh);
                        const f32x2 below = *(const LAS f32x2*)(X + ib * 256 + 128 * bj + colL + 4 * n + 2 * eh);
                        f32x2 U0, U1, U2, U3;
                        U0[0] = acc[ai][bj][0][n][2 * eh]; U0[1] = acc[ai][bj][0][n][2 * eh + 1]; U1[0] = acc[ai][bj][1][n][2 * eh]; U1[1] = acc[ai][bj][1][n][2 * eh + 1];
                        U2[0] = acc[ai][bj][2][n][2 * eh]; U2[1] = acc[ai][bj][2][n][2 * eh + 1]; U3[0] = acc[ai][bj][3][n][2 * eh]; U3[1] = acc[ai][bj][3][n][2 * eh + 1];
                        f32x2 up0, dn3;
                        up0[0] = dpp_shr1(above[0], U3[0]); up0[1] = dpp_shr1(above[1], U3[1]); dn3[0] = dpp_shl1(below[0], U0[0]); dn3[1] = dpp_shl1(below[1], U0[1]);
                        f32x2 cv[4];
                        cv[0] = w0 * up0 + w1 * U0 + w2 * U1 + cb;
                        cv[1] = w0 * U0 + w1 * U1 + w2 * U2 + cb;
                        cv[2] = w0 * U1 + w1 * U2 + w2 * U3 + cb;
                        cv[3] = w0 * U2 + w1 * U3 + w2 * dn3 + cb;
                        if (bj == 0) {
#pragma unroll
                            for (int m = 0; m < 4; ++m)
#pragma unroll
                                for (int e = 0; e < 2; ++e) { const float g = cv[m][e]; sg[m][e] = g * __builtin_amdgcn_rcpf(1.0f + __builtin_amdgcn_exp2f(g * -1.4426950408889634f)); }
                        } else {
#pragma unroll
                            for (int m = 0; m < 4; ++m) { const f32x2 av = sg[m] * cv[m]; pk[m][n][eh] = cvt_pk(av[0], av[1]); }
                        }
                    }
                }
            }
#pragma unroll
            for (int m = 0; m < 4; ++m) { const int tr = 128 * ai + 64 * wr + 4 * fr + m; v4u w; w.x = pk[m][0][0]; w.y = pk[m][0][1]; w.z = pk[m][1][0]; w.w = pk[m][1][1];
                *(v4u*)(act + blk_off(u.pm * 256 + tr, u.pn * 128 + colL, FF)) = w; }
        }
    }
};
struct EpiDown {
    static constexpr bool PERM = true, PERMA = false, AFTER_DRAIN = false, PREFETCH = false;
    const unsigned short* x1; float* out; const float* g2t; int pm0;
    __device__ __forceinline__ void operator()(AccRef acc, const pg8::Unit& u, int wr, int wc, int fr_, int fq_) const {
        int fr = fr_, fq = fq_; asm volatile("" : "+v"(fr), "+v"(fq));
        const int gpm = pm0 + u.pm, b = batch_of_tile(gpm), cl = wc * 32 + 8 * fq;
        const char* xb = (const char*)(x1 + (size_t)u.pm * 256 * D) + (size_t)u.pn * 512;
        char* ob = (char*)(out + (size_t)gpm * 256 * D) + (size_t)u.pn * 1024;
        const unsigned loff = (unsigned)(((wr * 64 + fr) * D + cl) * 4);
        v4u xv[2][2][4];
#pragma unroll
        for (int bj = 0; bj < 2; ++bj)
#pragma unroll
            for (int ai = 0; ai < 2; ++ai)
#pragma unroll
                for (int m = 0; m < 4; ++m) xv[bj][ai][m] = *(const v4u*)(xb + (size_t)((ai * 128 + m * 16) * D + bj * 128) * 2 + (loff >> 1));
        f32x4 g2a[2][2];
#pragma unroll
        for (int bj = 0; bj < 2; ++bj)
#pragma unroll
            for (int n = 0; n < 2; ++n) g2a[bj][n] = *(const f32x4*)(g2t + b * D + u.pn * 256 + bj * 128 + cl + 4 * n);
        asm volatile("" ::: "memory");
#pragma unroll
        for (int bj = 0; bj < 2; ++bj) {
            const f32x4 g2[2] = {g2a[bj][0], g2a[bj][1]};
#pragma unroll
            for (int ai = 0; ai < 2; ++ai)
#pragma unroll
                for (int m = 0; m < 4; ++m) { char* orow = ob + (size_t)((ai * 128 + m * 16) * D + bj * 128) * 4; const v4u w = xv[bj][ai][m];
                    const f32x2_t a0 = h2f(w.x), a1 = h2f(w.y), a2 = h2f(w.z), a3 = h2f(w.w);
                    const f32x4 x0 = {a0[0], a0[1], a1[0], a1[1]}, x1v = {a2[0], a2[1], a3[0], a3[1]};
                    __builtin_nontemporal_store(x0 + g2[0] * acc[ai][bj][m][0], (f32x4*)(orow + loff)); __builtin_nontemporal_store(x1v + g2[1] * acc[ai][bj][m][1], (f32x4*)(orow + 16 + loff)); }
        }
    }
};

__device__ __forceinline__ void transpose_item(const float* W, int ldw, int k0, int n0, bf16* WT, int ldt, int drow0, int kd0, LAS float* scr, int lane) {
#pragma unroll 8
    for (int i = 0; i < 32; ++i) { const int kk = 2 * i + (lane >> 5); scr[kk * 33 + (lane & 31)] = W[(size_t)(k0 + kk) * ldw + n0 + (lane & 31)]; }
    LDS_WAIT(); asm volatile("" ::: "memory");
    const int c = lane & 7;
#pragma unroll
    for (int j = 0; j < 4; ++j) { const int n = (lane >> 3) + 8 * j; const LAS float* s = scr + (8 * c) * 33 + n;
        v4u o; o.x = pk2(s[0 * 33], s[1 * 33]); o.y = pk2(s[2 * 33], s[3 * 33]); o.z = pk2(s[4 * 33], s[5 * 33]); o.w = pk2(s[6 * 33], s[7 * 33]);
        *(v4u*)(WT + blk_off(drow0 + n, kd0 + 8 * c, ldt)) = o; }
    LDS_WAIT(); asm volatile("" ::: "memory");
}
template <class Fill> __device__ __forceinline__ void gemv10_item(const float* W, int ldw, int k0, int n, LAS float* sb, float* dst, int dstride, int dcol, float asc, const Fill& fill) {
    float w[64];
#pragma unroll
    for (int kk = 0; kk < 64; ++kk) w[kk] = W[(size_t)(k0 + kk) * ldw + n];
    fill(sb);
    LDS_WAIT(); asm volatile("" ::: "memory");
    float acc[NBATCH];
#pragma unroll
    for (int b = 0; b < NBATCH; ++b) acc[b] = 0.f;
#pragma unroll
    for (int kk = 0; kk < 64; ++kk) {
        const f32x4 s0 = *(const LAS f32x4*)(sb + kk * 12), s1 = *(const LAS f32x4*)(sb + kk * 12 + 4), s2 = *(const LAS f32x4*)(sb + kk * 12 + 8);
        acc[0] += w[kk] * s0[0]; acc[1] += w[kk] * s0[1]; acc[2] += w[kk] * s0[2]; acc[3] += w[kk] * s0[3];
        acc[4] += w[kk] * s1[0]; acc[5] += w[kk] * s1[1]; acc[6] += w[kk] * s1[2]; acc[7] += w[kk] * s1[3];
        acc[8] += w[kk] * s2[0]; acc[9] += w[kk] * s2[1];
    }
#pragma unroll
    for (int b = 0; b < NBATCH; ++b) atomicAdd(dst + (size_t)b * dstride + dcol, acc[b] * asc);
    LDS_WAIT(); asm volatile("" ::: "memory");
}

template <int HW> __device__ __forceinline__ void pool_group(const bf16* PROJ, bf16* CAT, int pbase, int T, int t0, int ch) {
    constexpr int NL = 2 * HW + 3;
    v4u x[NL];
#pragma unroll
    for (int i = 0; i < NL; ++i) { const int s = t0 - HW + i; const v4u z = {0u, 0u, 0u, 0u}; x[i] = (s >= 0 && s < T) ? *(const v4u*)(PROJ + (size_t)(pbase + s) * INW + 3 * ATTW + 8 * ch) : z; }
    float S[8];
#pragma unroll
    for (int c = 0; c < 8; ++c) S[c] = 0.f;
#define POOL_ADD(sgn, VV) do { S[0] += sgn bflo((VV).x); S[1] += sgn bfhi((VV).x); S[2] += sgn bflo((VV).y); S[3] += sgn bfhi((VV).y); S[4] += sgn bflo((VV).z); S[5] += sgn bfhi((VV).z); S[6] += sgn bflo((VV).w); S[7] += sgn bfhi((VV).w); } while (0)
#pragma unroll
    for (int i = 0; i < 2 * HW; ++i) POOL_ADD(+, x[i]);
#pragma unroll
    for (int k = 0; k < 4; ++k) {
        if (k > 0) { POOL_ADD(-, x[k - 1]); POOL_ADD(+, x[k - 1 + 2 * HW]); }
        const int t = t0 + k; const float ic = 1.0f / (float)(min(t + HW, T) - max(t - HW, 0)); const v4u w = x[HW + k];
        v4u ow; ow.x = pk2(S[0] * ic - bflo(w.x), S[1] * ic - bfhi(w.x)); ow.y = pk2(S[2] * ic - bflo(w.y), S[3] * ic - bfhi(w.y));
        ow.z = pk2(S[4] * ic - bflo(w.z), S[5] * ic - bfhi(w.z)); ow.w = pk2(S[6] * ic - bflo(w.w), S[7] * ic - bfhi(w.w));
        *(v4u*)(CAT + blk_off(pbase + t, ATTW + 8 * ch, D)) = ow;
    }
#undef POOL_ADD
}

struct Args { const float* in[19]; float* out; unsigned char* ws; int ph_lo, ph_hi, row0, nrows; };
enum { I_XP = 0, I_XS, I_CP, I_CS, I_WADA, I_BADA, I_N1G, I_N2G, I_WIN, I_QNG, I_KNG, I_RPB, I_WPOOL, I_PSCALE, I_WOUT, I_WUP, I_CONVW, I_CONVB, I_WDOWN };
constexpr int N_PHASES = 8;
#ifndef SW_PHASE
#define SW_PHASE -1
#endif
#ifndef SW_SEL
#define SW_SEL 0
#endif
#ifndef SW_SCALE
#define SW_SCALE 8
#endif
#define SW_PTR(k) ((SW_PHASE == (k) && blockIdx.x == 0) ? (volatile LAS unsigned*)(lds + LDSCTL_OFF + 64) : (volatile LAS unsigned*)nullptr)
#ifndef PROBE_MASK
#define PROBE_MASK 0
#endif
#ifndef PROBE_N
#define PROBE_N 0
#endif
#define PROBE_REPS(k) ((((PROBE_MASK) >> (k)) & 1) ? (PROBE_N) : 0)
#ifndef MK_ONE_LAUNCH
#define MK_ONE_LAUNCH 1
#endif

__global__ void __launch_bounds__(NWAVES * 64, 2) fwd(Args a) {
    extern __shared__ __attribute__((aligned(16))) unsigned char lds_raw[];
    LAS unsigned char* lds = (LAS unsigned char*)lds_raw;
    volatile LAS unsigned* MISC = (volatile LAS unsigned*)(lds + MISC_OFF);
    const int wave = __builtin_amdgcn_readfirstlane((int)threadIdx.x >> 6);
#define LANE_SETUP() int tid_ = threadIdx.x; asm volatile("" : "+v"(tid_)); const int tid = tid_, lane = tid & 63; (void)lane
    const int G = gridDim.x; const int bx = blockIdx.x; const int vcu = (bx % 8) * (G / 8) + bx / 8;
    const int gw = vcu * NWAVES + wave, NGW = G * NWAVES;
    const int grp = (bx & 7) >> 1, xh = bx & 1, gk = bx >> 3, cph = G >> 3, gsz = G >> 2, pm0 = GPANELS * grp;
    unsigned char* ws = a.ws;
    unsigned* ctl = (unsigned*)(ws + WS_CTL);
    float* macc = (float*)(ws + OFF_MOD); float* c2acc = (float*)(ws + OFF_C2); float* rss2 = (float*)(ws + OFF_RSS2); float* hss = (float*)(ws + OFF_HSS);
    bf16* WinT = (bf16*)(ws + WS_WIN); bf16* WoT = (bf16*)(ws + WS_WOUT); bf16* WupT = (bf16*)(ws + WS_WUP); bf16* WdT = (bf16*)(ws + WS_WDN);
    float* convp = (float*)(ws + WS_SMALL); float* cbp = convp + 3 * FF2;
    float* g1t = (float*)(ws + WS_SMALL + 131072); float* G2t = g1t + NBATCH * D; float* g2t = G2t + NBATCH * D;
    float* EDGE = (float*)(ws + WS_EDGE);
    unsigned char* slice = ws + WS_SLICE0 + (size_t)grp * WS_SLICE;
    bf16* H1g = (bf16*)(slice + SL_H1); bf16* PROJg = (bf16*)(slice + SL_PROJ); bf16* CATg = (bf16*)(slice + SL_CAT); unsigned short* X1g = (unsigned short*)(slice + SL_X1); bf16* XG2g = (bf16*)(slice + SL_XG2); bf16* ACTg = (bf16*)(slice + SL_ACT);
    const float* b_ada = a.in[I_BADA];

    for (int u = threadIdx.x; u < (LDS_BYTES - LDSCTL_OFF) / 4; u += NWAVES * 64) ((LAS unsigned*)(lds + LDSCTL_OFF))[u] = 0u;
    __syncthreads();
    XcdBarrier bar = xcd_barrier_post(ctl + CW_BAR, MISC + 8, (unsigned)G);
    XcdBarrier barg = xcd_barrier_post(ctl + CW_GBAR + grp * XCD_BAR_WORDS, MISC + 12, (unsigned)gsz);
#define IN(k) true
#define SEAM(k) do { if ((k) < 2) xcd_barrier(bar); else xcd_barrier(barg); } while (0)

    for (int rep = 0; rep <= PROBE_REPS(0); ++rep) { const float asc = rep ? 0.f : 1.f; (void)asc;
    if (IN(0)) {
        LANE_SETUP();
        LAS float* scr = (LAS float*)(lds + RING_OFF + wave * 16384);
        for (int it = gw; it < 16 * 96; it += NGW) {
            const int kc = it / 96, nc = it % 96, k = 64 * kc + lane;
            const float* cp = a.in[I_CP]; const float* cs = a.in[I_CS];
            gemv10_item(a.in[I_WADA], MODW, 64 * kc, 64 * nc + lane, scr, macc, MODW, 64 * nc + lane, asc, [=](LAS float* sb) {
#pragma unroll
                for (int b = 0; b < NBATCH; ++b) { const float c = b < 8 ? cp[b * D + k] : cs[(b - 8) * D + k]; sb[lane * 12 + b] = silu_f(c); } });
        }
    }
    if (rep < PROBE_REPS(0)) xcd_barrier(bar); }
    SEAM(0);

    for (int rep = 0; rep <= PROBE_REPS(1); ++rep) { const float asc = rep ? 0.f : 1.f; (void)asc;
    if (IN(1)) {
        LANE_SETUP();
        LAS float* scr = (LAS float*)(lds + RING_OFF + wave * 16384);
        constexpr int I0 = 16 * 64, I1 = I0 + 8 * 32, I2 = I1 + 16 * 176, I4 = I2 + 44 * 32, I5 = I4 + 4 * 16 * 16, I6 = I5 + 88, I7 = I6 + NBATCH * 16;
        for (int it = gw; it < I7; it += NGW) {
            if (it < I0) { const int kb = it / 64, nb = it % 64; transpose_item(a.in[I_WIN], INW, 64 * kb, 32 * nb, WinT, D, 32 * nb, 64 * kb, scr, lane); }
            else if (it < I1) { const int r = it - I0, kb = r / 32, nb = r % 32; transpose_item(a.in[I_WOUT], D, 64 * kb, 32 * nb, WoT, D, 32 * nb, 64 * kb, scr, lane); }
            else if (it < I2) { const int r = it - I1, kb = r / 176, nb = r % 176; transpose_item(a.in[I_WUP], FF2, 64 * kb, 32 * nb, WupT, D, permcol(32 * nb), 64 * kb, scr, lane);
                LAS float* sb2 = scr + 64 * 33 + 16;
#pragma unroll
                for (int b = 0; b < NBATCH; ++b) sb2[lane * 12 + b] = modv(macc, b_ada, b, 3 * D + 64 * kb + lane);
                LDS_WAIT(); asm volatile("" ::: "memory");
                const int cn = lane & 31, bh = 5 * (lane >> 5);
                float ac[5] = {0.f, 0.f, 0.f, 0.f, 0.f};
#pragma unroll 8
                for (int kk = 0; kk < 64; ++kk) { const float w = scr[kk * 33 + cn];
#pragma unroll
                    for (int i = 0; i < 5; ++i) ac[i] += w * sb2[kk * 12 + bh + i]; }
#pragma unroll
                for (int i = 0; i < 5; ++i) atomicAdd(c2acc + (size_t)(bh + i) * FF2 + permcol(32 * nb) + cn, ac[i] * asc);
                LDS_WAIT(); asm volatile("" ::: "memory"); }
            else if (it < I4) { const int r = it - I2, kb = r / 32, nb = r % 32; transpose_item(a.in[I_WDOWN], D, 64 * kb, 32 * nb, WdT, FF, 32 * nb, 64 * kb, scr, lane); }
            else if (it < I5) {
                const int r = it - I4, g = r / 256, cb = (r / 16) % 16, nb = r % 16, n = 64 * nb + lane;
                float acc[8];
#pragma unroll
                for (int i = 0; i < 8; ++i) acc[i] = 0.f;
                const float* wp = a.in[I_WPOOL] + (size_t)(g * 128 + 8 * cb) * 128;
#pragma unroll 8
                for (int d = 0; d < 128; ++d) {
                    const float wo = a.in[I_WOUT][(size_t)(ATTW + g * 128 + d) * D + n] * a.in[I_PSCALE][g * 128 + d];
#pragma unroll
                    for (int i = 0; i < 8; ++i) acc[i] += wp[i * 128 + d] * wo;
                }
                v4u o; o.x = pk2(acc[0], acc[1]); o.y = pk2(acc[2], acc[3]); o.z = pk2(acc[4], acc[5]); o.w = pk2(acc[6], acc[7]);
                *(v4u*)(WoT + blk_off(n, ATTW + g * 128 + 8 * cb, D)) = o;
            }
            else if (it < I6) { const int n = 64 * (it - I5) + lane, pc = permcol(n);
                convp[pc] = a.in[I_CONVW][n]; convp[FF2 + pc] = a.in[I_CONVW][FF2 + n]; convp[2 * FF2 + pc] = a.in[I_CONVW][2 * FF2 + n]; cbp[pc] = a.in[I_CONVB][n]; }
            else { const int r = it - I6, b = r / 16, j = 64 * (r % 16) + lane;
                g1t[b * D + j] = modv(macc, b_ada, b, 2 * D + j); G2t[b * D + j] = a.in[I_N2G][j] * (modv(macc, b_ada, b, 4 * D + j) + 1.0f); g2t[b * D + j] = modv(macc, b_ada, b, 5 * D + j); }
        }
        for (int r0 = gw * 16; r0 < MT; r0 += NGW * 16) {
            const int b = batch_of_row(r0);
            bf16* h1b = (bf16*)(ws + WS_SLICE0 + (size_t)(r0 / GROWS) * WS_SLICE + SL_H1);
            f32x4 Gv[4], Sv[4];
#pragma unroll
            for (int j = 0; j < 4; ++j) { const int c = 4 * lane + 256 * j; Gv[j] = *(const f32x4*)(a.in[I_N1G] + c) * (modv4(macc, b_ada, b, D + c) + 1.0f); Sv[j] = modv4(macc, b_ada, b, c); }
#pragma unroll 1
            for (int rr = 0; rr < 16; rr += 4) {
                f32x4 v[4][4]; float s[4];
#pragma unroll
                for (int q = 0; q < 4; ++q) { const int row = r0 + rr + q; const float* xrow = row < NPR ? a.in[I_XP] + (size_t)row * D : a.in[I_XS] + (size_t)(row - NPR) * D;
#pragma unroll
                    for (int j = 0; j < 4; ++j) v[q][j] = *(const f32x4*)(xrow + 4 * lane + 256 * j); }
#pragma unroll
                for (int q = 0; q < 4; ++q) { float t = 0.f;
#pragma unroll
                    for (int j = 0; j < 4; ++j) t += (v[q][j][0] * v[q][j][0] + v[q][j][1] * v[q][j][1]) + (v[q][j][2] * v[q][j][2] + v[q][j][3] * v[q][j][3]);
                    s[q] = t; }
#pragma unroll
                for (int o = 1; o < 64; o <<= 1) { s[0] += __shfl_xor(s[0], o); s[1] += __shfl_xor(s[1], o); s[2] += __shfl_xor(s[2], o); s[3] += __shfl_xor(s[3], o); }
#pragma unroll
                for (int q = 0; q < 4; ++q) { const int row = r0 + rr + q; const float rstd = rsqrtf(s[q] * (1.0f / D) + EPS);
#pragma unroll
                    for (int j = 0; j < 4; ++j) { const f32x4 h = v[q][j] * rstd * Gv[j] + Sv[j]; v2u w; w.x = pk2(h[0], h[1]); w.y = pk2(h[2], h[3]);
                        *(v2u*)(h1b + blk_off(row & (GROWS - 1), 4 * lane + 256 * j, D)) = w; } }
            }
        }
    }
    if (rep < PROBE_REPS(1)) xcd_barrier(bar); }
    SEAM(1);

#ifndef GROUP_SKEW_US
#define GROUP_SKEW_US 0
#endif
    if (GROUP_SKEW_US > 0 && grp > 0) {
        if (threadIdx.x == 0) { const unsigned long long t0 = __builtin_amdgcn_s_memrealtime(), tgt = (unsigned long long)(100 * GROUP_SKEW_US) * (unsigned)grp;
            while (__builtin_amdgcn_s_memrealtime() - t0 < tgt) __builtin_amdgcn_s_sleep(10); }
        __syncthreads();
    }
    for (int rep = 0; rep <= PROBE_REPS(2); ++rep) { const float asc = rep ? 0.f : 1.f; (void)asc;
    if (IN(2)) {
        pg8::Gemm g{H1g, WinT, GROWS, INW, D}; GroupOrder S; S.init(INW, gk, xh, cph);
        EpiProj E{PROJg, hss, asc, pm0};
        pg8::gemm_phase<EpiProj, GroupOrder, PG8_ALIGN, PG8_SP2>(lds + RING_OFF, g, S, E, SW_PTR(2));
    }
    if (rep < PROBE_REPS(2)) xcd_barrier(barg); }
    SEAM(2);

    for (int rep = 0; rep <= PROBE_REPS(3); ++rep) { const float asc = rep ? 0.f : 1.f; (void)asc;
    if (IN(3)) {
        LANE_SETUP();
        typedef short bf16x8 __attribute__((ext_vector_type(8)));
        typedef short s16x4 __attribute__((ext_vector_type(4)));
        LAS float* tbl = (LAS float*)(lds + BIAS_OFF);
        LAS float* rkr = (LAS float*)(lds + RK_OFF);
        const int fq = lane >> 4, l15 = lane & 15, tq = l15 >> 2, tp = lane & 3;
        const int j = wave & 3, kc0 = min(max(16 * j - 8, 0), 32);
        for (int task = xh * cph + gk; task < 64; task += 2 * cph) {
            int b, h, r0, rows;
            if (grp < 2) { b = 4 * grp + (task >> 4); h = (task >> 1) & 7; r0 = (task & 1) * 16; rows = 32; }
            else { b = 8 + (grp - 2); h = task >> 3; r0 = (task & 7) * 16; rows = 128; }
            const int base = b < 8 ? b * 2048 : NPR + (b - 8) * 8192;
            const int gbase = base - GROWS * grp;
            __syncthreads();
            { const int dr = tid >> 5, dc = tid & 31; tbl[tid] = (dr < 15 && dc < 31) ? a.in[I_RPB][h * 465 + dr * 31 + dc] * 1.4426950408889634f : -1e30f; }
            int dco[2][4];
            { const int qc = 16 * j + l15, cs = min(max(qc - 8, 0), 48);
#pragma unroll
              for (int cbk = 0; cbk < 2; ++cbk)
#pragma unroll
                  for (int e = 0; e < 4; ++e) { const int kc = kc0 + 16 * cbk + 4 * fq + e; dco[cbk][e] = 4 * ((kc >= cs && kc < cs + 16) ? (kc - qc + 15) : 31); } }
            const int koff0 = l15 * 128 + 16 * (fq ^ (l15 & 7)), koff1 = l15 * 128 + 16 * ((fq ^ (l15 & 7)) ^ 4);
            int voff[4];
#pragma unroll
            for (int db = 0; db < 4; ++db) voff[db] = (4 * fq + tq) * 128 + 16 * ((2 * db + (tp >> 1)) ^ (4 * (fq & 1) + tq)) + 8 * (tp & 1);
#define STAGE_ROW(kr) do { const int kr_ = (kr); const int slot_ = kr_ % 9; const int tc_ = 8 * wave + (lane >> 3), c16_ = (lane & 7) ^ (tc_ & 7); \
                const bf16* src_ = PROJg + (size_t)(gbase + kr_ * 64 + tc_) * INW + ATTW + h * 64 + 8 * c16_; \
                __builtin_amdgcn_global_load_lds((const unsigned*)src_, (LAS unsigned*)(lds + KRING_OFF + slot_ * 8192 + wave * 1024), 16, 0, 0); \
                __builtin_amdgcn_global_load_lds((const unsigned*)(src_ + ATTW), (LAS unsigned*)(lds + VRING_OFF + slot_ * 8192 + wave * 1024), 16, 0, 0); \
                if (wave == 4) rkr[slot_ * 64 + lane] = rsqrtf(hss[(size_t)(8 + h) * MT + base + kr_ * 64 + lane] * (1.0f / 64.0f) + EPS) * 1.4426950408889634f; } while (0)
            { const int lo0 = min(max(r0 - 4, 0), rows - 8);
              for (int kr = lo0; kr < lo0 + 8; ++kr) STAGE_ROW(kr); }
            const int pu0 = 128 * grp + 2 * task;
            v4u qraw[2] = {{0u, 0u, 0u, 0u}, {0u, 0u, 0u, 0u}}; float qss = 0.f;
            if (wave < 4) { const int qrow0 = base + r0 * 64 + 16 * j + l15; qss = hss[(size_t)h * MT + qrow0];
                qraw[0] = *(const v4u*)(PROJg + (size_t)(qrow0 - GROWS * grp) * INW + h * 64 + 8 * fq); qraw[1] = *(const v4u*)(PROJg + (size_t)(qrow0 - GROWS * grp) * INW + h * 64 + 32 + 8 * fq); }
#pragma unroll 1
            for (int st = 0; st < 16; ++st) {
                if (wave < 4 && st > 0) asm volatile("s_waitcnt vmcnt(4)" ::: "memory"); else VM_WAIT();
                LDS_WAIT(); __builtin_amdgcn_s_barrier(); asm volatile("" ::: "memory");
                const int r = r0 + st, rs = min(max(r - 4, 0), rows - 8);
                if (st < 15) { const int rsn = min(max(r + 1 - 4, 0), rows - 8); if (rsn != rs) STAGE_ROW(rsn + 7); }
                if (wave < 4) {
                    const int dr0 = rs - r + 7;
                    const int qrow = base + r * 64 + 16 * j + l15;
                    bf16x8 qf[2];
                    { const float rqs = rsqrtf(qss * (1.0f / 64.0f) + EPS) * 0.125f;
#pragma unroll
                      for (int ks = 0; ks < 2; ++ks) { const int d0 = 32 * ks + 8 * fq; const v4u w = qraw[ks];
                          const f32x4 g0 = *(const f32x4*)(a.in[I_QNG] + d0) * *(const f32x4*)(a.in[I_KNG] + d0) * rqs, g1 = *(const f32x4*)(a.in[I_QNG] + d0 + 4) * *(const f32x4*)(a.in[I_KNG] + d0 + 4) * rqs;
                          v4u o; o.x = pk2(bflo(w.x) * g0[0], bfhi(w.x) * g0[1]); o.y = pk2(bflo(w.y) * g0[2], bfhi(w.y) * g0[3]); o.z = pk2(bflo(w.z) * g1[0], bfhi(w.z) * g1[1]); o.w = pk2(bflo(w.w) * g1[2], bfhi(w.w) * g1[3]);
                          qf[ks] = __builtin_bit_cast(bf16x8, o); } }
                    if (st < 15) { qss = hss[(size_t)h * MT + qrow + 64]; qraw[0] = *(const v4u*)(PROJg + (size_t)(qrow + 64 - GROWS * grp) * INW + h * 64 + 8 * fq); qraw[1] = *(const v4u*)(PROJg + (size_t)(qrow + 64 - GROWS * grp) * INW + h * 64 + 32 + 8 * fq); }
                    f32x4 sc[16]; float mx = -3e38f;
                    bf16x8 kA[2][2], kB[2][2]; f32x4 rkvA[2], rkvB[2]; float bsvA[2][4], bsvB[2][4];
                    const LAS unsigned char* tba[2][4];
#pragma unroll
                    for (int cbk = 0; cbk < 2; ++cbk)
#pragma unroll
                        for (int e = 0; e < 4; ++e) tba[cbk][e] = (const LAS unsigned char*)(tbl + dr0 * 32) + dco[cbk][e];
#define ATT_LOAD_K(KF, i) do { const LAS unsigned char* kb_ = lds + KRING_OFF + ((rs + (i)) % 9) * 8192 + kc0 * 128; \
                        _Pragma("unroll") for (int cbk = 0; cbk < 2; ++cbk) { KF[cbk][0] = *(const LAS bf16x8*)(kb_ + cbk * 2048 + koff0); KF[cbk][1] = *(const LAS bf16x8*)(kb_ + cbk * 2048 + koff1); } } while (0)
#define ATT_LOAD_RB(RK, BS, i) do { const LAS float* rkb_ = rkr + ((rs + (i)) % 9) * 64 + kc0 + 4 * fq; \
                        _Pragma("unroll") for (int cbk = 0; cbk < 2; ++cbk) { RK[cbk] = *(const LAS f32x4*)(rkb_ + 16 * cbk); \
                            BS[cbk][0] = *(const LAS float*)(tba[cbk][0] + (i) * 128); BS[cbk][1] = *(const LAS float*)(tba[cbk][1] + (i) * 128); BS[cbk][2] = *(const LAS float*)(tba[cbk][2] + (i) * 128); BS[cbk][3] = *(const LAS float*)(tba[cbk][3] + (i) * 128); } } while (0)
#define ATT_COMP_ROW(KF, RK, BS, i) do { f32x4 c_[2]; _Pragma("unroll") for (int cbk = 0; cbk < 2; ++cbk) { c_[cbk] = (f32x4){0.f, 0.f, 0.f, 0.f}; \
                            c_[cbk] = __builtin_amdgcn_mfma_f32_16x16x32_bf16(KF[cbk][0], qf[0], c_[cbk], 0, 0, 0); c_[cbk] = __builtin_amdgcn_mfma_f32_16x16x32_bf16(KF[cbk][1], qf[1], c_[cbk], 0, 0, 0); } \
                        __builtin_amdgcn_sched_barrier(0); \
                        _Pragma("unroll") for (int cbk = 0; cbk < 2; ++cbk) { \
                            f32x4 s; s[0] = c_[cbk][0] * RK[cbk][0] + BS[cbk][0]; s[1] = c_[cbk][1] * RK[cbk][1] + BS[cbk][1]; s[2] = c_[cbk][2] * RK[cbk][2] + BS[cbk][2]; s[3] = c_[cbk][3] * RK[cbk][3] + BS[cbk][3]; \
                            sc[2 * (i) + cbk] = s; mx = fmaxf(fmaxf(mx, fmaxf(s[0], s[1])), fmaxf(s[2], s[3])); } } while (0)
                    ATT_LOAD_K(kA, 0); ATT_LOAD_RB(rkvA, bsvA, 0);
#pragma unroll
                    for (int i2 = 0; i2 < 4; ++i2) {
                        ATT_LOAD_K(kB, 2 * i2 + 1); ATT_LOAD_RB(rkvB, bsvB, 2 * i2 + 1); __builtin_amdgcn_sched_barrier(0);
                        ATT_COMP_ROW(kA, rkvA, bsvA, 2 * i2);     __builtin_amdgcn_sched_barrier(0);
                        if (i2 < 3) { ATT_LOAD_K(kA, 2 * i2 + 2); ATT_LOAD_RB(rkvA, bsvA, 2 * i2 + 2); } __builtin_amdgcn_sched_barrier(0);
                        ATT_COMP_ROW(kB, rkvB, bsvB, 2 * i2 + 1); __builtin_amdgcn_sched_barrier(0);
                    }
#undef ATT_LOAD_K
#undef ATT_LOAD_RB
#undef ATT_COMP_ROW
                    mx = fmaxf(mx, __shfl_xor(mx, 16)); mx = fmaxf(mx, __shfl_xor(mx, 32));
                    float lsum = 0.f;
#pragma unroll
                    for (int kb = 0; kb < 16; ++kb) { f32x4 e; e[0] = __builtin_amdgcn_exp2f(sc[kb][0] - mx); e[1] = __builtin_amdgcn_exp2f(sc[kb][1] - mx); e[2] = __builtin_amdgcn_exp2f(sc[kb][2] - mx); e[3] = __builtin_amdgcn_exp2f(sc[kb][3] - mx);
                        sc[kb] = e; lsum += (e[0] + e[1]) + (e[2] + e[3]); }
                    lsum += __shfl_xor(lsum, 16); lsum += __shfl_xor(lsum, 32);
                    f32x4 oacc[4];
#pragma unroll
                    for (int db = 0; db < 4; ++db) oacc[db] = (f32x4){0.f, 0.f, 0.f, 0.f};
                    s16x4 vaA[4], vbA[4], vaB[4], vbB[4];
#define ATT_LOAD_V(VA, VB, t) do { const LAS unsigned char* pA_ = lds + VRING_OFF + ((rs + (t)) % 9) * 8192 + kc0 * 128, * pB_ = pA_ + 2048; \
                        _Pragma("unroll") for (int db = 0; db < 4; ++db) { VA[db] = __builtin_bit_cast(s16x4, __builtin_amdgcn_ds_read_tr16_b64_v4i16((LAS s16x4*)(pA_ + voff[db]))); \
                            VB[db] = __builtin_bit_cast(s16x4, __builtin_amdgcn_ds_read_tr16_b64_v4i16((LAS s16x4*)(pB_ + voff[db]))); } } while (0)
#define ATT_COMP_V(VA, VB, t) do { const int kbA_ = 2 * (t), kbB_ = 2 * (t) + 1; \
                        v4u pw_; pw_.x = cvt_pk(sc[kbA_][0], sc[kbA_][1]); pw_.y = cvt_pk(sc[kbA_][2], sc[kbA_][3]); pw_.z = cvt_pk(sc[kbB_][0], sc[kbB_][1]); pw_.w = cvt_pk(sc[kbB_][2], sc[kbB_][3]); \
                        const bf16x8 pf_ = __builtin_bit_cast(bf16x8, pw_); \
                        _Pragma("unroll") for (int db = 0; db < 4; ++db) { bf16x8 vf_; vf_[0] = VA[db][0]; vf_[1] = VA[db][1]; vf_[2] = VA[db][2]; vf_[3] = VA[db][3]; vf_[4] = VB[db][0]; vf_[5] = VB[db][1]; vf_[6] = VB[db][2]; vf_[7] = VB[db][3]; \
                            oacc[db] = __builtin_amdgcn_mfma_f32_16x16x32_bf16(vf_, pf_, oacc[db], 0, 0, 0); } } while (0)
                    ATT_LOAD_V(vaA, vbA, 0);
#pragma unroll
                    for (int t2 = 0; t2 < 4; ++t2) {
                        ATT_LOAD_V(vaB, vbB, 2 * t2 + 1); __builtin_amdgcn_sched_barrier(0);
                        ATT_COMP_V(vaA, vbA, 2 * t2);     __builtin_amdgcn_sched_barrier(0);
                        if (t2 < 3) { ATT_LOAD_V(vaA, vbA, 2 * t2 + 2); } __builtin_amdgcn_sched_barrier(0);
                        ATT_COMP_V(vaB, vbB, 2 * t2 + 1); __builtin_amdgcn_sched_barrier(0);
                    }
#undef ATT_LOAD_V
#undef ATT_COMP_V
                    const float il = 1.0f / lsum;
#pragma unroll
                    for (int db = 0; db < 4; ++db) { v2u w; w.x = cvt_pk(oacc[db][0] * il, oacc[db][1] * il); w.y = cvt_pk(oacc[db][2] * il, oacc[db][3] * il);
                        *(v2u*)(CATg + blk_off(qrow - GROWS * grp, h * 64 + 16 * db + 4 * fq, D)) = w; }
                } else if ((st & 1) == 0) {
                    const int it = st >> 1, g = wave - 4, pu = pu0 + (it >> 2), tg = 4 * (it & 3) + (lane >> 4), ch = 16 * g + (lane & 15);
                    int pb, prr, prows;
                    if (pu < 256) { pb = pu >> 5; prr = pu & 31; prows = 32; } else { pb = 8 + ((pu - 256) >> 7); prr = (pu - 256) & 127; prows = 128; }
                    const int pbase = (pb < 8 ? pb * 2048 : NPR + (pb - 8) * 8192) - GROWS * grp, T = prows * 64, t0 = prr * 64 + 4 * tg;
                    if (g == 0) pool_group<1>(PROJg, CATg, pbase, T, t0, ch); else if (g == 1) pool_group<2>(PROJg, CATg, pbase, T, t0, ch);
                    else if (g == 2) pool_group<4>(PROJg, CATg, pbase, T, t0, ch); else pool_group<8>(PROJg, CATg, pbase, T, t0, ch);
                }
            }
#undef STAGE_ROW
        }
    }
    if (rep < PROBE_REPS(3)) xcd_barrier(barg); }
    SEAM(3);

    for (int rep = 0; rep <= PROBE_REPS(4); ++rep) { const float asc = rep ? 0.f : 1.f; (void)asc;
    if (IN(4)) {
        pg8::Gemm g{CATg, WoT, GROWS, D, D}; GroupOrder S; S.init(D, gk, xh, cph);
        EpiOut E{a.in[I_XP], a.in[I_XS], X1g, XG2g, rss2, g1t, G2t, asc, pm0};
        pg8::gemm_phase<EpiOut, GroupOrder, PG8_ALIGN, PG8_SP2>(lds + RING_OFF, g, S, E, SW_PTR(4));
    }
    if (rep < PROBE_REPS(4)) xcd_barrier(barg); }
    SEAM(4);

    for (int rep = 0; rep <= PROBE_REPS(5); ++rep) { const float asc = rep ? 0.f : 1.f; (void)asc;
    if (IN(5)) {
        pg8::Gemm g{XG2g, WupT, GROWS, FF2, D}; GroupOrder S; S.init(FF2, gk, xh, cph);
        EpiConvAct E{ACTg, EDGE, rss2, c2acc, convp, cbp, (LAS float*)(lds + XCH_OFF), pm0};
        pg8::gemm_phase<EpiConvAct, GroupOrder, PG8_ALIGN, PG8_SP2>(lds + RING_OFF, g, S, E, SW_PTR(5));
    }
    if (rep < PROBE_REPS(5)) xcd_barrier(barg); }
    SEAM(5);

    for (int rep = 0; rep <= PROBE_REPS(6); ++rep) { const float asc = rep ? 0.f : 1.f; (void)asc;
    if (IN(6)) {
        LANE_SETUP();
        for (int idx = (xh * cph + gk) * 512 + tid; idx < 2 * GPANELS * (FF / 8); idx += gsz * 512) {
            const int br = idx / (FF / 8), f = 8 * (idx % (FF / 8)), gcol = (f >> 7) * 256 + (f & 127);
            const int pm = pm0 + (br >> 1), last = br & 1, row = pm * 256 + (last ? 255 : 0);
            const int b = batch_of_row(row), t = row < NPR ? (row & 2047) : ((row - NPR) & 8191), T = b < 8 ? 2048 : 8192;
            const float* em; const float* e0; const float* ep;
            if (!last) { em = EDGE + ((size_t)(pm - 1) * 4 + 3) * FF2; e0 = EDGE + ((size_t)pm * 4 + 0) * FF2; ep = EDGE + ((size_t)pm * 4 + 1) * FF2; }
            else       { em = EDGE + ((size_t)pm * 4 + 2) * FF2; e0 = EDGE + ((size_t)pm * 4 + 3) * FF2; ep = EDGE + ((size_t)(pm + 1) * 4 + 0) * FF2; }
            const bool hm = t > 0, hp = t < T - 1;
            float res[2][8];
#pragma unroll
            for (int part = 0; part < 2; ++part) {
                const int col = gcol + 128 * part;
#pragma unroll
                for (int hh = 0; hh < 2; ++hh) {
                    const int c = col + 4 * hh; const f32x4 zero = {0.f, 0.f, 0.f, 0.f};
                    const f32x4 um = hm ? *(const f32x4*)(em + c) : zero, u0 = *(const f32x4*)(e0 + c), up = hp ? *(const f32x4*)(ep + c) : zero;
                    const f32x4 w0 = *(const f32x4*)(convp + c), w1 = *(const f32x4*)(convp + FF2 + c), w2 = *(const f32x4*)(convp + 2 * FF2 + c), cb = *(const f32x4*)(cbp + c);
                    const f32x4 r = w0 * um + w1 * u0 + w2 * up + cb;
                    res[part][4 * hh + 0] = r[0]; res[part][4 * hh + 1] = r[1]; res[part][4 * hh + 2] = r[2]; res[part][4 * hh + 3] = r[3];
                }
            }
            v4u ow; ow.x = pk2(silu_f(res[0][0]) * res[1][0], silu_f(res[0][1]) * res[1][1]); ow.y = pk2(silu_f(res[0][2]) * res[1][2], silu_f(res[0][3]) * res[1][3]);
            ow.z = pk2(silu_f(res[0][4]) * res[1][4], silu_f(res[0][5]) * res[1][5]); ow.w = pk2(silu_f(res[0][6]) * res[1][6], silu_f(res[0][7]) * res[1][7]);
            *(v4u*)(ACTg + blk_off(row - GROWS * grp, f, FF)) = ow;
        }
    }
    if (rep < PROBE_REPS(6)) xcd_barrier(barg); }
    SEAM(6);

    for (int rep = 0; rep <= PROBE_REPS(7); ++rep) { const float asc = rep ? 0.f : 1.f; (void)asc;
    if (IN(7)) {
        pg8::Gemm g{ACTg, WdT, GROWS, D, FF}; GroupOrder S; S.init(D, gk, xh, cph);
        EpiDown E{X1g, a.out, g2t, pm0};
        pg8::gemm_phase<EpiDown, GroupOrder, PG8_ALIGN, PG8_SP2>(lds + RING_OFF, g, S, E, SW_PTR(7));
    }
    if (rep < PROBE_REPS(7)) xcd_barrier(barg); }
    if (SW_PHASE >= 0 && blockIdx.x == 0 && threadIdx.x == 0) {
        const unsigned long long tgt = (unsigned long long)SW_SCALE * ((volatile LAS unsigned*)(lds + LDSCTL_OFF + 64))[SW_SEL], t0 = __builtin_amdgcn_s_memrealtime();
        while (__builtin_amdgcn_s_memrealtime() - t0 < tgt) __builtin_amdgcn_s_sleep(20);
    }
#undef IN
#undef SEAM
}

extern "C" void kernel_launch(void* const* d_in, const int* in_sizes, int n_in, void* d_out, int out_size, void* d_ws, size_t ws_size, hipStream_t stream) {
    static int grid = 0;
    if (grid == 0) {
        if (n_in != 19 || out_size != MT * D || ws_size < WS_END) { fprintf(stderr, "kernel_launch: unexpected shapes (n_in %d, out %d, ws %zu)\n", n_in, out_size, ws_size); grid = -1; return; }
        int dev = 0, cus = 0;
        if (hipGetDevice(&dev) != hipSuccess || hipDeviceGetAttribute(&cus, hipDeviceAttributeMultiprocessorCount, dev) != hipSuccess) { grid = -1; return; }
        if (hipFuncSetAttribute((const void*)fwd, hipFuncAttributeMaxDynamicSharedMemorySize, LDS_BYTES) != hipSuccess) { fprintf(stderr, "kernel_launch: hipFuncSetAttribute failed\n"); grid = -1; return; }
        int per_cu = 0;
        if (hipOccupancyMaxActiveBlocksPerMultiprocessor(&per_cu, (const void*)fwd, NWAVES * 64, LDS_BYTES) != hipSuccess || per_cu < 1) { fprintf(stderr, "kernel_launch: the occupancy query admits %d workgroups per CU; nothing launched\n", per_cu); grid = -1; return; }
        (void)hipGetLastError();
        grid = cus;
        if (grid % 8 != 0 || grid < 8) { fprintf(stderr, "kernel_launch: needs a multiple of 8 CUs (got %d)\n", grid); grid = -1; return; }
    }
    if (grid < 0) return;
    if (hipMemsetAsync((char*)d_ws + WS_CTL, 0, CTL_ZERO_BYTES, stream) != hipSuccess) return;
    Args a{};
    for (int i = 0; i < 19; ++i) a.in[i] = (const float*)d_in[i];
    a.out = (float*)d_out; a.ws = (unsigned char*)d_ws;
    a.ph_lo = 0; a.ph_hi = N_PHASES; a.row0 = 0; a.nrows = 0;
    hipLaunchKernelGGL(fwd, dim3(grid), dim3(NWAVES * 64), LDS_BYTES, stream, a);
}
```

```cpp
#include <hip/hip_runtime.h>
#include <cstdio>
#include <cstdint>

constexpr int D = 1024, MT = 32768, NPR = 16384, INW = 2048, ATTW = 512, HD = 64, NH = 8, FF = 2816, FF2 = 5632, NBATCH = 10, MODW = 6144;
constexpr float EPS = 1e-6f;

namespace pg8 {
#define PG8_LAS __attribute__((address_space(3)))
typedef unsigned short bf16_t;
typedef short bf16x8 __attribute__((ext_vector_type(8)));
typedef float f32x4 __attribute__((ext_vector_type(4)));
typedef unsigned u32x4 __attribute__((ext_vector_type(4)));
constexpr int BM = 256, BK = 64, HALF = 128, HTB = HALF * BK * 2  , STAGE_BYTES = 8 * HTB, NXCD = 8, WGM = 8;

__host__ __device__ __forceinline__ int lds_byte(int r, int c) { const int st = (r >> 4) * 2 + (c >> 5), rr = r & 15, cc = c & 31, ob = rr * 64 + cc * 2; return st * 1024 + (ob ^ (((ob >> 9) & 1) << 5)); }
__host__ __device__ __forceinline__ void stage_rc(int b, int& R, int& C) { const int st = b / 1024, sb = b % 1024, swz = sb ^ (((sb >> 9) & 1) << 5); R = (st >> 1) * 16 + swz / 64; C = (st & 1) * 32 + (swz % 64) / 2; }
__host__ __device__ __forceinline__ int perm32(int rho) { const int n = rho >> 4, i = rho & 15; return 8 * (i >> 2) + 4 * n + (i & 3); }

struct Unit { int pm, pn; };
struct Gemm { const bf16_t* A; const bf16_t* Bt; int M, N, K; };

struct StaticOrder {
    int nM, nN, nwg, G, c;
    __host__ __device__ void init(int M, int N, int G_, int c_) { nM = M / BM; nN = N / BM; nwg = nM * nN; G = G_; c = c_; }
    __host__ __device__ bool next(int i, Unit& u) const {
        const long L = (long)i * G + c; if (L >= nwg) return false;
        int wgid = (int)L; { const int q = nwg / NXCD, r = nwg % NXCD, xcd = wgid % NXCD, off = wgid / NXCD; wgid = (xcd < r ? xcd * (q + 1) : r * (q + 1) + (xcd - r) * q) + off; }
        const int nig = WGM * nN, gid = wgid / nig, fm = gid * WGM, gsz = (nM - fm) < WGM ? (nM - fm) : WGM;
        u.pm = fm + ((wgid % nig) % gsz); u.pn = (wgid % nig) / gsz; return true;
    }
    __device__ __forceinline__ void a_ready(const Unit&) const {}
    __device__ __forceinline__ void done(const Unit&) const {}
};

template <class Epi, class Sched, bool ALIGN_EPI = false, bool SP2 = false>
__device__ __forceinline__ void gemm_phase(PG8_LAS unsigned char* lds, const Gemm g, const Sched& S, const Epi& E, volatile PG8_LAS unsigned* sw = nullptr) {
    unsigned long long sw_t = 0;
    int tid_ = threadIdx.x; asm volatile("" : "+v"(tid_));
    const int tid = tid_, wid = __builtin_amdgcn_readfirstlane(tid >> 6), lane = tid & 63, wr = wid >> 2, wc = wid & 3, fr = lane & 15, fq = lane >> 4;
    const int K = g.K, nt = K / BK;
    unsigned voffA[2], voffB[2];
#pragma unroll
    for (int i = 0; i < 2; ++i) { int R, C; stage_rc(tid * 16 + i * 8192, R, C); const int Rb = Epi::PERM ? ((R & ~31) + perm32(R & 31)) : R;
        const int Ra = Epi::PERMA ? ((R & 64) + 4 * (R & 15) + ((R >> 4) & 3)) : R;
        voffA[i] = (unsigned)(Ra * BK + C) * 2u; voffB[i] = (unsigned)(Rb * BK + C) * 2u; }
    const size_t kstep = (size_t)(BM * BK * 2);
    const size_t hstep = (size_t)HALF * BK * 2;
    const size_t tstep = (size_t)K * BM * 2;
    const unsigned ldsw = (unsigned)wid * 1024u;
    const int aoff = lds_byte(wr * 64 + fr, fq * 8), boff = lds_byte(wc * 32 + fr, fq * 8);
#define PG8_SA(b, h) (((b) * 2 + (h)) * HTB)
#define PG8_SB(b, h) ((4 + (b) * 2 + (h)) * HTB)
#define PG8_STAGE(bufoff, gbase, voff) do { _Pragma("unroll") for (int _i = 0; _i < 2; ++_i) \
        __builtin_amdgcn_global_load_lds((const unsigned*)((const char*)(gbase) + (voff)[_i]), (PG8_LAS unsigned*)(lds + (bufoff) + ldsw + _i * 8192), 16, 0, 0); } while (0)
#define PG8_LDA(dst, b, h) do { _Pragma("unroll") for (int m = 0; m < 4; ++m) _Pragma("unroll") for (int k = 0; k < 2; ++k) dst[m][k] = *(const PG8_LAS bf16x8*)(lds + PG8_SA(b, h) + aoff + m * 2048 + k * 1024); } while (0)
#define PG8_LDB(dst, b, h) do { _Pragma("unroll") for (int n = 0; n < 2; ++n) _Pragma("unroll") for (int k = 0; k < 2; ++k) dst[n][k] = *(const PG8_LAS bf16x8*)(lds + PG8_SB(b, h) + boff + n * 2048 + k * 1024); } while (0)
#define PG8_MMA(ai, bj, At, Bt) do { __builtin_amdgcn_s_setprio(1); _Pragma("unroll") for (int m = 0; m < 4; ++m) _Pragma("unroll") for (int n = 0; n < 2; ++n) _Pragma("unroll") for (int k = 0; k < 2; ++k) \
        acc[ai][bj][m][n] = __builtin_amdgcn_mfma_f32_16x16x32_bf16(Bt[n][k], At[m][k], acc[ai][bj][m][n], 0, 0, 0); __builtin_amdgcn_s_setprio(0); } while (0)
#define PG8_WAIT_V(n) asm volatile("s_waitcnt vmcnt(" #n ")" ::: "memory")
#define PG8_WAIT_L(n) asm volatile("s_waitcnt lgkmcnt(" #n ")" ::: "memory")
#define PG8_BAR __builtin_amdgcn_s_barrier()
#define PG8_SCHED __builtin_amdgcn_sched_barrier(0)
    Unit cur, nxt; int ui = 0;
    if (!S.next(0, cur)) return;
    if constexpr (Epi::PREFETCH) E.prefetch(cur, 0, wid, lane);
    f32x4 acc[2][2][4][2];
#pragma unroll
    for (int a = 0; a < 2; ++a)
#pragma unroll
        for (int b = 0; b < 2; ++b)
#pragma unroll
            for (int m = 0; m < 4; ++m)
#pragma unroll
                for (int n = 0; n < 2; ++n) acc[a][b][m][n] = (f32x4){0.f, 0.f, 0.f, 0.f};
    bf16x8 At[4][2], B0[2][2], B1[2][2];
    const char* cA = (const char*)g.A + (size_t)cur.pm * tstep; const char* cB = (const char*)g.Bt + (size_t)cur.pn * tstep;
    S.a_ready(cur);
    if constexpr (SP2) {
        PG8_STAGE(PG8_SB(0, 0), cB, voffB); PG8_STAGE(PG8_SB(0, 1), cB + hstep, voffB); PG8_STAGE(PG8_SA(0, 0), cA, voffA); PG8_STAGE(PG8_SA(0, 1), cA + hstep, voffA);
        if (wr == 1) PG8_BAR;
        PG8_WAIT_V(2); PG8_BAR;
        PG8_STAGE(PG8_SB(1, 0), cB + kstep, voffB); PG8_STAGE(PG8_SA(1, 0), cA + kstep, voffA); PG8_STAGE(PG8_SB(1, 1), cB + hstep + kstep, voffB);
        PG8_WAIT_V(6); PG8_BAR;
    } else {
        PG8_STAGE(PG8_SB(0, 0), cB, voffB); PG8_STAGE(PG8_SA(0, 0), cA, voffA); PG8_STAGE(PG8_SB(0, 1), cB + hstep, voffB); PG8_STAGE(PG8_SA(0, 1), cA + hstep, voffA);
        if (wr == 1) PG8_BAR;
        PG8_WAIT_V(4); PG8_BAR;
        PG8_STAGE(PG8_SB(1, 0), cB + kstep, voffB); PG8_STAGE(PG8_SA(1, 0), cA + kstep, voffA); PG8_STAGE(PG8_SB(1, 1), cB + hstep + kstep, voffB);
        PG8_WAIT_V(6); PG8_BAR;
    }
    for (;;) {
        if (sw) { __builtin_amdgcn_sched_barrier(0); sw_t = __builtin_amdgcn_s_memrealtime(); __builtin_amdgcn_sched_barrier(0); }
        const bool has_next = S.next(ui + 1, nxt);
        const char* nA = has_next ? (const char*)g.A + (size_t)nxt.pm * tstep : cA; const char* nB = has_next ? (const char*)g.Bt + (size_t)nxt.pn * tstep : cB;
        for (int t = 0; t < nt; t += 2) {
            const bool last = (t == nt - 2);
            const char* a1 = cA + (size_t)(t + 1) * kstep;
            const char* a2 = last ? nA : cA + (size_t)(t + 2) * kstep; const char* b2 = last ? nB : cB + (size_t)(t + 2) * kstep;
            const char* a3 = a2 + kstep; const char* b3 = b2 + kstep;
            if (last && has_next) S.a_ready(nxt);
            if constexpr (SP2) {
            PG8_LDB(B0, 0, 0); PG8_LDB(B1, 0, 1); PG8_SCHED; PG8_LDA(At, 0, 0); PG8_STAGE(PG8_SA(1, 1), a1 + hstep, voffA);
            PG8_WAIT_V(8); PG8_WAIT_L(0); PG8_BAR; PG8_MMA(0, 0, At, B0); PG8_MMA(0, 1, At, B1); PG8_BAR; PG8_SCHED;
            PG8_LDA(At, 0, 1); PG8_STAGE(PG8_SB(0, 0), b2, voffB); PG8_STAGE(PG8_SB(0, 1), b2 + hstep, voffB); PG8_STAGE(PG8_SA(0, 0), a2, voffA);
            PG8_WAIT_V(8); PG8_WAIT_L(0); PG8_BAR; PG8_MMA(1, 0, At, B0); PG8_MMA(1, 1, At, B1); PG8_BAR; PG8_SCHED;
            PG8_LDB(B0, 1, 0); PG8_LDB(B1, 1, 1); PG8_SCHED; PG8_LDA(At, 1, 0); PG8_STAGE(PG8_SA(0, 1), a2 + hstep, voffA);
            PG8_WAIT_V(8); PG8_WAIT_L(0); PG8_BAR; PG8_MMA(0, 0, At, B0); PG8_MMA(0, 1, At, B1); PG8_BAR; PG8_SCHED;
            PG8_LDA(At, 1, 1); PG8_STAGE(PG8_SB(1, 0), b3, voffB); PG8_STAGE(PG8_SB(1, 1), b3 + hstep, voffB); PG8_STAGE(PG8_SA(1, 0), a3, voffA);
            PG8_WAIT_V(8); PG8_WAIT_L(0); PG8_BAR; PG8_MMA(1, 0, At, B0); PG8_MMA(1, 1, At, B1); PG8_BAR; PG8_SCHED;
            } else {
            PG8_LDB(B0, 0, 0); PG8_SCHED; PG8_LDA(At, 0, 0); PG8_STAGE(PG8_SA(1, 1), a1 + hstep, voffA);
            PG8_WAIT_L(8); PG8_BAR; PG8_WAIT_L(0); PG8_MMA(0, 0, At, B0); PG8_BAR; PG8_SCHED;
            PG8_LDB(B1, 0, 1); PG8_STAGE(PG8_SB(0, 0), b2, voffB);
            PG8_BAR; PG8_WAIT_L(0); PG8_MMA(0, 1, At, B1); PG8_BAR;
            PG8_LDA(At, 0, 1); PG8_STAGE(PG8_SA(0, 0), a2, voffA);
            PG8_BAR; PG8_WAIT_L(0); PG8_MMA(1, 0, At, B0); PG8_BAR; PG8_SCHED;
            PG8_STAGE(PG8_SB(0, 1), b2 + hstep, voffB);
            PG8_WAIT_V(6); PG8_BAR; PG8_MMA(1, 1, At, B1); PG8_BAR;
            PG8_LDB(B0, 1, 0); PG8_SCHED; PG8_LDA(At, 1, 0); PG8_STAGE(PG8_SA(0, 1), a2 + hstep, voffA);
            PG8_WAIT_L(8); PG8_BAR; PG8_WAIT_L(0); PG8_MMA(0, 0, At, B0); PG8_BAR; PG8_SCHED;
            PG8_LDB(B1, 1, 1); PG8_STAGE(PG8_SB(1, 0), b3, voffB);
            PG8_BAR; PG8_WAIT_L(0); PG8_MMA(0, 1, At, B1); PG8_BAR;
            PG8_LDA(At, 1, 1); PG8_STAGE(PG8_SA(1, 0), a3, voffA);
            PG8_BAR; PG8_WAIT_L(0); PG8_MMA(1, 0, At, B0); PG8_BAR; PG8_SCHED;
            PG8_STAGE(PG8_SB(1, 1), b3 + hstep, voffB);
            PG8_WAIT_V(6); PG8_BAR; PG8_MMA(1, 1, At, B1); PG8_BAR;
            }
        }
        if constexpr (ALIGN_EPI) { if (wr == 0) PG8_BAR; }
        if (sw) { __builtin_amdgcn_sched_barrier(0); const unsigned long long t1 = __builtin_amdgcn_s_memrealtime(); if (threadIdx.x == 0) sw[0] += (unsigned)(t1 - sw_t); sw_t = t1; __builtin_amdgcn_sched_barrier(0); }
        if constexpr (Epi::PREFETCH) { E.run(acc, cur, wr, wc, fr, fq, ui & 1); if (has_next) E.prefetch(nxt, (ui + 1) & 1, wid, lane); S.done(cur); }
        else if constexpr (!Epi::AFTER_DRAIN) { E(acc, cur, wr, wc, fr, fq); S.done(cur); }
        if (sw) { __builtin_amdgcn_sched_barrier(0); const unsigned long long t1 = __builtin_amdgcn_s_memrealtime(); if (threadIdx.x == 0) sw[1] += (unsigned)(t1 - sw_t); __builtin_amdgcn_sched_barrier(0); }
        if (!has_next) break;
#pragma unroll
        for (int a = 0; a < 2; ++a)
#pragma unroll
            for (int b = 0; b < 2; ++b)
#pragma unroll
                for (int m = 0; m < 4; ++m)
#pragma unroll
                    for (int n = 0; n < 2; ++n) acc[a][b][m][n] = (f32x4){0.f, 0.f, 0.f, 0.f};
        cur = nxt; cA = nA; cB = nB; ++ui;
        if constexpr (ALIGN_EPI) { if (wr == 1) PG8_BAR; }
    }
    PG8_WAIT_V(0);
    if constexpr (!ALIGN_EPI) { if (wr == 0) PG8_BAR; }
    PG8_BAR;
    if constexpr (Epi::AFTER_DRAIN) { E.fused(acc, cur, wr, wc, fr, fq, lds, wid, lane); S.done(cur); }
#undef PG8_SA
#undef PG8_SB
#undef PG8_STAGE
#undef PG8_LDA
#undef PG8_LDB
#undef PG8_MMA
#undef PG8_WAIT_V
#undef PG8_WAIT_L
#undef PG8_BAR
#undef PG8_SCHED
}
}
#ifndef PG8_SP2
#define PG8_SP2 true
#endif
#ifndef PG8_ALIGN
#define PG8_ALIGN true
#endif
constexpr size_t MiB = 1u << 20;
constexpr size_t WS_CTL = 0, CTL_ZERO_BYTES = 3 * MiB;
constexpr size_t OFF_MOD = 131072, OFF_C2 = 393216, OFF_RSS2 = 622592, OFF_HSS = 1 * MiB;
constexpr size_t WS_WIN = 3 * MiB, WS_WOUT = 7 * MiB, WS_WUP = 9 * MiB, WS_WDN = 20 * MiB, WS_SMALL = 26 * MiB, WS_EDGE = 27 * MiB, WS_SLICE0 = 40 * MiB, WS_SLICE = 112 * MiB;
constexpr size_t SL_H1 = 0, SL_PROJ = 16 * MiB, SL_CAT = 48 * MiB, SL_XG2 = 64 * MiB, SL_X1 = 80 * MiB, SL_ACT = 0;
constexpr size_t WS_END = 512 * MiB;
constexpr int NGROUPS = 4, GROWS = MT / NGROUPS, GPANELS = GROWS / 256;
constexpr int CW_BAR = 4096, CW_GBAR = 8192;
constexpr int RING_OFF = 0, RING_BYTES = 131072;
constexpr int XCH_OFF = 131072;
constexpr int KRING_OFF = 0, VRING_OFF = 73728;
constexpr int BIAS_OFF = 147456, RK_OFF = 149504;
constexpr int LDSCTL_OFF = 155648, MISC_OFF = LDSCTL_OFF + 320, LDS_BYTES = 163840;
constexpr int NWAVES = 8;

#define GAS __attribute__((address_space(1)))
#define LAS __attribute__((address_space(3)))
typedef unsigned short bf16;
typedef unsigned v4u __attribute__((ext_vector_type(4)));
typedef unsigned v2u __attribute__((ext_vector_type(2)));
using pg8::f32x4;
#define LDS_WAIT() asm volatile("s_waitcnt lgkmcnt(0)" ::: "memory")
#define VM_WAIT() asm volatile("s_waitcnt vmcnt(0)" ::: "memory")
__device__ __forceinline__ unsigned f2bf(float f) { unsigned u = __builtin_bit_cast(unsigned, f); return (u + 0x7fffu + ((u >> 16) & 1u)) >> 16; }
__device__ __forceinline__ unsigned pk2(float lo, float hi) { return f2bf(lo) | (f2bf(hi) << 16); }
__device__ __forceinline__ float bflo(unsigned w) { return __builtin_bit_cast(float, w << 16); }
__device__ __forceinline__ float bfhi(unsigned w) { return __builtin_bit_cast(float, w & 0xffff0000u); }
typedef float f32x2_t __attribute__((ext_vector_type(2))); typedef __bf16 bf16x2_t __attribute__((ext_vector_type(2))); typedef _Float16 f16x2_t __attribute__((ext_vector_type(2)));
__device__ __forceinline__ unsigned cvt_pk_h(float lo, float hi) { f32x2_t v = {lo, hi}; f16x2_t h = __builtin_convertvector(v, f16x2_t); return __builtin_bit_cast(unsigned, h); }
__device__ __forceinline__ f32x2_t h2f(unsigned w) { return __builtin_convertvector(__builtin_bit_cast(f16x2_t, w), f32x2_t); }
__device__ __forceinline__ unsigned cvt_pk(float lo, float hi) { f32x2_t v = {lo, hi}; bf16x2_t b = __builtin_convertvector(v, bf16x2_t); return __builtin_bit_cast(unsigned, b); }
__device__ __forceinline__ size_t blk_off(int row, int col, int K) { return ((size_t)((row >> 8) * (K >> 6) + (col >> 6)) << 14) + (size_t)(((row & 255) << 6) + (col & 63)); }
__device__ __forceinline__ int batch_of_row(int row) { return row < NPR ? (row >> 11) : 8 + ((row - NPR) >> 13); }
__device__ __forceinline__ int batch_of_tile(int pm) { return pm < 64 ? (pm >> 3) : 8 + ((pm - 64) >> 5); }
__device__ __forceinline__ int permcol(int n) { const int f = n < FF ? n : n - FF; return (f >> 7) * 256 + (f & 127) + (n < FF ? 0 : 128); }
__device__ __forceinline__ float wave_sum(float v) {
#pragma unroll
    for (int o = 1; o < 64; o <<= 1) v += __shfl_xor(v, o);
    return v;
}
__device__ __forceinline__ float red_sum_16_32(float x) {
    float a = x, b = x; asm volatile("s_nop 1\n\tv_permlane16_swap_b32 %0, %1" : "+v"(a), "+v"(b)); x = a + b;
    a = x; b = x; asm volatile("s_nop 1\n\tv_permlane32_swap_b32 %0, %1" : "+v"(a), "+v"(b)); return a + b; }
__device__ __forceinline__ float red_max_16_32(float x) {
    float a = x, b = x; asm volatile("s_nop 1\n\tv_permlane16_swap_b32 %0, %1" : "+v"(a), "+v"(b)); x = fmaxf(a, b);
    a = x; b = x; asm volatile("s_nop 1\n\tv_permlane32_swap_b32 %0, %1" : "+v"(a), "+v"(b)); return fmaxf(a, b); }
__device__ __forceinline__ float silu_f(float x) { return x / (1.0f + __expf(-x)); }

#define XB_TMO      128
#define XB_XCNT(j)  (256  + 64 * (j))
#define XB_XSUB(j)  (1280 + 64 * (j))
#define XB_XGEN(j)  (2304 + 64 * (j))
#define XB_TOP      3328
#define XB_TOPGEN   3392
#define XCD_BAR_WORDS 3456
#define XB_SPIN_CAP (1u << 18)

__device__ __forceinline__ unsigned xb_ld(unsigned* p)              { return __hip_atomic_load(p, __ATOMIC_RELAXED, __HIP_MEMORY_SCOPE_AGENT); }
__device__ __forceinline__ unsigned xb_add(unsigned* p, unsigned v) { return __hip_atomic_fetch_add(p, v, __ATOMIC_RELAXED, __HIP_MEMORY_SCOPE_AGENT); }
__device__ __forceinline__ unsigned xb_xcc_id() { return (unsigned)__builtin_amdgcn_s_getreg((3 << 11) | 20) & 0xFu; }
#define XB_SPIN(cond, bar) do { unsigned _sp = 0; while (cond) { __builtin_amdgcn_s_sleep(1); \
    if ((++_sp & 255u) == 0u) { if (xb_ld(&(bar)[XB_TMO])) break; if (_sp > XB_SPIN_CAP) { atomicAdd(&(bar)[XB_TMO], 1u); break; } } } } while (0)

struct XcdBarrier {
    unsigned* bar; unsigned x; unsigned gsize;
    volatile LAS unsigned* st;
};

__device__ __forceinline__ XcdBarrier xcd_barrier_post(unsigned* bar, volatile LAS unsigned* st, unsigned gsize) {
    XcdBarrier b; b.bar = bar; b.x = xb_xcc_id(); b.st = st; b.gsize = gsize;
    if (threadIdx.x == 0) (void)xb_add(&bar[XB_XCNT(b.x)], 1u);
    return b;
}
__device__ __forceinline__ void xcd_barrier_complete(unsigned* bar, unsigned x, unsigned G, unsigned& nloc, unsigned& nx) {
    unsigned sum, cnt, mine, sp = 0u;
    for (;;) {
        sum = 0u; cnt = 0u; mine = 0u;
#pragma unroll
        for (unsigned j = 0; j < 16; ++j) { const unsigned c = xb_ld(&bar[XB_XCNT(j)]); sum += c; cnt += (c > 0u) ? 1u : 0u; mine = (j == x) ? c : mine; }
        if (sum == G) break;
        __builtin_amdgcn_s_sleep(1);
        if ((++sp & 255u) == 0u) { if (xb_ld(&bar[XB_TMO])) break; if (sp > XB_SPIN_CAP) { atomicAdd(&bar[XB_TMO], 1u); break; } }
    }
    nloc = mine > 0u ? mine : 1u; nx = cnt > 0u ? cnt : 1u;
}

__device__ __forceinline__ void xcd_barrier(const XcdBarrier& b) {
    asm volatile("s_waitcnt vmcnt(0)" ::: "memory");
    __syncthreads();
    if (threadIdx.x == 0) {
        unsigned* bar = b.bar;
        __builtin_amdgcn_s_waitcnt(0);
        unsigned nloc = b.st[0], nx = b.st[1];
        if (nloc == 0u) { xcd_barrier_complete(bar, b.x, b.gsize, nloc, nx); b.st[0] = nloc; b.st[1] = nx; }
        const unsigned old = xb_add(&bar[XB_XSUB(b.x)], 1u);
        const unsigned gen = old / nloc;
        if (old + 1u == (gen + 1u) * nloc) {
            __builtin_amdgcn_fence(__ATOMIC_RELEASE, "agent");
            asm volatile("s_waitcnt vmcnt(0)" ::: "memory");
            const unsigned og = xb_add(&bar[XB_TOP], 1u);
            const unsigned tg = og / nx;
            if (og + 1u == (tg + 1u) * nx) xb_add(&bar[XB_TOPGEN], 1u);
            else XB_SPIN(xb_ld(&bar[XB_TOPGEN]) == tg, bar);
            __builtin_amdgcn_fence(__ATOMIC_ACQUIRE, "agent");
            xb_add(&bar[XB_XGEN(b.x)], 1u);
            asm volatile("s_waitcnt vmcnt(0)" ::: "memory");
        } else {
            XB_SPIN(xb_ld(&bar[XB_XGEN(b.x)]) == gen, bar);
            __builtin_amdgcn_fence(__ATOMIC_ACQUIRE, "agent");
            asm volatile("s_waitcnt vmcnt(0)" ::: "memory");
        }
    }
    __syncthreads();
}

struct GroupOrder {
    int nN, k, xh, cph, nunits;
    __device__ void init(int N, int k_, int xh_, int cph_) { nN = N / 256; k = k_; xh = xh_; cph = cph_; nunits = 16 * nN; }
    __device__ bool next(int i, pg8::Unit& u) const { const int L = i * cph + k; if (L >= nunits) return false; const int nig = 8 * nN, gid = L / nig, w = L % nig; u.pm = 16 * xh + 8 * gid + (w & 7); u.pn = w >> 3; return true; }
    __device__ __forceinline__ void a_ready(const pg8::Unit&) const {}
    __device__ __forceinline__ void done(const pg8::Unit&) const {}
};

typedef const f32x4 (&AccRef)[2][2][4][2];
__device__ __forceinline__ float modv(const float* macc, const float* b_ada, int b, int j) { return macc[b * MODW + j] + b_ada[j]; }
__device__ __forceinline__ f32x4 modv4(const float* macc, const float* b_ada, int b, int j) { return *(const f32x4*)(macc + b * MODW + j) + *(const f32x4*)(b_ada + j); }

struct EpiProj {
    static constexpr bool PERM = true, PERMA = false, AFTER_DRAIN = false, PREFETCH = false;
    bf16* O; float* hss; float asc; int pm0;
    __device__ __forceinline__ void operator()(AccRef acc, const pg8::Unit& u, int wr, int wc, int fr, int fq) const {
        const int row0 = u.pm * 256 + wr * 64 + fr, col0 = u.pn * 256 + wc * 32 + 8 * fq;
#pragma unroll
        for (int ai = 0; ai < 2; ++ai)
#pragma unroll
            for (int m = 0; m < 4; ++m) { bf16* rowp = O + (size_t)(row0 + ai * 128 + m * 16) * INW + col0;
#pragma unroll
                for (int bj = 0; bj < 2; ++bj) { const f32x4 v0 = acc[ai][bj][m][0], v1 = acc[ai][bj][m][1];
                    v4u w; w.x = cvt_pk(v0[0], v0[1]); w.y = cvt_pk(v0[2], v0[3]); w.z = cvt_pk(v1[0], v1[1]); w.w = cvt_pk(v1[2], v1[3]);
                    { v4u* pp_ = (v4u*)(rowp + bj * 128); asm volatile("global_store_dwordx4 %0, %1, off sc1\n\ts_nop 2" :: "v"(pp_), "v"(w) : "memory"); } } }
        if (u.pn < 4) {
            float sr[2][4][2];
#pragma unroll
            for (int ai = 0; ai < 2; ++ai)
#pragma unroll
                for (int m = 0; m < 4; ++m)
#pragma unroll
                    for (int bj = 0; bj < 2; ++bj) { const f32x4 v0 = acc[ai][bj][m][0], v1 = acc[ai][bj][m][1];
                        sr[ai][m][bj] = red_sum_16_32(((v0[0] * v0[0] + v0[1] * v0[1]) + (v0[2] * v0[2] + v0[3] * v0[3])) + ((v1[0] * v1[0] + v1[1] * v1[1]) + (v1[2] * v1[2] + v1[3] * v1[3]))); }
            if (fq == 0) {
#pragma unroll
                for (int ai = 0; ai < 2; ++ai)
#pragma unroll
                    for (int m = 0; m < 4; ++m)
#pragma unroll
                        for (int bj = 0; bj < 2; ++bj) atomicAdd(hss + (size_t)(4 * u.pn + 2 * bj + (wc >> 1)) * MT + pm0 * 256 + row0 + ai * 128 + m * 16, sr[ai][m][bj] * asc);
            }
        }
    }
};
struct EpiOut {
    static constexpr bool PERM = true, PERMA = false, AFTER_DRAIN = false, PREFETCH = false;
    const float* xp; const float* xs; unsigned short* x1; bf16* xg2; float* rss2; const float* g1t; const float* G2t; float asc; int pm0;
    __device__ __forceinline__ void operator()(AccRef acc, const pg8::Unit& u, int wr, int wc, int fr_, int fq_) const {
        int fr = fr_, fq = fq_; asm volatile("" : "+v"(fr), "+v"(fq));
        const int gpm = pm0 + u.pm, b = batch_of_tile(gpm), grow0 = gpm * 256 + wr * 64 + fr, cl = wc * 32 + 8 * fq;
        const char* xb = (const char*)(gpm * 256 < NPR ? xp + (size_t)gpm * 256 * D : xs + ((size_t)gpm * 256 - NPR) * D) + (size_t)u.pn * 1024;
        char* x1b = (char*)(x1 + (size_t)u.pm * 256 * D) + (size_t)u.pn * 512;
        char* xgb = (char*)(xg2 + ((size_t)(u.pm * 16 + u.pn * 4 + (wc >> 1)) << 14));
        const unsigned loff = (unsigned)(((wr * 64 + fr) * D + cl) * 4), xgl = (unsigned)(((wr * 64 + fr) * 64 + (wc & 1) * 32 + 8 * fq) * 2);
        float ss[2][4];
#pragma unroll
        for (int ai = 0; ai < 2; ++ai)
#pragma unroll
            for (int m = 0; m < 4; ++m) ss[ai][m] = 0.f;
        f32x4 xv[2][2][2], g1a[2][2], G2a[2][2];
#define EO_LOADG(bj) do { _Pragma("unroll") for (int n = 0; n < 2; ++n) { const int c_ = u.pn * 256 + (bj) * 128 + cl + 4 * n; g1a[bj][n] = *(const f32x4*)(g1t + b * D + c_); G2a[bj][n] = *(const f32x4*)(G2t + b * D + c_); } } while (0)
#define EO_LOADB(k) do { _Pragma("unroll") for (int mm = 0; mm < 2; ++mm) { const char* xr = xb + (size_t)(((((k) >> 1) & 1) * 128 + (2 * ((k) & 1) + mm) * 16) * D + ((k) >> 2) * 128) * 4; \
            xv[(k) & 1][mm][0] = *(const f32x4*)(xr + loff); xv[(k) & 1][mm][1] = *(const f32x4*)(xr + 16 + loff); } } while (0)
        EO_LOADG(0); EO_LOADB(0);
#pragma unroll
        for (int k = 0; k < 8; ++k) {
            const int bj = k >> 2, ai = (k >> 1) & 1;
            if (k + 1 < 8) EO_LOADB(k + 1);
            if (k == 3) EO_LOADG(1);
            asm volatile("" ::: "memory");
#pragma unroll
            for (int mm = 0; mm < 2; ++mm) { const int m = 2 * (k & 1) + mm;
                const f32x4 v0 = xv[k & 1][mm][0] + g1a[bj][0] * acc[ai][bj][m][0], v1 = xv[k & 1][mm][1] + g1a[bj][1] * acc[ai][bj][m][1];
                ss[ai][m] += ((v0[0] * v0[0] + v0[1] * v0[1]) + (v0[2] * v0[2] + v0[3] * v0[3])) + ((v1[0] * v1[0] + v1[1] * v1[1]) + (v1[2] * v1[2] + v1[3] * v1[3]));
                const f32x4 h0 = v0 * G2a[bj][0], h1 = v1 * G2a[bj][1]; v4u w; w.x = cvt_pk(h0[0], h0[1]); w.y = cvt_pk(h0[2], h0[3]); w.z = cvt_pk(h1[0], h1[1]); w.w = cvt_pk(h1[2], h1[3]);
                *(v4u*)(xgb + (size_t)((2 * bj) << 15) + (size_t)((ai * 128 + m * 16) * 128) + xgl) = w;
            }
            asm volatile("" ::: "memory");
        }
#undef EO_LOADG
#undef EO_LOADB
#pragma unroll
        for (int ai = 0; ai < 2; ++ai)
#pragma unroll
            for (int m = 0; m < 4; ++m) ss[ai][m] = red_sum_16_32(ss[ai][m]);
        if (fq == 0) {
#pragma unroll
            for (int ai = 0; ai < 2; ++ai)
#pragma unroll
                for (int m = 0; m < 4; ++m) atomicAdd(rss2 + grow0 + ai * 128 + m * 16, ss[ai][m] * asc);
        }
    }
};
__device__ __forceinline__ float dpp_shr1(float old, float src) { return __builtin_bit_cast(float, __builtin_amdgcn_update_dpp(__builtin_bit_cast(int, old), __builtin_bit_cast(int, src), 0x111, 0xf, 0xf, false)); }
__device__ __forceinline__ float dpp_shl1(float old, float src) { return __builtin_bit_cast(float, __builtin_amdgcn_update_dpp(__builtin_bit_cast(int, old), __builtin_bit_cast(int, src), 0x101, 0xf, 0xf, false)); }
struct EpiConvAct {
    static constexpr bool PERM = true, PERMA = true, AFTER_DRAIN = false, PREFETCH = true;
    bf16* act; float* edge; const float* rss2; const float* c2; const float* convp; const float* cbp; LAS float* X; int pm0;
    __device__ __forceinline__ void prefetch(const pg8::Unit& u, int buf, int wid, int lane) const {
        if (wid < 6) {
            const int gpm = pm0 + u.pm, b = batch_of_tile(gpm);
            const float* src = wid == 0 ? rss2 + gpm * 256 : wid == 1 ? c2 + b * FF2 + u.pn * 256 : wid < 5 ? convp + (wid - 2) * FF2 + u.pn * 256 : cbp + u.pn * 256;
            __builtin_amdgcn_global_load_lds((const unsigned*)(src + 4 * lane), (LAS unsigned*)(X + 2048 + buf * 1536 + wid * 256), 16, 0, 0);
        }
    }
    __device__ __forceinline__ void run(f32x4 (&acc)[2][2][4][2], const pg8::Unit& u, int wr, int wc, int fr_, int fq_, int buf) const {
        int fr = fr_, fq = fq_; asm volatile("" : "+v"(fr), "+v"(fq));
        const int gpm = pm0 + u.pm, colL = wc * 32 + 8 * fq, colg = u.pn * 256 + colL;
        const LAS float* T = X + 2048 + buf * 1536; const LAS float* TB = T + 512;
        {   f32x4 rs[2];
#pragma unroll
            for (int ai = 0; ai < 2; ++ai) { const f32x4 q = *(const LAS f32x4*)(T + 128 * ai + 64 * wr + 4 * fr);
                rs[ai][0] = rsqrtf(q[0] * (1.0f / D) + EPS); rs[ai][1] = rsqrtf(q[1] * (1.0f / D) + EPS); rs[ai][2] = rsqrtf(q[2] * (1.0f / D) + EPS); rs[ai][3] = rsqrtf(q[3] * (1.0f / D) + EPS); }
#pragma unroll
            for (int bj = 0; bj < 2; ++bj)
#pragma unroll
                for (int n = 0; n < 2; ++n) { const f32x4 c2v = *(const LAS f32x4*)(T + 256 + 128 * bj + colL + 4 * n);
#pragma unroll
                    for (int ai = 0; ai < 2; ++ai)
#pragma unroll
                        for (int m = 0; m < 4; ++m) acc[ai][bj][m][n] = acc[ai][bj][m][n] * rs[ai][m] + c2v; } }
        if (fr == 0 || fr == 15) {
            const bool lastr = fr == 15;
            LAS float* xb = X + (lastr ? 256 : 0) + colL;
#pragma unroll
            for (int bj = 0; bj < 2; ++bj)
#pragma unroll
                for (int n = 0; n < 2; ++n)
#pragma unroll
                    for (int ai = 0; ai < 2; ++ai) { const int rb = 2 * ai + wr; f32x4 v;
#pragma unroll
                        for (int e = 0; e < 4; ++e) v[e] = lastr ? acc[ai][bj][3][n][e] : acc[ai][bj][0][n][e];
                        *(LAS f32x4*)(xb + rb * 512 + 128 * bj + 4 * n) = v; }
        }
        asm volatile("s_waitcnt lgkmcnt(0)" ::: "memory"); __builtin_amdgcn_s_barrier(); asm volatile("" ::: "memory");
        if (wr == 0 && fr == 0) {
#pragma unroll
            for (int bj = 0; bj < 2; ++bj)
#pragma unroll
                for (int n = 0; n < 2; ++n) { float* ep = edge + ((size_t)gpm * 4 + 0) * FF2 + colg + 128 * bj + 4 * n; *(f32x4*)ep = acc[0][bj][0][n]; *(f32x4*)(ep + FF2) = acc[0][bj][1][n]; }
        }
        if (wr == 1 && fr == 15) {
#pragma unroll
            for (int bj = 0; bj < 2; ++bj)
#pragma unroll
                for (int n = 0; n < 2; ++n) { float* ep = edge + ((size_t)gpm * 4 + 2) * FF2 + colg + 128 * bj + 4 * n; *(f32x4*)ep = acc[1][bj][2][n]; *(f32x4*)(ep + FF2) = acc[1][bj][3][n]; }
        }
        typedef float f32x2 __attribute__((ext_vector_type(2)));
#pragma unroll
        for (int ai = 0; ai < 2; ++ai) { const int rb = 2 * ai + wr;
            unsigned pk[4][2][2];
#pragma unroll
            for (int n = 0; n < 2; ++n) {
#pragma unroll
                for (int eh = 0; eh < 2; ++eh) {
                    f32x2 sg[4];
#pragma unroll
                    for (int bj = 0; bj < 2; ++bj) { const int col = colg + 128 * bj + 4 * n + 2 * eh;
                        const int tcol = 128 * bj + colL + 4 * n + 2 * eh;
                        const f32x2 w0 = *(const LAS f32x2*)(TB + tcol), w1 = *(const LAS f32x2*)(TB + 256 + tcol), w2 = *(const LAS f32x2*)(TB + 512 + tcol), cb = *(const LAS f32x2*)(TB + 768 + tcol);
                        const int ia = rb > 0 ? (rb - 1) * 2 + 1 : 0, ib = rb < 3 ? (rb + 1) * 2 : 7;
                        const f32x2 above = *(const LAS f32x2*)(X + ia * 256 + 128 * bj + colL + 4 * n + 2 * eh);
                        const f32x2 below = *(const LAS f32x2*)(X + ib * 256 + 128 * bj + colL + 4 * n + 2 * eh);
                        f32x2 U0, U1, U2, U3;
                        U0[0] = acc[ai][bj][0][n][2 * eh]; U0[1] = acc[ai][bj][0][n][2 * eh + 1]; U1[0] = acc[ai][bj][1][n][2 * eh]; U1[1] = acc[ai][bj][1][n][2 * eh + 1];
                        U2[0] = acc[ai][bj][2][n][2 * eh]; U2[1] = acc[ai][bj][2][n][2 * eh + 1]; U3[0] = acc[ai][bj][3][n][2 * eh]; U3[1] = acc[ai][bj][3][n][2 * eh + 1];
                        f32x2 up0, dn3;
                        up0[0] = dpp_shr1(above[0], U3[0]); up0[1] = dpp_shr1(above[1], U3[1]); dn3[0] = dpp_shl1(below[0], U0[0]); dn3[1] = dpp_shl1(below[1], U0[1]);
                        f32x2 cv[4];
                        cv[0] = w2 * U1 + (w1 * U0 + (w0 * up0 + cb));
                        cv[1] = w2 * U2 + (w1 * U1 + (w0 * U0 + cb));
                        cv[2] = w2 * U3 + (w1 * U2 + (w0 * U1 + cb));
                        cv[3] = w2 * dn3 + (w1 * U3 + (w0 * U2 + cb));
                        if (bj == 0) {
#pragma unroll
                            for (int m = 0; m < 4; ++m) {
                                f32x2 ex; ex[0] = __builtin_amdgcn_exp2f(-cv[m][0]); ex[1] = __builtin_amdgcn_exp2f(-cv[m][1]);
                                const f32x2 den = ex + 1.0f; f32x2 rc; rc[0] = __builtin_amdgcn_rcpf(den[0]); rc[1] = __builtin_amdgcn_rcpf(den[1]);
                                sg[m] = cv[m] * rc; }
                        } else {
#pragma unroll
                            for (int m = 0; m < 4; ++m) { const f32x2 av = sg[m] * cv[m]; pk[m][n][eh] = cvt_pk(av[0], av[1]); }
                        }
                    }
                }
            }
#pragma unroll
            for (int m = 0; m < 4; ++m) { const int tr = 128 * ai + 64 * wr + 4 * fr + m; v4u w; w.x = pk[m][0][0]; w.y = pk[m][0][1]; w.z = pk[m][1][0]; w.w = pk[m][1][1];
                __builtin_nontemporal_store(w, (v4u*)(act + blk_off(u.pm * 256 + tr, u.pn * 128 + colL, FF))); }
        }
    }
};
struct EpiDown {
    static constexpr bool PERM = true, PERMA = false, AFTER_DRAIN = false, PREFETCH = false;
    const bf16* xg2; float* out; const float* g2t; const float* iG2t; int pm0;
    __device__ __forceinline__ void operator()(AccRef acc, const pg8::Unit& u, int wr, int wc, int fr_, int fq_) const {
        int fr = fr_, fq = fq_; asm volatile("" : "+v"(fr), "+v"(fq));
        const int gpm = pm0 + u.pm, b = batch_of_tile(gpm), cl = wc * 32 + 8 * fq;
        const char* xb = (const char*)(xg2 + ((size_t)(u.pm * 16 + u.pn * 4 + (wc >> 1)) << 14));
        char* ob = (char*)(out + (size_t)gpm * 256 * D) + (size_t)u.pn * 1024;
        const unsigned loff = (unsigned)(((wr * 64 + fr) * D + cl) * 4), xgl = (unsigned)(((wr * 64 + fr) * 64 + (wc & 1) * 32 + 8 * fq) * 2);
        v4u xv[2][2][4];
#pragma unroll
        for (int bj = 0; bj < 2; ++bj)
#pragma unroll
            for (int ai = 0; ai < 2; ++ai)
#pragma unroll
                for (int m = 0; m < 4; ++m) xv[bj][ai][m] = *(const v4u*)(xb + (size_t)((2 * bj) << 15) + (size_t)((ai * 128 + m * 16) * 128) + xgl);
        f32x4 g2a[2][2], iGa[2][2];
#pragma unroll
        for (int bj = 0; bj < 2; ++bj)
#pragma unroll
            for (int n = 0; n < 2; ++n) { const int c_ = b * D + u.pn * 256 + bj * 128 + cl + 4 * n; g2a[bj][n] = *(const f32x4*)(g2t + c_); iGa[bj][n] = *(const f32x4*)(iG2t + c_); }
        asm volatile("" ::: "memory");
        const bool lastr = (u.pm & 8) != 0;
#pragma unroll
        for (int bj = 0; bj < 2; ++bj) {
#pragma unroll
            for (int ai = 0; ai < 2; ++ai)
#pragma unroll
                for (int m = 0; m < 4; ++m) { char* orow = ob + (size_t)((ai * 128 + m * 16) * D + bj * 128) * 4; const v4u w = xv[bj][ai][m];
                    const f32x4 x0 = (f32x4){bflo(w.x), bfhi(w.x), bflo(w.y), bfhi(w.y)} * iGa[bj][0], x1v = (f32x4){bflo(w.z), bfhi(w.z), bflo(w.w), bfhi(w.w)} * iGa[bj][1];
                    const f32x4 o0 = x0 + g2a[bj][0] * acc[ai][bj][m][0], o1 = x1v + g2a[bj][1] * acc[ai][bj][m][1];
                    if (lastr) { __builtin_nontemporal_store(o0, (f32x4*)(orow + loff)); __builtin_nontemporal_store(o1, (f32x4*)(orow + 16 + loff)); }
                    else { *(f32x4*)(orow + loff) = o0; *(f32x4*)(orow + 16 + loff) = o1; } }
        }
    }
};

__device__ __forceinline__ void transpose_item(const float* W, int ldw, int k0, int n0, bf16* WT, int ldt, int drow0, int kd0, LAS float* scr, int lane) {
    {
        f32x4 t[8]; const int kq = lane >> 3, nq = lane & 7;
#pragma unroll
        for (int i = 0; i < 8; ++i) t[i] = __builtin_nontemporal_load((const f32x4*)(W + (size_t)(k0 + kq + 8 * i) * ldw + n0 + 4 * nq));
#pragma unroll
        for (int i = 0; i < 8; ++i) { LAS float* d = scr + (kq + 8 * i) * 33 + 4 * nq; d[0] = t[i][0]; d[1] = t[i][1]; d[2] = t[i][2]; d[3] = t[i][3]; } }
    LDS_WAIT(); asm volatile("" ::: "memory");
    const int c = lane & 7;
#pragma unroll
    for (int j = 0; j < 4; ++j) { const int n = (lane >> 3) + 8 * j; const LAS float* s = scr + (8 * c) * 33 + n;
        v4u o; o.x = pk2(s[0 * 33], s[1 * 33]); o.y = pk2(s[2 * 33], s[3 * 33]); o.z = pk2(s[4 * 33], s[5 * 33]); o.w = pk2(s[6 * 33], s[7 * 33]);
        *(v4u*)(WT + blk_off(drow0 + n, kd0 + 8 * c, ldt)) = o; }
    LDS_WAIT(); asm volatile("" ::: "memory");
}
template <class Fill> __device__ __forceinline__ void gemv10_item(const float* W, int ldw, int k0, int n, LAS float* sb, float* dst, int dstride, int dcol, float asc, const Fill& fill) {
    float w[64];
#pragma unroll
    for (int kk = 0; kk < 64; ++kk) w[kk] = __builtin_nontemporal_load(W + (size_t)(k0 + kk) * ldw + n);
    fill(sb);
    LDS_WAIT(); asm volatile("" ::: "memory");
    float acc[NBATCH];
#pragma unroll
    for (int b = 0; b < NBATCH; ++b) acc[b] = 0.f;
#pragma unroll
    for (int kk = 0; kk < 64; ++kk) {
        const f32x4 s0 = *(const LAS f32x4*)(sb + kk * 12), s1 = *(const LAS f32x4*)(sb + kk * 12 + 4), s2 = *(const LAS f32x4*)(sb + kk * 12 + 8);
        acc[0] += w[kk] * s0[0]; acc[1] += w[kk] * s0[1]; acc[2] += w[kk] * s0[2]; acc[3] += w[kk] * s0[3];
        acc[4] += w[kk] * s1[0]; acc[5] += w[kk] * s1[1]; acc[6] += w[kk] * s1[2]; acc[7] += w[kk] * s1[3];
        acc[8] += w[kk] * s2[0]; acc[9] += w[kk] * s2[1];
    }
#pragma unroll
    for (int b = 0; b < NBATCH; ++b) atomicAdd(dst + (size_t)b * dstride + dcol, acc[b] * asc);
    LDS_WAIT(); asm volatile("" ::: "memory");
}

template <int HW> __device__ __forceinline__ void pool_group(const bf16* PROJ, bf16* CAT, int pbase, int T, int t0, int ch) {
    constexpr int NL = 2 * HW + 3;
    v4u x[NL];
#pragma unroll
    for (int i = 0; i < NL; ++i) { const int s = t0 - HW + i; const v4u z = {0u, 0u, 0u, 0u}; x[i] = (s >= 0 && s < T) ? *(const v4u*)(PROJ + (size_t)(pbase + s) * INW + 3 * ATTW + 8 * ch) : z; }
    float S[8];
#pragma unroll
    for (int c = 0; c < 8; ++c) S[c] = 0.f;
#define POOL_ADD(sgn, VV) do { S[0] += sgn bflo((VV).x); S[1] += sgn bfhi((VV).x); S[2] += sgn bflo((VV).y); S[3] += sgn bfhi((VV).y); S[4] += sgn bflo((VV).z); S[5] += sgn bfhi((VV).z); S[6] += sgn bflo((VV).w); S[7] += sgn bfhi((VV).w); } while (0)
#pragma unroll
    for (int i = 0; i < 2 * HW; ++i) POOL_ADD(+, x[i]);
#pragma unroll
    for (int k = 0; k < 4; ++k) {
        if (k > 0) { POOL_ADD(-, x[k - 1]); POOL_ADD(+, x[k - 1 + 2 * HW]); }
        const int t = t0 + k; const float ic = 1.0f / (float)(min(t + HW, T) - max(t - HW, 0)); const v4u w = x[HW + k];
        v4u ow; ow.x = pk2(S[0] * ic - bflo(w.x), S[1] * ic - bfhi(w.x)); ow.y = pk2(S[2] * ic - bflo(w.y), S[3] * ic - bfhi(w.y));
        ow.z = pk2(S[4] * ic - bflo(w.z), S[5] * ic - bfhi(w.z)); ow.w = pk2(S[6] * ic - bflo(w.w), S[7] * ic - bfhi(w.w));
        *(v4u*)(CAT + blk_off(pbase + t, ATTW + 8 * ch, D)) = ow;
    }
#undef POOL_ADD
}

struct Args { const float* in[19]; float* out; unsigned char* ws; int ph_lo, ph_hi, row0, nrows; };
enum { I_XP = 0, I_XS, I_CP, I_CS, I_WADA, I_BADA, I_N1G, I_N2G, I_WIN, I_QNG, I_KNG, I_RPB, I_WPOOL, I_PSCALE, I_WOUT, I_WUP, I_CONVW, I_CONVB, I_WDOWN };
constexpr int N_PHASES = 8;
#ifndef SW_PHASE
#define SW_PHASE -1
#endif
#ifndef SW_SEL
#define SW_SEL 0
#endif
#ifndef SW_SCALE
#define SW_SCALE 8
#endif
#define SW_PTR(k) ((SW_PHASE == (k) && blockIdx.x == 0) ? (volatile LAS unsigned*)(lds + LDSCTL_OFF + 64) : (volatile LAS unsigned*)nullptr)
#ifndef PROBE_MASK
#define PROBE_MASK 0
#endif
#ifndef PROBE_N
#define PROBE_N 0
#endif
#define PROBE_REPS(k) ((((PROBE_MASK) >> (k)) & 1) ? (PROBE_N) : 0)
#ifndef MK_ONE_LAUNCH
#define MK_ONE_LAUNCH 1
#endif

__global__ void __launch_bounds__(NWAVES * 64, 2) fwd(Args a) {
    extern __shared__ __attribute__((aligned(16))) unsigned char lds_raw[];
    LAS unsigned char* lds = (LAS unsigned char*)lds_raw;
    volatile LAS unsigned* MISC = (volatile LAS unsigned*)(lds + MISC_OFF);
    const int wave = __builtin_amdgcn_readfirstlane((int)threadIdx.x >> 6);
#define LANE_SETUP() int tid_ = threadIdx.x; asm volatile("" : "+v"(tid_)); const int tid = tid_, lane = tid & 63; (void)lane
    const int G = gridDim.x; const int bx = blockIdx.x; const int vcu = (bx % 8) * (G / 8) + bx / 8;
    const int gw = vcu * NWAVES + wave, NGW = G * NWAVES;
    const int grp = (bx & 7) >> 1, xh = bx & 1, gk = bx >> 3, cph = G >> 3, gsz = G >> 2, pm0 = GPANELS * grp;
    unsigned char* ws = a.ws;
    unsigned* ctl = (unsigned*)(ws + WS_CTL);
    float* macc = (float*)(ws + OFF_MOD); float* c2acc = (float*)(ws + OFF_C2); float* rss2 = (float*)(ws + OFF_RSS2); float* hss = (float*)(ws + OFF_HSS);
    bf16* WinT = (bf16*)(ws + WS_WIN); bf16* WoT = (bf16*)(ws + WS_WOUT); bf16* WupT = (bf16*)(ws + WS_WUP); bf16* WdT = (bf16*)(ws + WS_WDN);
    float* convp = (float*)(ws + WS_SMALL); float* cbp = convp + 3 * FF2;
    float* g1t = (float*)(ws + WS_SMALL + 131072); float* G2t = g1t + NBATCH * D; float* g2t = G2t + NBATCH * D; float* iG2t = g2t + NBATCH * D;
    float* EDGE = (float*)(ws + WS_EDGE);
    unsigned char* slice = ws + WS_SLICE0 + (size_t)grp * WS_SLICE;
    bf16* H1g = (bf16*)(slice + SL_H1); bf16* PROJg = (bf16*)(slice + SL_PROJ); bf16* CATg = (bf16*)(slice + SL_CAT); unsigned short* X1g = (unsigned short*)(slice + SL_X1); bf16* XG2g = (bf16*)(slice + SL_XG2); bf16* ACTg = (bf16*)(slice + SL_ACT);
    const float* b_ada = a.in[I_BADA];

    for (int u = threadIdx.x; u < (LDS_BYTES - LDSCTL_OFF) / 4; u += NWAVES * 64) ((LAS unsigned*)(lds + LDSCTL_OFF))[u] = 0u;
    __syncthreads();
    XcdBarrier bar = xcd_barrier_post(ctl + CW_BAR, MISC + 8, (unsigned)G);
    XcdBarrier barg = xcd_barrier_post(ctl + CW_GBAR + grp * XCD_BAR_WORDS, MISC + 12, (unsigned)gsz);
#define IN(k) true
#define SEAM(k) do { if ((k) < 2) xcd_barrier(bar); else xcd_barrier(barg); } while (0)

    for (int rep = 0; rep <= PROBE_REPS(0); ++rep) { const float asc = rep ? 0.f : 1.f; (void)asc;
    if (IN(0)) {
        LANE_SETUP();
        LAS float* scr = (LAS float*)(lds + RING_OFF + wave * 16384);
        for (int it = gw; it < 16 * 96; it += NGW) {
            const int kc = it / 96, nc = it % 96, k = 64 * kc + lane;
            const float* cp = a.in[I_CP]; const float* cs = a.in[I_CS];
            gemv10_item(a.in[I_WADA], MODW, 64 * kc, 64 * nc + lane, scr, macc, MODW, 64 * nc + lane, asc, [=](LAS float* sb) {
#pragma unroll
                for (int b = 0; b < NBATCH; ++b) { const float c = b < 8 ? cp[b * D + k] : cs[(b - 8) * D + k]; sb[lane * 12 + b] = silu_f(c); } });
        }
    }
    if (rep < PROBE_REPS(0)) xcd_barrier(bar); }
    SEAM(0);

    for (int rep = 0; rep <= PROBE_REPS(1); ++rep) { const float asc = rep ? 0.f : 1.f; (void)asc;
    if (IN(1)) {
        LANE_SETUP();
        LAS float* scr = (LAS float*)(lds + RING_OFF + wave * 16384);
        constexpr int I0 = 16 * 64, I1 = I0 + 8 * 32, I2 = I1 + 16 * 176, I4 = I2 + 44 * 32, I5 = I4 + 4 * 16 * 16, I6 = I5 + 88, I7 = I6 + NBATCH * 16;
        for (int it = gw; it < I7; it += NGW) {
            if (it < I0) { const int kb = it / 64, nb = it % 64; transpose_item(a.in[I_WIN], INW, 64 * kb, 32 * nb, WinT, D, 32 * nb, 64 * kb, scr, lane); }
            else if (it < I1) { const int r = it - I0, kb = r / 32, nb = r % 32; transpose_item(a.in[I_WOUT], D, 64 * kb, 32 * nb, WoT, D, 32 * nb, 64 * kb, scr, lane); }
            else if (it < I2) { const int r = it - I1, kb = r / 176, nb = r % 176; transpose_item(a.in[I_WUP], FF2, 64 * kb, 32 * nb, WupT, D, permcol(32 * nb), 64 * kb, scr, lane);
                LAS float* sb2 = scr + 64 * 33 + 16;
#pragma unroll
                for (int b = 0; b < NBATCH; ++b) sb2[lane * 12 + b] = modv(macc, b_ada, b, 3 * D + 64 * kb + lane);
                LDS_WAIT(); asm volatile("" ::: "memory");
                const int cn = lane & 31, bh = 5 * (lane >> 5);
                float ac[5] = {0.f, 0.f, 0.f, 0.f, 0.f};
#pragma unroll 8
                for (int kk = 0; kk < 64; ++kk) { const float w = scr[kk * 33 + cn];
#pragma unroll
                    for (int i = 0; i < 5; ++i) ac[i] += w * sb2[kk * 12 + bh + i]; }
#pragma unroll
                for (int i = 0; i < 5; ++i) atomicAdd(c2acc + (size_t)(bh + i) * FF2 + permcol(32 * nb) + cn, ac[i] * asc);
                LDS_WAIT(); asm volatile("" ::: "memory"); }
            else if (it < I4) { const int r = it - I2, kb = r / 32, nb = r % 32; transpose_item(a.in[I_WDOWN], D, 64 * kb, 32 * nb, WdT, FF, 32 * nb, 64 * kb, scr, lane); }
            else if (it < I5) {
                const int r = it - I4, g = r / 256, cb = (r / 16) % 16, nb = r % 16, n = 64 * nb + lane;
                float acc[8];
#pragma unroll
                for (int i = 0; i < 8; ++i) acc[i] = 0.f;
                const float* wp = a.in[I_WPOOL] + (size_t)(g * 128 + 8 * cb) * 128;
#pragma unroll 8
                for (int d = 0; d < 128; ++d) {
                    const float wo = a.in[I_WOUT][(size_t)(ATTW + g * 128 + d) * D + n] * a.in[I_PSCALE][g * 128 + d];
#pragma unroll
                    for (int i = 0; i < 8; ++i) acc[i] += wp[i * 128 + d] * wo;
                }
                v4u o; o.x = pk2(acc[0], acc[1]); o.y = pk2(acc[2], acc[3]); o.z = pk2(acc[4], acc[5]); o.w = pk2(acc[6], acc[7]);
                *(v4u*)(WoT + blk_off(n, ATTW + g * 128 + 8 * cb, D)) = o;
            }
            else if (it < I6) { const int n = 64 * (it - I5) + lane, pc = permcol(n);
                const float cs_ = n < FF ? 1.4426950408889634f : 0.6931471805599453f;
                convp[pc] = a.in[I_CONVW][n] * cs_; convp[FF2 + pc] = a.in[I_CONVW][FF2 + n] * cs_; convp[2 * FF2 + pc] = a.in[I_CONVW][2 * FF2 + n] * cs_; cbp[pc] = a.in[I_CONVB][n] * cs_; }
            else { const int r = it - I6, b = r / 16, j = 64 * (r % 16) + lane;
                g1t[b * D + j] = modv(macc, b_ada, b, 2 * D + j); G2t[b * D + j] = a.in[I_N2G][j] * (modv(macc, b_ada, b, 4 * D + j) + 1.0f); g2t[b * D + j] = modv(macc, b_ada, b, 5 * D + j);
                { const float G2v = a.in[I_N2G][j] * (modv(macc, b_ada, b, 4 * D + j) + 1.0f); iG2t[b * D + j] = G2v != 0.f ? 1.0f / G2v : 0.f; } }
        }
        for (int r0 = gw * 16; r0 < MT; r0 += NGW * 16) {
            const int b = batch_of_row(r0);
            bf16* h1b = (bf16*)(ws + WS_SLICE0 + (size_t)(r0 / GROWS) * WS_SLICE + SL_H1);
            f32x4 Gv[4], Sv[4];
#pragma unroll
            for (int j = 0; j < 4; ++j) { const int c = 4 * lane + 256 * j; Gv[j] = *(const f32x4*)(a.in[I_N1G] + c) * (modv4(macc, b_ada, b, D + c) + 1.0f); Sv[j] = modv4(macc, b_ada, b, c); }
#pragma unroll 1
            for (int rr = 0; rr < 16; rr += 4) {
                f32x4 v[4][4]; float s[4];
#pragma unroll
                for (int q = 0; q < 4; ++q) { const int row = r0 + rr + q; const float* xrow = row < NPR ? a.in[I_XP] + (size_t)row * D : a.in[I_XS] + (size_t)(row - NPR) * D;
#pragma unroll
                    for (int j = 0; j < 4; ++j) v[q][j] = __builtin_nontemporal_load((const f32x4*)(xrow + 4 * lane + 256 * j)); }
#pragma unroll
                for (int q = 0; q < 4; ++q) { float t = 0.f;
#pragma unroll
                    for (int j = 0; j < 4; ++j) t += (v[q][j][0] * v[q][j][0] + v[q][j][1] * v[q][j][1]) + (v[q][j][2] * v[q][j][2] + v[q][j][3] * v[q][j][3]);
                    s[q] = t; }
#pragma unroll
                for (int o = 1; o < 64; o <<= 1) { s[0] += __shfl_xor(s[0], o); s[1] += __shfl_xor(s[1], o); s[2] += __shfl_xor(s[2], o); s[3] += __shfl_xor(s[3], o); }
#pragma unroll
                for (int q = 0; q < 4; ++q) { const int row = r0 + rr + q; const float rstd = rsqrtf(s[q] * (1.0f / D) + EPS);
#pragma unroll
                    for (int j = 0; j < 4; ++j) { const f32x4 h = v[q][j] * rstd * Gv[j] + Sv[j]; v2u w; w.x = cvt_pk(h[0], h[1]); w.y = cvt_pk(h[2], h[3]);
                        *(v2u*)(h1b + blk_off(row & (GROWS - 1), 4 * lane + 256 * j, D)) = w; } }
            }
        }
    }
    if (rep < PROBE_REPS(1)) xcd_barrier(bar); }
    SEAM(1);

#ifndef GROUP_SKEW_US
#define GROUP_SKEW_US 0
#endif
    if (GROUP_SKEW_US > 0 && grp > 0) {
        if (threadIdx.x == 0) { const unsigned long long t0 = __builtin_amdgcn_s_memrealtime(), tgt = (unsigned long long)(100 * GROUP_SKEW_US) * (unsigned)grp;
            while (__builtin_amdgcn_s_memrealtime() - t0 < tgt) __builtin_amdgcn_s_sleep(10); }
        __syncthreads();
    }
    for (int rep = 0; rep <= PROBE_REPS(2); ++rep) { const float asc = rep ? 0.f : 1.f; (void)asc;
    if (IN(2)) {
        pg8::Gemm g{H1g, WinT, GROWS, INW, D}; GroupOrder S; S.init(INW, gk, xh, cph);
        EpiProj E{PROJg, hss, asc, pm0};
        pg8::gemm_phase<EpiProj, GroupOrder, PG8_ALIGN, PG8_SP2>(lds + RING_OFF, g, S, E, SW_PTR(2));
    }
    if (rep < PROBE_REPS(2)) xcd_barrier(barg); }
    SEAM(2);

    for (int rep = 0; rep <= PROBE_REPS(3); ++rep) { const float asc = rep ? 0.f : 1.f; (void)asc;
    if (IN(3)) {
        LANE_SETUP();
        typedef short bf16x8 __attribute__((ext_vector_type(8)));
        typedef short s16x4 __attribute__((ext_vector_type(4)));
        LAS float* tbl = (LAS float*)(lds + BIAS_OFF);
        LAS float* rkr = (LAS float*)(lds + RK_OFF);
        LAS float* qgt = rkr + 9 * 64;
        const int fq = lane >> 4, l15 = lane & 15, tq = l15 >> 2, tp = lane & 3;
        const int j = wave & 3, kc0 = min(max(16 * j - 8, 0), 32);
        for (int task = xh * cph + gk; task < 64; task += 2 * cph) {
            int b, h, r0, rows;
            if (grp < 2) { b = 4 * grp + (task >> 4); h = (task >> 1) & 7; r0 = (task & 1) * 16; rows = 32; }
            else { b = 8 + (grp - 2); h = task >> 3; r0 = (task & 7) * 16; rows = 128; }
            const int base = b < 8 ? b * 2048 : NPR + (b - 8) * 8192;
            const int gbase = base - GROWS * grp;
            __syncthreads();
            { const int dr = tid >> 5, dc = tid & 31; tbl[tid] = (dr < 15 && dc < 31) ? a.in[I_RPB][h * 465 + dr * 31 + dc] * 1.4426950408889634f : -1e30f; }
            if (tid < 64) qgt[tid] = a.in[I_QNG][tid] * a.in[I_KNG][tid];
            bool sel[4]; int dsel[4]; unsigned psel[2];
            { const int qc = 16 * j + l15, cs = min(max(qc - 8, 0), 48), o = cs - kc0;
#pragma unroll
              for (int e = 0; e < 4; ++e) { const int pp = 4 * fq + e; sel[e] = pp < o; dsel[e] = 4 * (kc0 + pp + (sel[e] ? 16 : 0) - qc + 15); }
              psel[0] = (sel[0] ? 0u : 0xFFFFu) | (sel[1] ? 0u : 0xFFFF0000u); psel[1] = (sel[2] ? 0u : 0xFFFFu) | (sel[3] ? 0u : 0xFFFF0000u); }
            const int koff0 = l15 * 128 + 16 * (fq ^ (l15 & 7)), koff1 = l15 * 128 + 16 * ((fq ^ (l15 & 7)) ^ 4);
            int voff[4];
#pragma unroll
            for (int db = 0; db < 4; ++db) voff[db] = (4 * fq + tq) * 128 + 16 * ((2 * db + (tp >> 1)) ^ (4 * (fq & 1) + tq)) + 8 * (tp & 1);
#define STAGE_ROW(kr) do { const int kr_ = (kr); const int slot_ = kr_ % 9; const int tc_ = 8 * wave + (lane >> 3), c16_ = (lane & 7) ^ (tc_ & 7); \
                const bf16* src_ = PROJg + (size_t)(gbase + kr_ * 64 + tc_) * INW + ATTW + h * 64 + 8 * c16_; \
                __builtin_amdgcn_global_load_lds((const unsigned*)src_, (LAS unsigned*)(lds + KRING_OFF + slot_ * 8192 + wave * 1024), 16, 0, 0); \
                __builtin_amdgcn_global_load_lds((const unsigned*)(src_ + ATTW), (LAS unsigned*)(lds + VRING_OFF + slot_ * 8192 + wave * 1024), 16, 0, 0); \
                if (wave == 4) rkr[slot_ * 64 + lane] = rsqrtf(hss[(size_t)(8 + h) * MT + base + kr_ * 64 + lane] * (1.0f / 64.0f) + EPS) * 1.4426950408889634f; } while (0)
            { const int lo0 = min(max(r0 - 4, 0), rows - 8);
              for (int kr = lo0; kr < lo0 + 8; ++kr) STAGE_ROW(kr); }
            const int pu0 = 128 * grp + 2 * task;
            v4u qraw[2] = {{0u, 0u, 0u, 0u}, {0u, 0u, 0u, 0u}}; float qss = 0.f;
            if (wave < 4) { const int qrow0 = base + r0 * 64 + 16 * j + l15; const bf16* qp0 = PROJg + (size_t)(qrow0 - GROWS * grp) * INW + h * 64 + 8 * fq;
                qss = hss[(size_t)h * MT + qrow0]; qraw[0] = *(const v4u*)qp0; qraw[1] = *(const v4u*)(qp0 + 32); }
            f32x4 sc[8]; float mxn = -3e38f; bf16x8 qfn[2] = {};
#pragma unroll 1
            for (int st = 0; st < 16; ++st) {
                if (wave < 4 && st > 0) asm volatile("s_waitcnt vmcnt(2)" ::: "memory"); else VM_WAIT();
                LDS_WAIT(); __builtin_amdgcn_s_barrier(); asm volatile("" ::: "memory");
                const int r = r0 + st, rs = min(max(r - 4, 0), rows - 8);
                if (st < 15) { const int rsn = min(max(r + 1 - 4, 0), rows - 8); if (rsn != rs) STAGE_ROW(rsn + 7); }
                if (wave < 4) {
                    const int dr0 = rs - r + 7;
                    const int qrow = base + r * 64 + 16 * j + l15;
                    bf16x8 kA[2][2], kB[2][2]; f32x4 rkvA[2], cq[2]; float bsvA[4];
                    const LAS unsigned char* tba[4];
#pragma unroll
                    for (int e = 0; e < 4; ++e) tba[e] = (const LAS unsigned char*)(tbl + dr0 * 32) + dsel[e];
#define AT_BUILDQ(QF, QR, QS) do { const float rqs_ = rsqrtf((QS) * (1.0f / 64.0f) + EPS) * 0.125f; \
                        _Pragma("unroll") for (int ks = 0; ks < 2; ++ks) { const int d0 = 32 * ks + 8 * fq; const v4u w = QR[ks]; \
                            const f32x4 g0 = *(const LAS f32x4*)(qgt + d0) * rqs_, g1 = *(const LAS f32x4*)(qgt + d0 + 4) * rqs_; \
                            v4u o; o.x = cvt_pk(bflo(w.x) * g0[0], bfhi(w.x) * g0[1]); o.y = cvt_pk(bflo(w.y) * g0[2], bfhi(w.y) * g0[3]); o.z = cvt_pk(bflo(w.z) * g1[0], bfhi(w.z) * g1[1]); o.w = cvt_pk(bflo(w.w) * g1[2], bfhi(w.w) * g1[3]); \
                            QF[ks] = __builtin_bit_cast(bf16x8, o); } } while (0)
#define AT_LDK(KF, RSX, i) do { const LAS unsigned char* kb_ = lds + KRING_OFF + (((RSX) + (i)) % 9) * 8192 + kc0 * 128; \
                        _Pragma("unroll") for (int cbk = 0; cbk < 2; ++cbk) { KF[cbk][0] = *(const LAS bf16x8*)(kb_ + cbk * 2048 + koff0); KF[cbk][1] = *(const LAS bf16x8*)(kb_ + cbk * 2048 + koff1); } } while (0)
#define AT_LDRB(RK, BS, RSX, TB, i) do { const LAS float* rkb_ = rkr + (((RSX) + (i)) % 9) * 64 + kc0 + 4 * fq; RK[0] = *(const LAS f32x4*)(rkb_); RK[1] = *(const LAS f32x4*)(rkb_ + 16); \
                        BS[0] = *(const LAS float*)(TB[0] + (i) * 128); BS[1] = *(const LAS float*)(TB[1] + (i) * 128); BS[2] = *(const LAS float*)(TB[2] + (i) * 128); BS[3] = *(const LAS float*)(TB[3] + (i) * 128); } while (0)
#define AT_MF(KF) do { _Pragma("unroll") for (int cbk = 0; cbk < 2; ++cbk) { cq[cbk] = (f32x4){0.f, 0.f, 0.f, 0.f}; \
                        cq[cbk] = __builtin_amdgcn_mfma_f32_16x16x32_bf16(KF[cbk][0], qfn[0], cq[cbk], 0, 0, 0); cq[cbk] = __builtin_amdgcn_mfma_f32_16x16x32_bf16(KF[cbk][1], qfn[1], cq[cbk], 0, 0, 0); } } while (0)
#define AT_SC(RK, BS, i) do { f32x4 s_; _Pragma("unroll") for (int e = 0; e < 4; ++e) s_[e] = (sel[e] ? cq[1][e] : cq[0][e]) * (sel[e] ? RK[1][e] : RK[0][e]) + BS[e]; \
                        sc[i] = s_; mxn = fmaxf(fmaxf(mxn, fmaxf(s_[0], s_[1])), fmaxf(s_[2], s_[3])); } while (0)
                    if (st == 0) {
                        AT_BUILDQ(qfn, qraw, qss); mxn = -3e38f;
                        qss = hss[(size_t)h * MT + qrow + 64]; qraw[0] = *(const v4u*)(PROJg + (size_t)(qrow + 64 - GROWS * grp) * INW + h * 64 + 8 * fq); qraw[1] = *(const v4u*)(PROJg + (size_t)(qrow + 64 - GROWS * grp) * INW + h * 64 + 32 + 8 * fq);
                        AT_LDK(kA, rs, 0);
#pragma unroll
                        for (int i2 = 0; i2 < 3; ++i2) {
                            AT_LDK(kB, rs, 2 * i2 + 1); AT_LDRB(rkvA, bsvA, rs, tba, 2 * i2); __builtin_amdgcn_sched_barrier(0);
                            AT_MF(kA); __builtin_amdgcn_sched_barrier(0); AT_SC(rkvA, bsvA, 2 * i2); __builtin_amdgcn_sched_barrier(0);
                            AT_LDK(kA, rs, 2 * i2 + 2); AT_LDRB(rkvA, bsvA, rs, tba, 2 * i2 + 1); __builtin_amdgcn_sched_barrier(0);
                            AT_MF(kB); __builtin_amdgcn_sched_barrier(0); AT_SC(rkvA, bsvA, 2 * i2 + 1); __builtin_amdgcn_sched_barrier(0);
                        }
                        AT_LDRB(rkvA, bsvA, rs, tba, 6); __builtin_amdgcn_sched_barrier(0);
                        AT_MF(kA); __builtin_amdgcn_sched_barrier(0); AT_SC(rkvA, bsvA, 6); __builtin_amdgcn_sched_barrier(0);
                    }
                    AT_LDK(kA, rs, 7); AT_LDRB(rkvA, bsvA, rs, tba, 7); __builtin_amdgcn_sched_barrier(0);
                    AT_MF(kA); __builtin_amdgcn_sched_barrier(0); AT_SC(rkvA, bsvA, 7); __builtin_amdgcn_sched_barrier(0);
                    float mx = red_max_16_32(mxn);
                    float lsum = 0.f;
                    f32x4 oacc[4];
#pragma unroll
                    for (int db = 0; db < 4; ++db) oacc[db] = (f32x4){0.f, 0.f, 0.f, 0.f};
                    s16x4 vaA[4], vbA[4];
#define ATT_LOAD_V(VA, VB, t) do { const LAS unsigned char* pA_ = lds + VRING_OFF + ((rs + (t)) % 9) * 8192 + kc0 * 128, * pB_ = pA_ + 2048; \
                        _Pragma("unroll") for (int db = 0; db < 4; ++db) { VA[db] = __builtin_bit_cast(s16x4, __builtin_amdgcn_ds_read_tr16_b64_v4i16((LAS s16x4*)(pA_ + voff[db]))); \
                            VB[db] = __builtin_bit_cast(s16x4, __builtin_amdgcn_ds_read_tr16_b64_v4i16((LAS s16x4*)(pB_ + voff[db]))); } } while (0)
#define ATT_EXP(t) do { f32x4 e_; e_[0] = __builtin_amdgcn_exp2f(sc[t][0] - mx); e_[1] = __builtin_amdgcn_exp2f(sc[t][1] - mx); e_[2] = __builtin_amdgcn_exp2f(sc[t][2] - mx); e_[3] = __builtin_amdgcn_exp2f(sc[t][3] - mx); \
                        sc[t] = e_; lsum += (e_[0] + e_[1]) + (e_[2] + e_[3]); } while (0)
#define ATT_COMP_V(VA, VB, t) do { const unsigned p01_ = cvt_pk(sc[t][0], sc[t][1]), p23_ = cvt_pk(sc[t][2], sc[t][3]); \
                        v4u pw_; pw_.x = p01_ & psel[0]; pw_.y = p23_ & psel[1]; pw_.z = p01_ & ~psel[0]; pw_.w = p23_ & ~psel[1]; \
                        const bf16x8 pf_ = __builtin_bit_cast(bf16x8, pw_); \
                        _Pragma("unroll") for (int db = 0; db < 4; ++db) { bf16x8 vf_; vf_[0] = VA[db][0]; vf_[1] = VA[db][1]; vf_[2] = VA[db][2]; vf_[3] = VA[db][3]; vf_[4] = VB[db][0]; vf_[5] = VB[db][1]; vf_[6] = VB[db][2]; vf_[7] = VB[db][3]; \
                            oacc[db] = __builtin_amdgcn_mfma_f32_16x16x32_bf16(vf_, pf_, oacc[db], 0, 0, 0); } } while (0)
                    if (st < 15) {
                        const int rsn_ = min(max(r + 1 - 4, 0), rows - 8), dr0n = rsn_ - (r + 1) + 7;
                        const LAS unsigned char* tbn[4];
#pragma unroll
                        for (int e = 0; e < 4; ++e) tbn[e] = (const LAS unsigned char*)(tbl + dr0n * 32) + dsel[e];
                        AT_BUILDQ(qfn, qraw, qss); mxn = -3e38f;
                        if (st < 14) { qss = hss[(size_t)h * MT + qrow + 128]; qraw[0] = *(const v4u*)(PROJg + (size_t)(qrow + 128 - GROWS * grp) * INW + h * 64 + 8 * fq); qraw[1] = *(const v4u*)(PROJg + (size_t)(qrow + 128 - GROWS * grp) * INW + h * 64 + 32 + 8 * fq); }
#define AT_PIPE(t, KC, KN) do { \
                            ATT_LOAD_V(vaA, vbA, t); if ((t) < 7) { AT_LDRB(rkvA, bsvA, rsn_, tbn, t); } if ((t) < 6) { AT_LDK(KN, rsn_, (t) + 1); } \
                            if ((t) < 7) { AT_MF(KC); } if ((t) < 7) { ATT_EXP((t) + 1); } ATT_COMP_V(vaA, vbA, t); if ((t) < 7) { AT_SC(rkvA, bsvA, t); } } while (0)
                        AT_LDK(kA, rsn_, 0); ATT_EXP(0); __builtin_amdgcn_sched_barrier(0);
                        AT_PIPE(0, kA, kB); AT_PIPE(1, kB, kA); AT_PIPE(2, kA, kB); AT_PIPE(3, kB, kA); AT_PIPE(4, kA, kB); AT_PIPE(5, kB, kA); AT_PIPE(6, kA, kB); AT_PIPE(7, kB, kA);
#undef AT_PIPE
                    } else {
                        ATT_EXP(0);
#pragma unroll
                        for (int t = 0; t < 8; ++t) {
                            ATT_LOAD_V(vaA, vbA, t); __builtin_amdgcn_sched_barrier(0);
                            if (t < 7) { ATT_EXP(t + 1); } ATT_COMP_V(vaA, vbA, t); __builtin_amdgcn_sched_barrier(0);
                        }
                    }
#undef ATT_LOAD_V
#undef ATT_EXP
#undef ATT_COMP_V
#undef AT_BUILDQ
#undef AT_LDK
#undef AT_LDRB
#undef AT_MF
#undef AT_SC
                    lsum = red_sum_16_32(lsum);
                    const float il = 1.0f / lsum;
#pragma unroll
                    for (int pr = 0; pr < 2; ++pr) {
                        unsigned ex = cvt_pk(oacc[2 * pr][0] * il, oacc[2 * pr][1] * il), ey = cvt_pk(oacc[2 * pr][2] * il, oacc[2 * pr][3] * il);
                        unsigned ox = cvt_pk(oacc[2 * pr + 1][0] * il, oacc[2 * pr + 1][1] * il), oy = cvt_pk(oacc[2 * pr + 1][2] * il, oacc[2 * pr + 1][3] * il);
                        asm volatile("s_nop 1\n\tv_permlane16_swap_b32 %0, %1" : "+v"(ex), "+v"(ox)); asm volatile("s_nop 1\n\tv_permlane16_swap_b32 %0, %1" : "+v"(ey), "+v"(oy));
                        v4u w; w.x = ex; w.y = ey; w.z = ox; w.w = oy;
                        *(v4u*)(CATg + blk_off(qrow - GROWS * grp, h * 64 + 16 * (2 * pr + (fq & 1)) + 4 * (fq & ~1), D)) = w; }
                } else if ((st & 1) == 0) {
                    const int it = st >> 1, g = wave - 4, pu = pu0 + (it >> 2), tg = 4 * (it & 3) + (lane >> 4), ch = 16 * g + (lane & 15);
                    int pb, prr, prows;
                    if (pu < 256) { pb = pu >> 5; prr = pu & 31; prows = 32; } else { pb = 8 + ((pu - 256) >> 7); prr = (pu - 256) & 127; prows = 128; }
                    const int pbase = (pb < 8 ? pb * 2048 : NPR + (pb - 8) * 8192) - GROWS * grp, T = prows * 64, t0 = prr * 64 + 4 * tg;
                    if (g == 0) pool_group<1>(PROJg, CATg, pbase, T, t0, ch); else if (g == 1) pool_group<2>(PROJg, CATg, pbase, T, t0, ch);
                    else if (g == 2) pool_group<4>(PROJg, CATg, pbase, T, t0, ch); else pool_group<8>(PROJg, CATg, pbase, T, t0, ch);
                }
            }
#undef STAGE_ROW
        }
    }
    if (rep < PROBE_REPS(3)) xcd_barrier(barg); }
    SEAM(3);

    for (int rep = 0; rep <= PROBE_REPS(4); ++rep) { const float asc = rep ? 0.f : 1.f; (void)asc;
    if (IN(4)) {
        pg8::Gemm g{CATg, WoT, GROWS, D, D}; GroupOrder S; S.init(D, gk, xh, cph);
        EpiOut E{a.in[I_XP], a.in[I_XS], X1g, XG2g, rss2, g1t, G2t, asc, pm0};
        pg8::gemm_phase<EpiOut, GroupOrder, PG8_ALIGN, PG8_SP2>(lds + RING_OFF, g, S, E, SW_PTR(4));
    }
    if (rep < PROBE_REPS(4)) xcd_barrier(barg); }
    SEAM(4);

    for (int rep = 0; rep <= PROBE_REPS(5); ++rep) { const float asc = rep ? 0.f : 1.f; (void)asc;
    if (IN(5)) {
        pg8::Gemm g{XG2g, WupT, GROWS, FF2, D}; GroupOrder S; S.init(FF2, gk, xh, cph);
        EpiConvAct E{ACTg, EDGE, rss2, c2acc, convp, cbp, (LAS float*)(lds + XCH_OFF), pm0};
        pg8::gemm_phase<EpiConvAct, GroupOrder, PG8_ALIGN, PG8_SP2>(lds + RING_OFF, g, S, E, SW_PTR(5));
    }
    if (rep < PROBE_REPS(5)) xcd_barrier(barg); }
    SEAM(5);

    for (int rep = 0; rep <= PROBE_REPS(6); ++rep) { const float asc = rep ? 0.f : 1.f; (void)asc;
    if (IN(6)) {
        LANE_SETUP();
        for (int idx = (xh * cph + gk) * 512 + tid; idx < 2 * GPANELS * (FF / 8); idx += gsz * 512) {
            const int br = idx / (FF / 8), f = 8 * (idx % (FF / 8)), gcol = (f >> 7) * 256 + (f & 127);
            const int pm = pm0 + (br >> 1), last = br & 1, row = pm * 256 + (last ? 255 : 0);
            const int b = batch_of_row(row), t = row < NPR ? (row & 2047) : ((row - NPR) & 8191), T = b < 8 ? 2048 : 8192;
            const float* em; const float* e0; const float* ep;
            if (!last) { em = EDGE + ((size_t)(pm - 1) * 4 + 3) * FF2; e0 = EDGE + ((size_t)pm * 4 + 0) * FF2; ep = EDGE + ((size_t)pm * 4 + 1) * FF2; }
            else       { em = EDGE + ((size_t)pm * 4 + 2) * FF2; e0 = EDGE + ((size_t)pm * 4 + 3) * FF2; ep = EDGE + ((size_t)(pm + 1) * 4 + 0) * FF2; }
            const bool hm = t > 0, hp = t < T - 1;
            float res[2][8];
#pragma unroll
            for (int part = 0; part < 2; ++part) {
                const int col = gcol + 128 * part;
#pragma unroll
                for (int hh = 0; hh < 2; ++hh) {
                    const int c = col + 4 * hh; const f32x4 zero = {0.f, 0.f, 0.f, 0.f};
                    const f32x4 um = hm ? *(const f32x4*)(em + c) : zero, u0 = *(const f32x4*)(e0 + c), up = hp ? *(const f32x4*)(ep + c) : zero;
                    const f32x4 w0 = *(const f32x4*)(convp + c), w1 = *(const f32x4*)(convp + FF2 + c), w2 = *(const f32x4*)(convp + 2 * FF2 + c), cb = *(const f32x4*)(cbp + c);
                    const f32x4 r = w0 * um + w1 * u0 + w2 * up + cb;
                    res[part][4 * hh + 0] = r[0]; res[part][4 * hh + 1] = r[1]; res[part][4 * hh + 2] = r[2]; res[part][4 * hh + 3] = r[3];
                }
            }
            float av[8];
#pragma unroll
            for (int i = 0; i < 8; ++i) av[i] = res[0][i] * res[1][i] * __builtin_amdgcn_rcpf(1.0f + __builtin_amdgcn_exp2f(-res[0][i]));
            v4u ow; ow.x = pk2(av[0], av[1]); ow.y = pk2(av[2], av[3]); ow.z = pk2(av[4], av[5]); ow.w = pk2(av[6], av[7]);
            *(v4u*)(ACTg + blk_off(row - GROWS * grp, f, FF)) = ow;
        }
    }
    if (rep < PROBE_REPS(6)) xcd_barrier(barg); }
    SEAM(6);

    for (int rep = 0; rep <= PROBE_REPS(7); ++rep) { const float asc = rep ? 0.f : 1.f; (void)asc;
    if (IN(7)) {
        pg8::Gemm g{ACTg, WdT, GROWS, D, FF}; GroupOrder S; S.init(D, gk, xh, cph);
        EpiDown E{XG2g, a.out, g2t, iG2t, pm0};
        pg8::gemm_phase<EpiDown, GroupOrder, PG8_ALIGN, PG8_SP2>(lds + RING_OFF, g, S, E, SW_PTR(7));
    }
    if (rep < PROBE_REPS(7)) xcd_barrier(barg); }
    if (SW_PHASE >= 0 && blockIdx.x == 0 && threadIdx.x == 0) {
        const unsigned long long tgt = (unsigned long long)SW_SCALE * ((volatile LAS unsigned*)(lds + LDSCTL_OFF + 64))[SW_SEL], t0 = __builtin_amdgcn_s_memrealtime();
        while (__builtin_amdgcn_s_memrealtime() - t0 < tgt) __builtin_amdgcn_s_sleep(20);
    }
#undef IN
#undef SEAM
}

extern "C" void kernel_launch(void* const* d_in, const int* in_sizes, int n_in, void* d_out, int out_size, void* d_ws, size_t ws_size, hipStream_t stream) {
    static int grid = 0;
    if (grid == 0) {
        if (n_in != 19 || out_size != MT * D || ws_size < WS_END) { fprintf(stderr, "kernel_launch: unexpected shapes (n_in %d, out %d, ws %zu)\n", n_in, out_size, ws_size); grid = -1; return; }
        int dev = 0, cus = 0;
        if (hipGetDevice(&dev) != hipSuccess || hipDeviceGetAttribute(&cus, hipDeviceAttributeMultiprocessorCount, dev) != hipSuccess) { grid = -1; return; }
        if (hipFuncSetAttribute((const void*)fwd, hipFuncAttributeMaxDynamicSharedMemorySize, LDS_BYTES) != hipSuccess) { fprintf(stderr, "kernel_launch: hipFuncSetAttribute failed\n"); grid = -1; return; }
        int per_cu = 0;
        if (hipOccupancyMaxActiveBlocksPerMultiprocessor(&per_cu, (const void*)fwd, NWAVES * 64, LDS_BYTES) != hipSuccess || per_cu < 1) { fprintf(stderr, "kernel_launch: the occupancy query admits %d workgroups per CU; nothing launched\n", per_cu); grid = -1; return; }
        (void)hipGetLastError();
        grid = cus;
        if (grid % 8 != 0 || grid < 8) { fprintf(stderr, "kernel_launch: needs a multiple of 8 CUs (got %d)\n", grid); grid = -1; return; }
    }
    if (grid < 0) return;
    if (hipMemsetAsync((char*)d_ws + WS_CTL, 0, CTL_ZERO_BYTES, stream) != hipSuccess) return;
    Args a{};
    for (int i = 0; i < 19; ++i) a.in[i] = (const float*)d_in[i];
    a.out = (float*)d_out; a.ws = (unsigned char*)d_ws;
    a.ph_lo = 0; a.ph_hi = N_PHASES; a.row0 = 0; a.nrows = 0;
    hipLaunchKernelGGL(fwd, dim3(grid), dim3(NWAVES * 64), LDS_BYTES, stream, a);
}
```
